# Optimizing an MI355X kernel written in HIP

```python
import jax, jax.numpy as jnp
from jax import lax
import numpy as np

D_MODEL = 1024
BATCH = 16
SEQ = 256
DEPTH = 2
DEC_BATCH = 4
DEC_SEQ = 4096
PAST_LEN = 512

GRID_W = 64
N_EVEN = (DEPTH + 1) // 2
N_ODD = DEPTH // 2
EPS = 1e-6
POOL_WIDTH = D_MODEL // 2
POOL_GROUPS = 4
POOL_GROUP_DIM = POOL_WIDTH // POOL_GROUPS
POOL_WINDOWS = (2, 4, 8, 16)
CONV_WIDTH = D_MODEL // 2
CONV_K = 3
EVEN_IN = POOL_WIDTH + 3 * CONV_WIDTH
EVEN_OUT = POOL_WIDTH + CONV_WIDTH
HEAD_DIM = 128
N_HEADS = D_MODEL // HEAD_DIM
N_KV_HEADS = N_HEADS // 4
QKV_WIDTH = (N_HEADS + 2 * N_KV_HEADS) * HEAD_DIM
Q_BLOCK = 128
ROPE_THETA = 10000.0
AXIS_DIM = HEAD_DIM // 2
D_FF = ((8 * D_MODEL // 3 + 255) // 256) * 256

kernel_name = "hybrid_pool_conv_gqa_diffusion_step"


def rms_norm(x, g):
    xf = x.astype(jnp.float32)
    y = xf * lax.rsqrt(jnp.mean(xf * xf, axis=-1, keepdims=True) + EPS)
    return (y * g.astype(jnp.float32)).astype(x.dtype)


def ada_params(cvec, w_ada, b_ada):
    m = jax.nn.silu(cvec) @ w_ada + b_ada
    return jnp.split(m[:, None, :], 6, axis=-1)


def modulate(x, g, shift, scale):
    return rms_norm(x, g) * (1 + scale) + shift


def window_mean(x, w):
    L = x.shape[1]
    cs = jnp.pad(jnp.cumsum(x.astype(jnp.float32), axis=1), ((0, 0), (1, 0), (0, 0)))
    t = jnp.arange(L)
    lo = jnp.clip(t - w // 2, 0, L)
    hi = jnp.clip(t + w // 2, 0, L)
    cnt = (hi - lo).astype(jnp.float32)[None, :, None]
    return ((cs[:, hi] - cs[:, lo]) / cnt).astype(x.dtype)


def pool_mixer(u, w_grp, scale):
    B, L, _ = u.shape
    ug = u.reshape(B, L, POOL_GROUPS, POOL_GROUP_DIM)
    pooled = jnp.stack([window_mean(ug[:, :, i], w) for i, w in enumerate(POOL_WINDOWS)], axis=2) - ug
    y = jnp.einsum('blgc,gcd->blgd', pooled, w_grp).reshape(B, L, POOL_WIDTH)
    return y * scale


def short_conv_mixer(bg, cg, v, conv_w, conv_b):
    z = cg * v
    L = z.shape[1]
    zp = jnp.pad(z, ((0, 0), (CONV_K // 2, CONV_K // 2), (0, 0)))
    conv = sum(zp[:, k:k + L] * conv_w[k] for k in range(CONV_K)) + conv_b
    return bg * conv


def even_mixer(h, w_in, pool_w, pool_scale, conv_w, conv_b, w_out):
    p = h @ w_in
    u, bg, cg, v = jnp.split(p, [POOL_WIDTH, POOL_WIDTH + CONV_WIDTH, POOL_WIDTH + 2 * CONV_WIDTH], axis=-1)
    ya = pool_mixer(u, pool_w, pool_scale)
    yb = short_conv_mixer(bg, cg, v, conv_w, conv_b)
    return jnp.concatenate([ya, yb], axis=-1) @ w_out


def rope_2d_tables(L):
    rows = L // GRID_W
    r = jnp.repeat(jnp.arange(rows), GRID_W).astype(jnp.float32)
    col = jnp.tile(jnp.arange(GRID_W), rows).astype(jnp.float32)
    inv = ROPE_THETA ** (-jnp.arange(0, AXIS_DIM, 2, dtype=jnp.float32) / AXIS_DIM)
    ar = r[:, None] * inv
    ac = col[:, None] * inv
    ang = jnp.concatenate([ar, ar, ac, ac], axis=-1)
    return jnp.cos(ang), jnp.sin(ang)


def _rot_half(a):
    a1, a2 = jnp.split(a, 2, axis=-1)
    return jnp.concatenate([-a2, a1], axis=-1)


def apply_rope_2d(x, cos, sin):
    xr, xc = jnp.split(x, 2, axis=-1)
    xrot = jnp.concatenate([_rot_half(xr), _rot_half(xc)], axis=-1)
    return (x * cos[None, :, None, :] + xrot * sin[None, :, None, :]).astype(x.dtype)


def qkv_proj(h, w_qkv, q_gain, k_gain):
    B, L, _ = h.shape
    p = h @ w_qkv
    q, k, v = jnp.split(p, [N_HEADS * HEAD_DIM, (N_HEADS + N_KV_HEADS) * HEAD_DIM], axis=-1)
    q = rms_norm(q.reshape(B, L, N_HEADS, HEAD_DIM), q_gain)
    k = rms_norm(k.reshape(B, L, N_KV_HEADS, HEAD_DIM), k_gain)
    v = v.reshape(B, L, N_KV_HEADS, HEAD_DIM)
    return q, k, v


def blocked_attention(q, k, v):
    B, Lq, _, _ = q.shape
    nb = Lq // Q_BLOCK
    G = N_HEADS // N_KV_HEADS
    qb = q.reshape(B, nb, Q_BLOCK, N_KV_HEADS, G, HEAD_DIM).transpose(1, 0, 2, 3, 4, 5)
    sm_scale = HEAD_DIM ** -0.5

    def one_block(qi):
        s = jnp.einsum('bqkgd,bskd->bkgqs', qi, k, preferred_element_type=jnp.float32) * sm_scale
        p = jax.nn.softmax(s, axis=-1).astype(v.dtype)
        return jnp.einsum('bkgqs,bskd->bqkgd', p, v)

    o = lax.map(one_block, qb)
    return o.transpose(1, 0, 2, 3, 4, 5).reshape(B, Lq, N_HEADS * HEAD_DIM)


def swiglu(h, w_in, w_out):
    a, b = jnp.split(h @ w_in, 2, axis=-1)
    return (jax.nn.silu(a) * b) @ w_out


def setup_inputs(seed: int = 0) -> dict:
    key = jax.random.key(seed)
    ks = jax.random.split(key, 24)
    nrm = lambda k, shape, s: jax.random.normal(k, shape, jnp.float32) * s
    return {
        "x_prompt": nrm(ks[0], (BATCH, SEQ, D_MODEL), 1.0),
        "x_sample": nrm(ks[1], (DEC_BATCH, DEC_SEQ, D_MODEL), 1.0),
        "cache_k": nrm(ks[2], (DEC_BATCH, N_ODD, PAST_LEN, N_KV_HEADS, HEAD_DIM), 1.0),
        "cache_v": nrm(ks[3], (DEC_BATCH, N_ODD, PAST_LEN, N_KV_HEADS, HEAD_DIM), 1.0),
        "c": nrm(ks[4], (DEC_BATCH, D_MODEL), 1.0),
        "c_ctx": nrm(ks[5], (D_MODEL,), 1.0),
        "w_ada": nrm(ks[6], (DEPTH, D_MODEL, 6 * D_MODEL), 0.5 * D_MODEL ** -0.5),
        "b_ada": nrm(ks[7], (DEPTH, 6 * D_MODEL), 0.02),
        "norm_g": 1.0 + nrm(ks[8], (DEPTH, 2, D_MODEL), 0.02),
        "w_in_even": nrm(ks[9], (N_EVEN, D_MODEL, EVEN_IN), D_MODEL ** -0.5),
        "pool_w": nrm(ks[10], (N_EVEN, POOL_GROUPS, POOL_GROUP_DIM, POOL_GROUP_DIM), POOL_GROUP_DIM ** -0.5),
        "pool_scale": 1.0 + nrm(ks[11], (N_EVEN, POOL_WIDTH), 0.02),
        "conv_w": nrm(ks[12], (N_EVEN, CONV_K, CONV_WIDTH), CONV_K ** -0.5),
        "conv_b": nrm(ks[13], (N_EVEN, CONV_WIDTH), 0.02),
        "w_out_even": nrm(ks[14], (N_EVEN, EVEN_OUT, D_MODEL), EVEN_OUT ** -0.5),
        "w_qkv": nrm(ks[15], (N_ODD, D_MODEL, QKV_WIDTH), D_MODEL ** -0.5),
        "q_gain": 1.0 + nrm(ks[16], (N_ODD, HEAD_DIM), 0.02),
        "k_gain": 1.0 + nrm(ks[17], (N_ODD, HEAD_DIM), 0.02),
        "w_o": nrm(ks[18], (N_ODD, N_HEADS * HEAD_DIM, D_MODEL), (N_HEADS * HEAD_DIM) ** -0.5),
        "w_ffn_in": nrm(ks[19], (DEPTH, D_MODEL, 2 * D_FF), D_MODEL ** -0.5),
        "w_ffn_out": nrm(ks[20], (DEPTH, D_FF, D_MODEL), D_FF ** -0.5),
        "final_g": 1.0 + nrm(ks[21], (D_MODEL,), 0.02),
    }


def reference(x_prompt, x_sample, cache_k, cache_v, c, c_ctx, w_ada, b_ada, norm_g,
              w_in_even, pool_w, pool_scale, conv_w, conv_b, w_out_even,
              w_qkv, q_gain, k_gain, w_o, w_ffn_in, w_ffn_out, final_g):
    x = x_prompt
    ctx_cond = c_ctx[None, :]
    new_k, new_v = [], []
    for l in range(DEPTH):
        i = l // 2
        sh1, sc1, g1, sh2, sc2, g2 = ada_params(ctx_cond, w_ada[l], b_ada[l])
        h = modulate(x, norm_g[l, 0], sh1, sc1)
        if l % 2 == 0:
            y = even_mixer(h, w_in_even[i], pool_w[i], pool_scale[i], conv_w[i], conv_b[i], w_out_even[i])
        else:
            q, k, v = qkv_proj(h, w_qkv[i], q_gain[i], k_gain[i])
            y = blocked_attention(q, k, v) @ w_o[i]
            new_k.append(k)
            new_v.append(v)
        x = x + g1 * y
        h = modulate(x, norm_g[l, 1], sh2, sc2)
        x = x + g2 * swiglu(h, w_ffn_in[l], w_ffn_out[l])
    y_prompt = rms_norm(x, final_g)
    new_cache_k = jnp.stack(new_k, axis=1)
    new_cache_v = jnp.stack(new_v, axis=1)

    x = x_sample
    cos, sin = rope_2d_tables(x_sample.shape[1])
    for l in range(DEPTH):
        i = l // 2
        sh1, sc1, g1, sh2, sc2, g2 = ada_params(c, w_ada[l], b_ada[l])
        h = modulate(x, norm_g[l, 0], sh1, sc1)
        if l % 2 == 0:
            y = even_mixer(h, w_in_even[i], pool_w[i], pool_scale[i], conv_w[i], conv_b[i], w_out_even[i])
        else:
            q, k, v = qkv_proj(h, w_qkv[i], q_gain[i], k_gain[i])
            q = apply_rope_2d(q, cos, sin)
            k = apply_rope_2d(k, cos, sin)
            k_all = jnp.concatenate([cache_k[:, i].astype(k.dtype), k], axis=1)
            v_all = jnp.concatenate([cache_v[:, i].astype(v.dtype), v], axis=1)
            y = blocked_attention(q, k_all, v_all) @ w_o[i]
        x = x + g1 * y
        h = modulate(x, norm_g[l, 1], sh2, sc2)
        x = x + g2 * swiglu(h, w_ffn_in[l], w_ffn_out[l])
    y_sample = rms_norm(x, final_g)

    return (y_prompt, y_sample, new_cache_k, new_cache_v)
```

```cpp
#include <hip/hip_runtime.h>
#include <hip/hip_cooperative_groups.h>
#include <hip/hip_bf16.h>
#include <cstdio>
#include <cstdint>
namespace cg = cooperative_groups;

namespace pg8 {
#define PG8_LAS __attribute__((address_space(3)))
typedef unsigned short bf16_t;
typedef short bf16x8 __attribute__((ext_vector_type(8)));
typedef float f32x4 __attribute__((ext_vector_type(4)));
typedef unsigned u32x4 __attribute__((ext_vector_type(4)));
constexpr int BM = 256, BK = 64, HALF = 128, HTB = HALF * BK * 2  , STAGE_BYTES = 8 * HTB, NXCD = 8, WGM = 8;

__host__ __device__ __forceinline__ int lds_byte(int r, int c) { const int st = (r >> 4) * 2 + (c >> 5), rr = r & 15, cc = c & 31, ob = rr * 64 + cc * 2; return st * 1024 + (ob ^ (((ob >> 9) & 1) << 5)); }
__host__ __device__ __forceinline__ void stage_rc(int b, int& R, int& C) { const int st = b / 1024, sb = b % 1024, swz = sb ^ (((sb >> 9) & 1) << 5); R = (st >> 1) * 16 + swz / 64; C = (st & 1) * 32 + (swz % 64) / 2; }
__host__ __device__ __forceinline__ int perm32(int rho) { const int n = rho >> 4, i = rho & 15; return 8 * (i >> 2) + 4 * n + (i & 3); }

struct Unit { int pm, pn, hf; };
struct Gemm { const bf16_t* A; const bf16_t* Bt; int M, N, K; };

struct StaticOrder {
    int nM, nN, nwg, G, c;
    __host__ __device__ void init(int M, int N, int G_, int c_) { nM = M / BM; nN = N / BM; nwg = nM * nN; G = G_; c = c_; }
    __host__ __device__ bool next(int i, Unit& u) const {
        const long L = (long)i * G + c; if (L >= nwg) return false;
        int wgid = (int)L; { const int q = nwg / NXCD, r = nwg % NXCD, xcd = wgid % NXCD, off = wgid / NXCD; wgid = (xcd < r ? xcd * (q + 1) : r * (q + 1) + (xcd - r) * q) + off; }
        const int nig = WGM * nN, gid = wgid / nig, fm = gid * WGM, gsz = (nM - fm) < WGM ? (nM - fm) : WGM;
        u.pm = fm + ((wgid % nig) % gsz); u.pn = (wgid % nig) / gsz; u.hf = 0; return true;
    }
    __device__ __forceinline__ void a_ready(const Unit&) const {}
    __device__ __forceinline__ void done(const Unit&) const {}
};
struct HalfOrder {
    int G, c, ncol;
    __host__ __device__ void init(int G_, int c_, int ncol_ = 4) { G = G_; c = c_; ncol = ncol_; }
    __host__ __device__ __forceinline__ bool next(int i, Unit& u) const {
        const int L = i * G + c, nhalf = 32 * ncol; if (L >= nhalf + 64 * ncol) return false;
        const bool full = L >= nhalf; const int Lf = L - nhalf, x = Lf & 7, slot = Lf >> 3, h = L;
        u.pm = full ? 16 + x * 8 + slot / ncol : h / (2 * ncol); u.pn = full ? slot % ncol : h % (2 * ncol); u.hf = full ? 0 : 1;
        return true;
    }
    __device__ __forceinline__ void a_ready(const Unit&) const {}
    __device__ __forceinline__ void done(const Unit&) const {}
};

__device__ __forceinline__ unsigned cvt_pk_bf16(float lo, float hi) { unsigned r; asm volatile("v_cvt_pk_bf16_f32 %0, %1, %2" : "=v"(r) : "v"(lo), "v"(hi)); return r; }
__device__ __forceinline__ int cond_of(int pm) { return pm < 16 ? 0 : 1 + ((pm - 16) >> 4); }
template <bool NORM> struct EpiStoreN {
    static constexpr bool PERM = true, AFTER_DRAIN = false;
    bf16_t* O; int ldc; const float* ss; const float* sW; int ldw;
    __device__ __forceinline__ void operator()(const f32x4 (&acc)[2][2][4][2], const Unit& u, int wr, int wc, int fr, int fq) const {
        const int row0 = u.pm * BM + wr * 64 + fr, col0 = u.pn * (u.hf ? HALF : BM) + wc * 32 + 8 * fq; const int nbj = u.hf ? 1 : 2;
        f32x4 bv[2][2];
        if constexpr (NORM) { const float* bp = sW + (size_t)cond_of(u.pm) * ldw + col0;
#pragma unroll
            for (int bj = 0; bj < 2; ++bj)
#pragma unroll
                for (int n = 0; n < 2; ++n) bv[bj][n] = *(const f32x4*)(bp + bj * HALF + 4 * n); }
#pragma unroll
        for (int ai = 0; ai < 2; ++ai)
#pragma unroll
            for (int m = 0; m < 4; ++m) { const int r = row0 + ai * HALF + m * 16; bf16_t* rowp = O + (size_t)r * ldc + col0;
                float rs = 1.f; if constexpr (NORM) rs = __builtin_amdgcn_rsqf(ss[r] * (1.0f / 1024.0f) + 1e-6f);
#pragma unroll
                for (int bj = 0; bj < 2; ++bj) { if (bj >= nbj) continue; f32x4 v0 = acc[ai][bj][m][0], v1 = acc[ai][bj][m][1];
                    if constexpr (NORM) { v0 = v0 * rs + bv[bj][0]; v1 = v1 * rs + bv[bj][1]; }
                    u32x4 w; w.x = cvt_pk_bf16(v0[0], v0[1]); w.y = cvt_pk_bf16(v0[2], v0[3]); w.z = cvt_pk_bf16(v1[0], v1[1]); w.w = cvt_pk_bf16(v1[2], v1[3]);
                    *(u32x4*)(rowp + bj * HALF) = w; } }
    }
};
__device__ __forceinline__ float silu_mul(float a, float b) { return a * __builtin_amdgcn_rcpf(1.0f + __builtin_amdgcn_exp2f(-1.4426950408889634f * a)) * b; }
struct EpiSwigluN {
    static constexpr bool PERM = true, AFTER_DRAIN = false;
    bf16_t* O; int ldc; const float* ss; const float* sW; int ldw;
    __device__ __forceinline__ void operator()(const f32x4 (&acc)[2][2][4][2], const Unit& u, int wr, int wc, int fr, int fq) const {
        const int row0 = u.pm * BM + wr * 64 + fr, col0 = u.pn * HALF + wc * 32 + 8 * fq;
        const float* bp = sW + (size_t)cond_of(u.pm) * ldw + u.pn * BM + wc * 32 + 8 * fq;
        const f32x4 ba0 = *(const f32x4*)(bp), ba1 = *(const f32x4*)(bp + 4), bb0 = *(const f32x4*)(bp + HALF), bb1 = *(const f32x4*)(bp + HALF + 4);
#pragma unroll
        for (int ai = 0; ai < 2; ++ai)
#pragma unroll
            for (int m = 0; m < 4; ++m) { const int r = row0 + ai * HALF + m * 16; bf16_t* rowp = O + (size_t)r * ldc + col0;
                const float rs = __builtin_amdgcn_rsqf(ss[r] * (1.0f / 1024.0f) + 1e-6f);
                const f32x4 a0 = acc[ai][0][m][0] * rs + ba0, a1 = acc[ai][0][m][1] * rs + ba1, b0 = acc[ai][1][m][0] * rs + bb0, b1 = acc[ai][1][m][1] * rs + bb1;
                u32x4 w; w.x = cvt_pk_bf16(silu_mul(a0[0], b0[0]), silu_mul(a0[1], b0[1])); w.y = cvt_pk_bf16(silu_mul(a0[2], b0[2]), silu_mul(a0[3], b0[3]));
                w.z = cvt_pk_bf16(silu_mul(a1[0], b1[0]), silu_mul(a1[1], b1[1])); w.w = cvt_pk_bf16(silu_mul(a1[2], b1[2]), silu_mul(a1[3], b1[3]));
                *(u32x4*)rowp = w; }
    }
};
template <bool HB, bool FIRST> struct EpiResNorm {
    static constexpr bool PERM = true, AFTER_DRAIN = false;
    const float* base_ctx; const float* base_lat; bf16_t* xb; const float* gate; const float* gp; bf16_t* hb; float* ss;
    __device__ __forceinline__ void operator()(const f32x4 (&acc)[2][2][4][2], const Unit& u, int wr, int wc, int fr, int fq) const {
        const int j = cond_of(u.pm);
        const float* base = u.pm < 16 ? base_ctx + (size_t)u.pm * BM * 1024 : base_lat + (size_t)(u.pm - 16) * BM * 1024;
        const int col0 = u.pn * (u.hf ? HALF : BM) + wc * 32 + 8 * fq, rl0 = wr * 64 + fr; const int nbj = u.hf ? 1 : 2;
        f32x4 gv[2][2], pv[2][2];
#pragma unroll
        for (int bj = 0; bj < 2; ++bj)
#pragma unroll
            for (int n = 0; n < 2; ++n) { if (bj >= nbj) continue; gv[bj][n] = *(const f32x4*)(gate + (size_t)j * 6144 + col0 + bj * HALF + n * 4);
                if constexpr (HB) pv[bj][n] = *(const f32x4*)(gp + (size_t)j * 1024 + col0 + bj * HALF + n * 4); }
        bf16_t* outp = xb + (size_t)u.pm * BM * 1024; bf16_t* hbp = hb + (size_t)u.pm * BM * 1024; float* ssp = ss + u.pm * BM;
#pragma unroll
        for (int ai = 0; ai < 2; ++ai)
#pragma unroll
            for (int m = 0; m < 4; ++m) { const int rl = rl0 + ai * HALF + m * 16; const size_t off = (size_t)rl * 1024 + col0; float s = 0.f;
#pragma unroll
                for (int bj = 0; bj < 2; ++bj) { if (bj >= nbj) continue;
                    f32x4 b0, b1;
                    if constexpr (FIRST) { b0 = *(const f32x4*)(base + off + bj * HALF); b1 = *(const f32x4*)(base + off + bj * HALF + 4); }
                    else { const u32x4 bw = *(const u32x4*)(outp + off + bj * HALF);
                        b0 = (f32x4){__builtin_bit_cast(float, bw.x << 16), __builtin_bit_cast(float, bw.x & 0xffff0000u), __builtin_bit_cast(float, bw.y << 16), __builtin_bit_cast(float, bw.y & 0xffff0000u)};
                        b1 = (f32x4){__builtin_bit_cast(float, bw.z << 16), __builtin_bit_cast(float, bw.z & 0xffff0000u), __builtin_bit_cast(float, bw.w << 16), __builtin_bit_cast(float, bw.w & 0xffff0000u)}; }
                    const f32x4 o0 = b0 + gv[bj][0] * acc[ai][bj][m][0], o1 = b1 + gv[bj][1] * acc[ai][bj][m][1];
                    { u32x4 ow; ow.x = cvt_pk_bf16(o0[0], o0[1]); ow.y = cvt_pk_bf16(o0[2], o0[3]); ow.z = cvt_pk_bf16(o1[0], o1[1]); ow.w = cvt_pk_bf16(o1[2], o1[3]); *(u32x4*)(outp + off + bj * HALF) = ow; }
                    s += ((o0[0] * o0[0] + o0[1] * o0[1]) + (o0[2] * o0[2] + o0[3] * o0[3])) + ((o1[0] * o1[0] + o1[1] * o1[1]) + (o1[2] * o1[2] + o1[3] * o1[3]));
                    if constexpr (HB) { const f32x4 h0 = o0 * pv[bj][0], h1 = o1 * pv[bj][1]; u32x4 w; w.x = cvt_pk_bf16(h0[0], h0[1]); w.y = cvt_pk_bf16(h0[2], h0[3]); w.z = cvt_pk_bf16(h1[0], h1[1]); w.w = cvt_pk_bf16(h1[2], h1[3]); *(u32x4*)(hbp + off + bj * HALF) = w; } }
                s += __shfl_xor(s, 16); s += __shfl_xor(s, 32);
                if (fq == 0) __hip_atomic_fetch_add(ssp + rl, s, __ATOMIC_RELAXED, __HIP_MEMORY_SCOPE_AGENT); }
    }
};

template <class Epi, class Sched, bool ALIGN_EPI = false, bool SP2 = false>
__device__ __forceinline__ void gemm_phase(PG8_LAS unsigned char* lds, const Gemm g, const Sched& S, const Epi& E) {
    const int tid = threadIdx.x, wid = __builtin_amdgcn_readfirstlane(tid >> 6), lane = tid & 63, wr = wid >> 2, wc = wid & 3, fr = lane & 15, fq = lane >> 4;
    const int K = g.K, nt = K / BK;
    unsigned voffA[2], voffB[2];
#pragma unroll
    for (int i = 0; i < 2; ++i) { int R, C; stage_rc(tid * 16 + i * 8192, R, C); const int Rb = Epi::PERM ? ((R & ~31) + perm32(R & 31)) : R;
        voffA[i] = (unsigned)(R * K + C) * 2u; voffB[i] = (unsigned)(Rb * K + C) * 2u; }
    const size_t kstep = (size_t)(BK * 2);
    const size_t hstep = (size_t)HALF * K * 2;
    const size_t tstep = 2 * hstep;
    const unsigned ldsw = (unsigned)wid * 1024u;
    const int aoff = lds_byte(wr * 64 + fr, fq * 8), boff = lds_byte(wc * 32 + fr, fq * 8);
#define PG8_SA(b, h) (((b) * 2 + (h)) * HTB)
#define PG8_SB(b, h) ((4 + (b) * 2 + (h)) * HTB)
#define PG8_STAGE(bufoff, gbase, voff) do { _Pragma("unroll") for (int _i = 0; _i < 2; ++_i) \
        __builtin_amdgcn_global_load_lds((const unsigned*)((const char*)(gbase) + (voff)[_i]), (PG8_LAS unsigned*)(lds + (bufoff) + ldsw + _i * 8192), 16, 0, 0); } while (0)
#define PG8_LDA(dst, b, h) do { _Pragma("unroll") for (int m = 0; m < 4; ++m) _Pragma("unroll") for (int k = 0; k < 2; ++k) dst[m][k] = *(const PG8_LAS bf16x8*)(lds + PG8_SA(b, h) + aoff + m * 2048 + k * 1024); } while (0)
#define PG8_LDB(dst, b, h) do { _Pragma("unroll") for (int n = 0; n < 2; ++n) _Pragma("unroll") for (int k = 0; k < 2; ++k) dst[n][k] = *(const PG8_LAS bf16x8*)(lds + PG8_SB(b, h) + boff + n * 2048 + k * 1024); } while (0)
#define PG8_MMA(ai, bj, At, Bt) do { __builtin_amdgcn_s_setprio(1); _Pragma("unroll") for (int m = 0; m < 4; ++m) _Pragma("unroll") for (int n = 0; n < 2; ++n) _Pragma("unroll") for (int k = 0; k < 2; ++k) \
        acc[ai][bj][m][n] = __builtin_amdgcn_mfma_f32_16x16x32_bf16(Bt[n][k], At[m][k], acc[ai][bj][m][n], 0, 0, 0); __builtin_amdgcn_s_setprio(0); } while (0)
#define PG8_WAIT_V(n) asm volatile("s_waitcnt vmcnt(" #n ")" ::: "memory")
#define PG8_WAIT_L(n) asm volatile("s_waitcnt lgkmcnt(" #n ")" ::: "memory")
#define PG8_BAR __builtin_amdgcn_s_barrier()
#define PG8_SCHED __builtin_amdgcn_sched_barrier(0)
    Unit cur, nxt; int ui = 0;
    if (!S.next(0, cur)) return;
    f32x4 acc[2][2][4][2];
#pragma unroll
    for (int a = 0; a < 2; ++a)
#pragma unroll
        for (int b = 0; b < 2; ++b)
#pragma unroll
            for (int m = 0; m < 4; ++m)
#pragma unroll
                for (int n = 0; n < 2; ++n) acc[a][b][m][n] = (f32x4){0.f, 0.f, 0.f, 0.f};
    bf16x8 At[4][2], B0[2][2], B1[2][2];
    const char* cA = (const char*)g.A + (size_t)cur.pm * tstep; const char* cB = (const char*)g.Bt + (size_t)cur.pn * (cur.hf ? hstep : tstep);
    S.a_ready(cur);
    if constexpr (SP2) {
        PG8_STAGE(PG8_SB(0, 0), cB, voffB); PG8_STAGE(PG8_SB(0, 1), cB + hstep, voffB); PG8_STAGE(PG8_SA(0, 0), cA, voffA); PG8_STAGE(PG8_SA(0, 1), cA + hstep, voffA);
        if (wr == 1) PG8_BAR;
        PG8_WAIT_V(2); PG8_BAR;
        PG8_STAGE(PG8_SB(1, 0), cB + kstep, voffB); PG8_STAGE(PG8_SA(1, 0), cA + kstep, voffA); PG8_STAGE(PG8_SB(1, 1), cB + hstep + kstep, voffB);
        PG8_WAIT_V(6); PG8_BAR;
    } else {
        PG8_STAGE(PG8_SB(0, 0), cB, voffB); PG8_STAGE(PG8_SA(0, 0), cA, voffA); PG8_STAGE(PG8_SB(0, 1), cB + hstep, voffB); PG8_STAGE(PG8_SA(0, 1), cA + hstep, voffA);
        if (wr == 1) PG8_BAR;
        PG8_WAIT_V(4); PG8_BAR;
        PG8_STAGE(PG8_SB(1, 0), cB + kstep, voffB); PG8_STAGE(PG8_SA(1, 0), cA + kstep, voffA); PG8_STAGE(PG8_SB(1, 1), cB + hstep + kstep, voffB);
        PG8_WAIT_V(6); PG8_BAR;
    }
    for (;;) {
        const bool has_next = S.next(ui + 1, nxt);
        const char* nA = has_next ? (const char*)g.A + (size_t)nxt.pm * tstep : cA; const char* nB = has_next ? (const char*)g.Bt + (size_t)nxt.pn * (nxt.hf ? hstep : tstep) : cB;
        const bool fullu = cur.hf == 0;
        if (fullu) {
        for (int t = 0; t < nt; t += 2) {
            const bool last = (t == nt - 2);
            const char* a1 = cA + (size_t)(t + 1) * kstep;
            const char* a2 = last ? nA : cA + (size_t)(t + 2) * kstep; const char* b2 = last ? nB : cB + (size_t)(t + 2) * kstep;
            const char* a3 = a2 + kstep; const char* b3 = b2 + kstep;
            if (last && has_next) S.a_ready(nxt);
            if constexpr (SP2) {
            PG8_LDB(B0, 0, 0); PG8_LDB(B1, 0, 1); PG8_SCHED; PG8_LDA(At, 0, 0); PG8_STAGE(PG8_SA(1, 1), a1 + hstep, voffA);
            PG8_WAIT_V(8); PG8_WAIT_L(0); PG8_BAR; PG8_MMA(0, 0, At, B0); PG8_MMA(0, 1, At, B1); PG8_BAR; PG8_SCHED;
            PG8_LDA(At, 0, 1); PG8_STAGE(PG8_SB(0, 0), b2, voffB); PG8_STAGE(PG8_SB(0, 1), b2 + hstep, voffB); PG8_STAGE(PG8_SA(0, 0), a2, voffA);
            PG8_WAIT_V(8); PG8_WAIT_L(0); PG8_BAR; PG8_MMA(1, 0, At, B0); PG8_MMA(1, 1, At, B1); PG8_BAR; PG8_SCHED;
            PG8_LDB(B0, 1, 0); PG8_LDB(B1, 1, 1); PG8_SCHED; PG8_LDA(At, 1, 0); PG8_STAGE(PG8_SA(0, 1), a2 + hstep, voffA);
            PG8_WAIT_V(8); PG8_WAIT_L(0); PG8_BAR; PG8_MMA(0, 0, At, B0); PG8_MMA(0, 1, At, B1); PG8_BAR; PG8_SCHED;
            PG8_LDA(At, 1, 1); PG8_STAGE(PG8_SB(1, 0), b3, voffB); PG8_STAGE(PG8_SB(1, 1), b3 + hstep, voffB); PG8_STAGE(PG8_SA(1, 0), a3, voffA);
            PG8_WAIT_V(8); PG8_WAIT_L(0); PG8_BAR; PG8_MMA(1, 0, At, B0); PG8_MMA(1, 1, At, B1); PG8_BAR; PG8_SCHED;
            } else {
            PG8_LDB(B0, 0, 0); PG8_SCHED; PG8_LDA(At, 0, 0); PG8_STAGE(PG8_SA(1, 1), a1 + hstep, voffA);
            PG8_WAIT_L(8); PG8_BAR; PG8_WAIT_L(0); PG8_MMA(0, 0, At, B0); PG8_BAR; PG8_SCHED;
            PG8_LDB(B1, 0, 1); PG8_STAGE(PG8_SB(0, 0), b2, voffB);
            PG8_BAR; PG8_WAIT_L(0); PG8_MMA(0, 1, At, B1); PG8_BAR;
            PG8_LDA(At, 0, 1); PG8_STAGE(PG8_SA(0, 0), a2, voffA);
            PG8_BAR; PG8_WAIT_L(0); PG8_MMA(1, 0, At, B0); PG8_BAR; PG8_SCHED;
            PG8_STAGE(PG8_SB(0, 1), b2 + hstep, voffB);
            PG8_WAIT_V(6); PG8_BAR; PG8_MMA(1, 1, At, B1); PG8_BAR;
            PG8_LDB(B0, 1, 0); PG8_SCHED; PG8_LDA(At, 1, 0); PG8_STAGE(PG8_SA(0, 1), a2 + hstep, voffA);
            PG8_WAIT_L(8); PG8_BAR; PG8_WAIT_L(0); PG8_MMA(0, 0, At, B0); PG8_BAR; PG8_SCHED;
            PG8_LDB(B1, 1, 1); PG8_STAGE(PG8_SB(1, 0), b3, voffB);
            PG8_BAR; PG8_WAIT_L(0); PG8_MMA(0, 1, At, B1); PG8_BAR;
            PG8_LDA(At, 1, 1); PG8_STAGE(PG8_SA(1, 0), a3, voffA);
            PG8_BAR; PG8_WAIT_L(0); PG8_MMA(1, 0, At, B0); PG8_BAR; PG8_SCHED;
            PG8_STAGE(PG8_SB(1, 1), b3 + hstep, voffB);
            PG8_WAIT_V(6); PG8_BAR; PG8_MMA(1, 1, At, B1); PG8_BAR;
            }
        }
        } else {
        for (int t = 0; t < nt; t += 2) {
            const bool last = (t == nt - 2);
            const char* a1 = cA + (size_t)(t + 1) * kstep;
            const char* a2 = last ? nA : cA + (size_t)(t + 2) * kstep; const char* b2 = last ? nB : cB + (size_t)(t + 2) * kstep;
            const char* a3 = a2 + kstep; const char* b3 = b2 + kstep;
            if (last && has_next) S.a_ready(nxt);
            if constexpr (SP2) {
            PG8_LDB(B0, 0, 0); PG8_LDB(B1, 0, 1); PG8_SCHED; PG8_LDA(At, 0, 0); PG8_STAGE(PG8_SA(1, 1), a1 + hstep, voffA);
            PG8_WAIT_V(8); PG8_WAIT_L(0); PG8_BAR; PG8_MMA(0, 0, At, B0);  PG8_BAR; PG8_SCHED;
            PG8_LDA(At, 0, 1); PG8_STAGE(PG8_SB(0, 0), b2, voffB); PG8_STAGE(PG8_SB(0, 1), b2 + hstep, voffB); PG8_STAGE(PG8_SA(0, 0), a2, voffA);
            PG8_WAIT_V(8); PG8_WAIT_L(0); PG8_BAR; PG8_MMA(1, 0, At, B0);  PG8_BAR; PG8_SCHED;
            PG8_LDB(B0, 1, 0); PG8_LDB(B1, 1, 1); PG8_SCHED; PG8_LDA(At, 1, 0); PG8_STAGE(PG8_SA(0, 1), a2 + hstep, voffA);
            PG8_WAIT_V(8); PG8_WAIT_L(0); PG8_BAR; PG8_MMA(0, 0, At, B0);  PG8_BAR; PG8_SCHED;
            PG8_LDA(At, 1, 1); PG8_STAGE(PG8_SB(1, 0), b3, voffB); PG8_STAGE(PG8_SB(1, 1), b3 + hstep, voffB); PG8_STAGE(PG8_SA(1, 0), a3, voffA);
            PG8_WAIT_V(8); PG8_WAIT_L(0); PG8_BAR; PG8_MMA(1, 0, At, B0);  PG8_BAR; PG8_SCHED;
            } else {
            PG8_LDB(B0, 0, 0); PG8_SCHED; PG8_LDA(At, 0, 0); PG8_STAGE(PG8_SA(1, 1), a1 + hstep, voffA);
            PG8_WAIT_L(8); PG8_BAR; PG8_WAIT_L(0); PG8_MMA(0, 0, At, B0); PG8_BAR; PG8_SCHED;
            PG8_LDB(B1, 0, 1); PG8_STAGE(PG8_SB(0, 0), b2, voffB);
            PG8_BAR; PG8_WAIT_L(0); PG8_MMA(0, 1, At, B1); PG8_BAR;
            PG8_LDA(At, 0, 1); PG8_STAGE(PG8_SA(0, 0), a2, voffA);
            PG8_BAR; PG8_WAIT_L(0); PG8_MMA(1, 0, At, B0); PG8_BAR; PG8_SCHED;
            PG8_STAGE(PG8_SB(0, 1), b2 + hstep, voffB);
            PG8_WAIT_V(6); PG8_BAR; PG8_MMA(1, 1, At, B1); PG8_BAR;
            PG8_LDB(B0, 1, 0); PG8_SCHED; PG8_LDA(At, 1, 0); PG8_STAGE(PG8_SA(0, 1), a2 + hstep, voffA);
            PG8_WAIT_L(8); PG8_BAR; PG8_WAIT_L(0); PG8_MMA(0, 0, At, B0); PG8_BAR; PG8_SCHED;
            PG8_LDB(B1, 1, 1); PG8_STAGE(PG8_SB(1, 0), b3, voffB);
            PG8_BAR; PG8_WAIT_L(0); PG8_MMA(0, 1, At, B1); PG8_BAR;
            PG8_LDA(At, 1, 1); PG8_STAGE(PG8_SA(1, 0), a3, voffA);
            PG8_BAR; PG8_WAIT_L(0); PG8_MMA(1, 0, At, B0); PG8_BAR; PG8_SCHED;
            PG8_STAGE(PG8_SB(1, 1), b3 + hstep, voffB);
            PG8_WAIT_V(6); PG8_BAR; PG8_MMA(1, 1, At, B1); PG8_BAR;
            }
        }
        }
        if constexpr (ALIGN_EPI) { if (wr == 0) PG8_BAR; }
        if constexpr (!Epi::AFTER_DRAIN) { E(acc, cur, wr, wc, fr, fq); S.done(cur); }
        if (!has_next) break;
#pragma unroll
        for (int a = 0; a < 2; ++a)
#pragma unroll
            for (int b = 0; b < 2; ++b)
#pragma unroll
                for (int m = 0; m < 4; ++m)
#pragma unroll
                    for (int n = 0; n < 2; ++n) acc[a][b][m][n] = (f32x4){0.f, 0.f, 0.f, 0.f};
        cur = nxt; cA = nA; cB = nB; ++ui;
        if constexpr (ALIGN_EPI) { if (wr == 1) PG8_BAR; }
    }
    PG8_WAIT_V(0);
    if constexpr (!ALIGN_EPI) { if (wr == 0) PG8_BAR; }
    PG8_BAR;
    if constexpr (Epi::AFTER_DRAIN) { E.fused(acc, cur, wr, wc, fr, fq, lds, wid, lane); S.done(cur); }
#undef PG8_SA
#undef PG8_SB
#undef PG8_STAGE
#undef PG8_LDA
#undef PG8_LDB
#undef PG8_MMA
#undef PG8_WAIT_V
#undef PG8_WAIT_L
#undef PG8_BAR
#undef PG8_SCHED
}
}
namespace attn {
using bf16 = __hip_bfloat16;
constexpr int   D = 128, NW = 8, QBLK = 32, KVBLK = 64;
constexpr float SCALE = 0.088388347648318440f;
constexpr float THR = 8.f;
constexpr int SDEPTH = 2;
constexpr int LDQ = 1024, LDK = 128, LDO = 1024;
constexpr size_t SHM_V = KVBLK * D * 2, SHM_K = KVBLK * D * 2, SHM_ATTN = 2 * SHM_V + 2 * SHM_K + NW * 64 * 4;
using bf16x8 = __attribute__((ext_vector_type(8))) short;
using s16x4  = __attribute__((ext_vector_type(4))) short;
using f32x16 = __attribute__((ext_vector_type(16))) float;
using f32x8  = __attribute__((ext_vector_type(8))) float;
using u32x4  = __attribute__((ext_vector_type(4))) unsigned;
#define KSWZ(row, colB) ((row) * 256 + ((colB) ^ (((row) & 7) << 4)))
#define SBAR() __builtin_amdgcn_sched_barrier(0)
__device__ __forceinline__ int crow(int r, int hi) { return (r & 3) + 8 * (r >> 2) + 4 * hi; }
__device__ __forceinline__ unsigned cvtpk(float lo, float hi) {
  unsigned r; asm volatile("v_cvt_pk_bf16_f32 %0, %1, %2" : "=v"(r) : "v"(lo), "v"(hi)); return r;
}
template <typename TIn> struct Stage;
template <> struct Stage<bf16>  { using T = bf16x8;
  __device__ static __forceinline__ T ld8(const bf16* p) { return *reinterpret_cast<const bf16x8*>(p); }
  __device__ static __forceinline__ bf16x8 tobf(T x) { return x; } };
template <> struct Stage<float> { using T = f32x8;
  __device__ static __forceinline__ T ld8(const float* p) { return *reinterpret_cast<const f32x8*>(p); }
  __device__ static __forceinline__ bf16x8 tobf(T x) {
    u32x4 w = {cvtpk(x[0], x[1]), cvtpk(x[2], x[3]), cvtpk(x[4], x[5]), cvtpk(x[6], x[7])}; return *reinterpret_cast<bf16x8*>(&w); } };

__device__ __forceinline__ void partialSM(f32x16& p0, f32x16& p1, float& m_reg, float& mn, float& alpha) {
  constexpr float C = SCALE * 1.4426950408889634f;
  float pmax = p0[0]; for (int r = 1; r < 16; ++r) pmax = fmaxf(pmax, p0[r]); for (int r = 0; r < 16; ++r) pmax = fmaxf(pmax, p1[r]);
  { auto rr = __builtin_amdgcn_permlane32_swap(__float_as_uint(pmax), __float_as_uint(pmax), false, false);
    pmax = fmaxf(__uint_as_float(rr[0]), __uint_as_float(rr[1])); }
  if (__builtin_expect(__all(pmax - m_reg <= THR / SCALE), 1)) { mn = m_reg; alpha = 1.f; }
  else { mn = fmaxf(m_reg, pmax); alpha = __builtin_amdgcn_exp2f((m_reg - mn) * C); m_reg = mn; }
  float mnC = -mn * C;
  for (int r = 0; r < 16; ++r) p0[r] = fmaf(p0[r], C, mnC); for (int r = 0; r < 16; ++r) p1[r] = fmaf(p1[r], C, mnC);
  for (int r = 0; r < 16; ++r) p0[r] = __builtin_amdgcn_exp2f(p0[r]);
}
__device__ __forceinline__ void finishSM(f32x16& p0, f32x16& p1, float alpha, float& l_reg, bf16x8& pa0, bf16x8& pa1, bf16x8& pa2, bf16x8& pa3) {
  for (int r = 0; r < 16; ++r) p1[r] = __builtin_amdgcn_exp2f(p1[r]);
  float ps = 0; for (int r = 0; r < 16; ++r) ps += p0[r]; for (int r = 0; r < 16; ++r) ps += p1[r];
  { auto rr = __builtin_amdgcn_permlane32_swap(__float_as_uint(ps), __float_as_uint(ps), false, false);
    ps = __uint_as_float(rr[0]) + __uint_as_float(rr[1]); }
  l_reg = l_reg * alpha + ps;
#define PK4(P, BASE, OUT) do { unsigned a0 = cvtpk(P[BASE + 0], P[BASE + 1]), a1 = cvtpk(P[BASE + 2], P[BASE + 3]);   \
    unsigned b0 = cvtpk(P[BASE + 4], P[BASE + 5]), b1 = cvtpk(P[BASE + 6], P[BASE + 7]);                              \
    auto r0 = __builtin_amdgcn_permlane32_swap(a0, b0, false, false); auto r1 = __builtin_amdgcn_permlane32_swap(a1, b1, false, false); \
    u32x4 w = {r0[0], r1[0], r0[1], r1[1]}; OUT = *reinterpret_cast<bf16x8*>(&w); } while (0)
  PK4(p0, 0, pa0); PK4(p0, 8, pa1); PK4(p1, 0, pa2); PK4(p1, 8, pa3);
#undef PK4
}
__device__ __forceinline__ void qkt(f32x16& p0, f32x16& p1, const bf16* Ks, const bf16x8* qr, int r32, int hi) {
  p0 = f32x16{}; p1 = f32x16{};
  for (int d0 = 0; d0 < 8; ++d0) { int cb = (d0 * 16 + hi * 8) * 2;
    bf16x8 b0 = *reinterpret_cast<const bf16x8*>((const char*)Ks + KSWZ(r32, cb));
    bf16x8 b1 = *reinterpret_cast<const bf16x8*>((const char*)Ks + KSWZ(32 + r32, cb));
    p0 = __builtin_amdgcn_mfma_f32_32x32x16_bf16(b0, qr[d0], p0, 0, 0, 0);
    p1 = __builtin_amdgcn_mfma_f32_32x32x16_bf16(b1, qr[d0], p1, 0, 0, 0); }
}
__device__ __forceinline__ int v_st(int k, int c) { const int kk = (k & ~0xC) | ((k & 4) << 1) | ((k & 8) >> 1); return ((kk >> 3) * 4 + (c >> 5)) * 512 + ((kk & 7) * 32 + (c & 31)) * 2; }
__device__ __forceinline__ int v_rd_base(int lane) { return ((lane & 3) << 3) | (((lane >> 2) & 3) << 6) | (((lane >> 4) & 1) << 5) | (((lane >> 5) & 1) << 8); }
constexpr int v_rd_off(int d0, int ks, int half) { return d0 * 512 + ks * 4096 + half * 2048; }
template <int OFF> __device__ __forceinline__ s16x4 tr_read(int vb) {
  s16x4 r; asm volatile("ds_read_b64_tr_b16 %0, %1 offset:%2" : "=&v"(r) : "v"(vb), "i"(OFF) : "memory"); return r;
}
template <int D0> __device__ __forceinline__ void pv_one(f32x16& od, int vb, bf16x8 pa0, bf16x8 pa1, bf16x8 pa2, bf16x8 pa3) {
  const s16x4 l0 = tr_read<v_rd_off(D0, 0, 0)>(vb), h0 = tr_read<v_rd_off(D0, 0, 1)>(vb), l1 = tr_read<v_rd_off(D0, 1, 0)>(vb), h1 = tr_read<v_rd_off(D0, 1, 1)>(vb);
  const s16x4 l2 = tr_read<v_rd_off(D0, 2, 0)>(vb), h2 = tr_read<v_rd_off(D0, 2, 1)>(vb), l3 = tr_read<v_rd_off(D0, 3, 0)>(vb), h3 = tr_read<v_rd_off(D0, 3, 1)>(vb);
  asm volatile("s_waitcnt lgkmcnt(0)" ::: "memory"); SBAR();
#define PK(L, H) (bf16x8){L[0], L[1], L[2], L[3], H[0], H[1], H[2], H[3]}
  od = __builtin_amdgcn_mfma_f32_32x32x16_bf16(pa0, PK(l0, h0), od, 0, 0, 0);
  od = __builtin_amdgcn_mfma_f32_32x32x16_bf16(pa1, PK(l1, h1), od, 0, 0, 0);
  od = __builtin_amdgcn_mfma_f32_32x32x16_bf16(pa2, PK(l2, h2), od, 0, 0, 0);
  od = __builtin_amdgcn_mfma_f32_32x32x16_bf16(pa3, PK(l3, h3), od, 0, 0, 0);
#undef PK
}
__device__ __forceinline__ void pv_d0(f32x16* o, int vb, bf16x8 pa0, bf16x8 pa1, bf16x8 pa2, bf16x8 pa3) {
  pv_one<0>(o[0], vb, pa0, pa1, pa2, pa3); pv_one<1>(o[1], vb, pa0, pa1, pa2, pa3); pv_one<2>(o[2], vb, pa0, pa1, pa2, pa3); pv_one<3>(o[3], vb, pa0, pa1, pa2, pa3);
}

template <typename TQ>
__device__ __forceinline__ void attn_dense_body(const TQ* __restrict__ Qb, const bf16* __restrict__ Kh, const bf16* __restrict__ Vh,
                                                bf16* __restrict__ Ob, int seq, char* lds) {
  using St = Stage<bf16>; using SQ = Stage<TQ>;
  const int tid = threadIdx.x, wid = tid >> 6, lane = tid & 63, r32 = lane & 31, hi = lane >> 5;
  bf16* V_lds = (bf16*)lds; bf16* K_lds = (bf16*)(lds + 2 * SHM_V);
  float* ws = (float*)(lds + 2 * SHM_V + 2 * SHM_K) + wid * 64; float* li_l = ws; float* al_l = ws + 32;
  float m_reg = -1e30f, l_reg = 0; f32x16 o[4] = {}; bf16x8 qr[8];
  const TQ* Qw = Qb + (long)(wid * QBLK + r32) * LDQ + hi * 8;
#pragma unroll
  for (int d0 = 0; d0 < 8; ++d0) qr[d0] = SQ::tobf(SQ::ld8(Qw + d0 * 16));
  const int sr = tid >> 4, sc = (tid & 15) * 8, vst0 = v_st(sr, sc), vst1 = v_st(32 + sr, sc);
  const int vb0 = (int)(uintptr_t)V_lds + v_rd_base(lane);
  struct { typename St::T vs0, vs1, ks0, ks1; } sr_[SDEPTH];
#define SLOAD(i, k0) do { sr_[i].vs0 = St::ld8(&Vh[(long)((k0) + sr) * LDK + sc]); sr_[i].vs1 = St::ld8(&Vh[(long)((k0) + 32 + sr) * LDK + sc]); \
    sr_[i].ks0 = St::ld8(&Kh[(long)((k0) + sr) * LDK + sc]); sr_[i].ks1 = St::ld8(&Kh[(long)((k0) + 32 + sr) * LDK + sc]); } while (0)
#define SWRITE(b, i) do { *(bf16x8*)((char*)V_lds + (b) * SHM_V + vst0) = St::tobf(sr_[i].vs0);          \
    *(bf16x8*)((char*)V_lds + (b) * SHM_V + vst1) = St::tobf(sr_[i].vs1); int kc = sc * 2;               \
    *(bf16x8*)((char*)K_lds + (b) * SHM_K + KSWZ(sr, kc)) = St::tobf(sr_[i].ks0);                       \
    *(bf16x8*)((char*)K_lds + (b) * SHM_K + KSWZ(32 + sr, kc)) = St::tobf(sr_[i].ks1); } while (0)
#define SWAIT() do { if constexpr (SDEPTH == 2) asm volatile("s_waitcnt vmcnt(4)" ::: "memory"); else asm volatile("s_waitcnt vmcnt(0)" ::: "memory"); } while (0)
#define RESC(a) do { if (__any((a) < 1.f)) { if (hi == 0) al_l[r32] = (a); asm volatile("s_waitcnt lgkmcnt(0)" ::: "memory"); \
    for (int d = 0; d < 4; ++d) for (int r = 0; r < 16; ++r) o[d][r] *= al_l[crow(r, hi)]; } } while (0)
  f32x16 pA0, pA1, pB0, pB1; float mnA, mnB, alA, alB; bf16x8 pa0, pa1, pa2, pa3; const int NT = seq / KVBLK;
  constexpr int SE = 0, SO = SDEPTH - 1;
  SLOAD(SE, 0); asm volatile("s_waitcnt vmcnt(0)" ::: "memory"); SWRITE(0, SE); __syncthreads();
  qkt(pA0, pA1, K_lds, qr, r32, hi); partialSM(pA0, pA1, m_reg, mnA, alA);
  SLOAD(SO, KVBLK); if constexpr (SDEPTH == 2) { if (2 < NT) SLOAD(SE, 2 * KVBLK); }
  SWAIT(); SWRITE(1, SO); __syncthreads();
  for (int j = 1; j + 1 < NT; j += 2) {
    SBAR(); qkt(pB0, pB1, (bf16*)((char*)K_lds + SHM_K), qr, r32, hi);
    finishSM(pA0, pA1, alA, l_reg, pa0, pa1, pa2, pa3); SBAR();
    SLOAD(SO, (j + SDEPTH) * KVBLK); SBAR();
    pv_d0(o, vb0, pa0, pa1, pa2, pa3); partialSM(pB0, pB1, m_reg, mnB, alB);
    __syncthreads(); SWAIT(); SWRITE(0, SE);
    RESC(alB); __syncthreads();
    SBAR(); qkt(pA0, pA1, K_lds, qr, r32, hi);
    finishSM(pB0, pB1, alB, l_reg, pa0, pa1, pa2, pa3); SBAR();
    if (SDEPTH == 1 || j + 3 < NT) SLOAD(SE, (j + 1 + SDEPTH) * KVBLK); SBAR();
    pv_d0(o, vb0 + (int)SHM_V, pa0, pa1, pa2, pa3); partialSM(pA0, pA1, m_reg, mnA, alA);
    __syncthreads(); SWAIT(); SWRITE(1, SO);
    RESC(alA); __syncthreads();
  }
  SBAR(); qkt(pB0, pB1, (bf16*)((char*)K_lds + SHM_K), qr, r32, hi);
  finishSM(pA0, pA1, alA, l_reg, pa0, pa1, pa2, pa3); SBAR();
  pv_d0(o, vb0, pa0, pa1, pa2, pa3); partialSM(pB0, pB1, m_reg, mnB, alB);
  __syncthreads(); RESC(alB);
  finishSM(pB0, pB1, alB, l_reg, pa0, pa1, pa2, pa3); SBAR();
  pv_d0(o, vb0 + (int)SHM_V, pa0, pa1, pa2, pa3);
  if (hi == 0) li_l[r32] = l_reg; asm volatile("s_waitcnt lgkmcnt(0)" ::: "memory");
  float rli[16];
#pragma unroll
  for (int r = 0; r < 16; ++r) rli[r] = __builtin_amdgcn_rcpf(li_l[crow(r, hi)]);
  bf16* Ow = Ob + (long)(wid * QBLK) * LDO;
#pragma unroll
  for (int r = 0; r < 16; ++r) { int orow = crow(r, hi);
    for (int d0 = 0; d0 < 4; ++d0) Ow[(long)orow * LDO + d0 * 32 + r32] = __float2bfloat16(o[d0][r] * rli[r]); }
#undef SLOAD
#undef SWRITE
#undef SWAIT
#undef RESC
}
}
#define LAS __attribute__((address_space(3)))
typedef __hip_bfloat16 bf16;
typedef float f32x4v __attribute__((ext_vector_type(4)));
typedef unsigned u32x4v __attribute__((ext_vector_type(4)));
typedef unsigned u32x2v __attribute__((ext_vector_type(2)));
constexpr int DM = 1024, NCTX = 4096, NLAT = 16384, MTOK = NCTX + NLAT, DFF = 2816, NQKV = 1536, EVIN = 2048, LCTX = 256, LLAT = 4096, PAST = 512, SKV = PAST + LLAT;
constexpr float EPS = 1e-6f;
constexpr size_t MiB = 1u << 20;
constexpr size_t WS_MODS = 0;
constexpr size_t WS_GP = 256 * 1024, WS_SWF1 = 384 * 1024, WS_SWQKV = 640 * 1024, WS_SS = 672 * 1024;
constexpr size_t WS_WIN = 1 * MiB, WS_WOUT = 5 * MiB, WS_WQKV = 7 * MiB, WS_WO = 10 * MiB, WS_WF1 = 12 * MiB, WF1_STRIDE = 11 * MiB, WS_WF2 = 34 * MiB, WF2_STRIDE = (size_t)DM * DFF * 2;
constexpr size_t WS_H = 46 * MiB;
constexpr size_t WS_B = 86 * MiB;
constexpr size_t WS_P = WS_B, WS_MX = WS_B + 80 * MiB;
constexpr size_t WS_ACT = WS_B;
constexpr size_t WS_O = WS_B;
constexpr size_t WS_QKV = WS_B, WS_Q = WS_B + 60 * MiB, WS_KLAT = WS_B + 100 * MiB, WS_VLAT = WS_B + 109 * MiB, WS_KCTX = WS_B + 118 * MiB, WS_VCTX = WS_B + 120 * MiB;
constexpr size_t WS_XB = 208 * MiB, WS_END = 248 * MiB;
constexpr size_t WS_BAR = 992 * 1024, WS_ZERO_BEGIN = WS_SS, WS_ZERO_BYTES = 1 * MiB - WS_SS;
constexpr int LDS_BYTES = 135168;
constexpr int NPHASE = 14;

struct Params { const float* in[22]; float* out; unsigned char* ws; int ph_lo, ph_hi; };

__device__ __forceinline__ float wave_sum(float v) {
#pragma unroll
    for (int o = 1; o < 64; o <<= 1) v += __shfl_xor(v, o);
    return v;
}
__device__ __forceinline__ unsigned f2bf(float f) { unsigned u = __builtin_bit_cast(unsigned, f); return (u + 0x7fffu + ((u >> 16) & 1u)) >> 16; }
__device__ __forceinline__ unsigned pk2(float lo, float hi) { return f2bf(lo) | (f2bf(hi) << 16); }
__device__ __forceinline__ float bf_lo(unsigned w) { return __builtin_bit_cast(float, w << 16); }
__device__ __forceinline__ float bf_hi(unsigned w) { return __builtin_bit_cast(float, w & 0xffff0000u); }
__device__ __forceinline__ float bf1(unsigned short h) { return __builtin_bit_cast(float, (unsigned)h << 16); }

__device__ __forceinline__ void ld8f(const unsigned short* ptr, float* f) { const u32x4v w = *(const u32x4v*)ptr; f[0] = bf_lo(w.x); f[1] = bf_hi(w.x); f[2] = bf_lo(w.y); f[3] = bf_hi(w.y); f[4] = bf_lo(w.z); f[5] = bf_hi(w.z); f[6] = bf_lo(w.w); f[7] = bf_hi(w.w); }
__device__ __forceinline__ void transpose_item(const float* W, int N, int k0, int n0, unsigned short* WT, int ldk, int dst_row0, int dst_k0, LAS float* scr, int lane) {
    float tv[32];
#pragma unroll
    for (int i = 0; i < 32; ++i) tv[i] = W[(size_t)(k0 + 2 * i + (lane >> 5)) * N + n0 + (lane & 31)];
#pragma unroll
    for (int i = 0; i < 32; ++i) scr[(2 * i + (lane >> 5)) * 33 + (lane & 31)] = tv[i];
    asm volatile("s_waitcnt lgkmcnt(0)" ::: "memory");
    const int c = lane & 7;
#pragma unroll
    for (int j = 0; j < 4; ++j) { const int n = (lane >> 3) + 8 * j; const LAS float* s = scr + (8 * c) * 33 + n;
        u32x4v o; o.x = pk2(s[0 * 33], s[1 * 33]); o.y = pk2(s[2 * 33], s[3 * 33]); o.z = pk2(s[4 * 33], s[5 * 33]); o.w = pk2(s[6 * 33], s[7 * 33]);
        *(u32x4v*)(WT + (size_t)(dst_row0 + n) * ldk + dst_k0 + k0 + 8 * c) = o; }
    asm volatile("s_waitcnt lgkmcnt(0)" ::: "memory");
}

__device__ __forceinline__ void phase_prep(const Params& p, LAS unsigned char* lds, int tid, int lane, int wave) {
    unsigned char* ws = p.ws;
    {
        LAS float* sc = (LAS float*)lds;
        LAS float* red = (LAS float*)(lds + 20480);
        const float* cl = p.in[4]; const float* cctx = p.in[5]; const float* w_ada = p.in[6]; const float* b_ada = p.in[7];
        float* mods = (float*)(ws + WS_MODS);
        if ((int)blockIdx.x < 192) {
            for (int idx = tid; idx < 5 * 1024; idx += 512) { const int j = idx >> 10, k = idx & 1023; const float v = j == 0 ? cctx[k] : cl[(j - 1) * 1024 + k]; sc[idx] = v / (1.0f + __expf(-v)); }
            __syncthreads();
            for (int item = blockIdx.x; item < 192; item += gridDim.x) {
                const int l = item / 96, n0 = (item % 96) * 64;
                float a0 = 0.f, a1 = 0.f, a2 = 0.f, a3 = 0.f, a4 = 0.f;
                const float* wp = w_ada + ((size_t)l * 1024 + wave * 128) * 6144 + n0 + lane;
#pragma unroll 16
                for (int k = 0; k < 128; ++k) { const float wv = wp[(size_t)k * 6144]; const int kk = wave * 128 + k;
                    a0 += sc[kk] * wv; a1 += sc[1024 + kk] * wv; a2 += sc[2048 + kk] * wv; a3 += sc[3072 + kk] * wv; a4 += sc[4096 + kk] * wv; }
                red[(wave * 5 + 0) * 64 + lane] = a0; red[(wave * 5 + 1) * 64 + lane] = a1; red[(wave * 5 + 2) * 64 + lane] = a2; red[(wave * 5 + 3) * 64 + lane] = a3; red[(wave * 5 + 4) * 64 + lane] = a4;
                __syncthreads();
                if (tid < 320) { const int j = tid >> 6, ln = tid & 63; float s = b_ada[l * 6144 + n0 + ln];
#pragma unroll
                    for (int w = 0; w < 8; ++w) s += red[(w * 5 + j) * 64 + ln];
                    mods[(size_t)(l * 5 + j) * 6144 + n0 + ln] = s; }
                __syncthreads();
            }
        }
    }
    {
        LAS float* scr = (LAS float*)(lds + 32768 + wave * 8704);
        const int gw = blockIdx.x * 8 + wave, NGW = gridDim.x * 8;
        constexpr int I_IN = 16 * 64, I_QKV = 16 * 48, I_O = 16 * 32, I_OUT = 8 * 32, I_F1 = 16 * 176, I_F2 = 44 * 32, I_FOLD = 1024;
        constexpr int NITEMS = I_IN + I_QKV + I_O + I_OUT + 2 * I_F1 + 2 * I_F2 + I_FOLD;
        for (int it = gw; it < NITEMS; it += NGW) {
            int r = it;
            if (r < I_IN) { const int kb = r / 64, nb = r % 64; transpose_item(p.in[9], EVIN, kb * 64, nb * 32, (unsigned short*)(ws + WS_WIN), 1024, nb * 32, 0, scr, lane); continue; } r -= I_IN;
            if (r < I_QKV) { const int kb = r / 48, nb = r % 48; transpose_item(p.in[15], NQKV, kb * 64, nb * 32, (unsigned short*)(ws + WS_WQKV), 1024, nb * 32, 0, scr, lane); continue; } r -= I_QKV;
            if (r < I_O) { const int kb = r / 32, nb = r % 32; transpose_item(p.in[18], DM, kb * 64, nb * 32, (unsigned short*)(ws + WS_WO), 1024, nb * 32, 0, scr, lane); continue; } r -= I_O;
            if (r < I_OUT) { const int kb = r / 32, nb = r % 32; transpose_item(p.in[14] + (size_t)512 * 1024, DM, kb * 64, nb * 32, (unsigned short*)(ws + WS_WOUT), 1024, nb * 32, 512, scr, lane); continue; } r -= I_OUT;
            if (r < 2 * I_F1) { const int l = r / I_F1, q = r % I_F1, kb = q / 176, nb = q % 176, n0 = nb * 32;
                const int part = n0 >= DFF, jj = n0 - part * DFF, drow = (jj >> 7) * 256 + part * 128 + (jj & 127);
                transpose_item(p.in[19] + (size_t)l * DM * 2 * DFF, 2 * DFF, kb * 64, n0, (unsigned short*)(ws + WS_WF1 + l * WF1_STRIDE), 1024, drow, 0, scr, lane); continue; } r -= 2 * I_F1;
            if (r < 2 * I_F2) { const int l = r / I_F2, q = r % I_F2, kb = q / 32, nb = q % 32;
                transpose_item(p.in[20] + (size_t)l * DFF * DM, DM, kb * 64, nb * 32, (unsigned short*)(ws + WS_WF2 + l * WF2_STRIDE), DFF, nb * 32, 0, scr, lane); continue; } r -= 2 * I_F2;
            {
                const int g = r >> 8, cc = (r >> 4) & 15, nb = r & 15, n = nb * 64 + lane;
                const float* pw = p.in[10] + ((size_t)g * 128 + cc * 8) * 128; const float* psc = p.in[11] + g * 128; const float* wo = p.in[14] + (size_t)(g * 128) * 1024 + n;
                float a[8] = {0.f, 0.f, 0.f, 0.f, 0.f, 0.f, 0.f, 0.f};
                for (int d = 0; d < 128; ++d) { const float wv = psc[d] * wo[(size_t)d * 1024];
#pragma unroll
                    for (int c = 0; c < 8; ++c) a[c] += pw[c * 128 + d] * wv; }
                u32x4v o; o.x = pk2(a[0], a[1]); o.y = pk2(a[2], a[3]); o.z = pk2(a[4], a[5]); o.w = pk2(a[6], a[7]);
                *(u32x4v*)((unsigned short*)(ws + WS_WOUT) + (size_t)n * 1024 + g * 128 + cc * 8) = o;
            }
        }
    }
}

__device__ __forceinline__ void phase_p1(const Params& p, int tid, int lane, int wave) {
    unsigned char* ws = p.ws;
    const float* mods = (const float*)(ws + WS_MODS); const float* norm_g = p.in[8];
    const int gw = blockIdx.x * 8 + wave, NGW = gridDim.x * 8;
    {   float* gp = (float*)(ws + WS_GP);
        for (int idx = blockIdx.x * 512 + tid; idx < 3 * 5 * 1024; idx += gridDim.x * 512) { const int site = idx / 5120, j = (idx >> 10) % 5, c = idx & 1023, l = site >= 1, nrm = site != 1;
            gp[idx] = norm_g[(l * 2 + nrm) * 1024 + c] * (1.0f + mods[(size_t)(l * 5 + j) * 6144 + (nrm ? 4 : 1) * 1024 + c]); } }
#pragma unroll 1
    for (int site = 0; site < 3; ++site) {
        const int N = site == 1 ? NQKV : 2 * DFF, l = site >= 1, chunk = site == 1 ? 0 : 3;
        const unsigned short* Wt = (const unsigned short*)(ws + (site == 0 ? WS_WF1 : site == 1 ? WS_WQKV : WS_WF1 + WF1_STRIDE));
        float* dst = site == 1 ? (float*)(ws + WS_SWQKV) : (float*)(ws + WS_SWF1) + (site == 2) * 5 * 2 * DFF;
        if (gw < N) {
            float sh[5][16];
#pragma unroll
            for (int j = 0; j < 5; ++j) { const float* sp = mods + (size_t)(l * 5 + j) * 6144 + chunk * 1024 + 8 * lane;
#pragma unroll
                for (int q = 0; q < 4; ++q) { const f32x4v v = *(const f32x4v*)(sp + (q >> 1) * 512 + (q & 1) * 4); sh[j][4 * q] = v.x; sh[j][4 * q + 1] = v.y; sh[j][4 * q + 2] = v.z; sh[j][4 * q + 3] = v.w; } }
            for (int col = gw; col < N; col += NGW) {
                float f[16]; ld8f(Wt + (size_t)col * 1024 + 8 * lane, f); ld8f(Wt + (size_t)col * 1024 + 512 + 8 * lane, f + 8);
                float a[5];
#pragma unroll
                for (int j = 0; j < 5; ++j) { float s = 0.f;
#pragma unroll
                    for (int q = 0; q < 16; ++q) s += sh[j][q] * f[q];
                    a[j] = wave_sum(s); }
                if (lane == 0) {
#pragma unroll
                    for (int j = 0; j < 5; ++j) dst[(size_t)j * N + col] = a[j]; }
            }
        }
    }
    const float* xc = p.in[0]; const float* xl = p.in[1]; unsigned short* h = (unsigned short*)(ws + WS_H);
    for (int it = gw; it < MTOK / 4; it += NGW) {
        const int row0 = 4 * it, j = row0 < NCTX ? 0 : 1 + ((row0 - NCTX) >> 12);
        const float* shp = mods + (size_t)j * 6144; const float* scp = shp + 1024;
        f32x4v gm[4], sh[4];
#pragma unroll
        for (int q = 0; q < 4; ++q) { const int c = 4 * lane + 256 * q; gm[q] = *(const f32x4v*)(norm_g + c) * (*(const f32x4v*)(scp + c) + 1.0f); sh[q] = *(const f32x4v*)(shp + c); }
        const float* xr0 = row0 < NCTX ? xc + (size_t)row0 * DM : xl + (size_t)(row0 - NCTX) * DM;
        f32x4v v[4][4]; float ss[4];
#pragma unroll
        for (int rr = 0; rr < 4; ++rr)
#pragma unroll
            for (int q = 0; q < 4; ++q) v[rr][q] = *(const f32x4v*)(xr0 + (size_t)rr * DM + 4 * lane + 256 * q);
#pragma unroll
        for (int rr = 0; rr < 4; ++rr) { float s = 0.f;
#pragma unroll
            for (int q = 0; q < 4; ++q) s += (v[rr][q].x * v[rr][q].x + v[rr][q].y * v[rr][q].y) + (v[rr][q].z * v[rr][q].z + v[rr][q].w * v[rr][q].w);
            ss[rr] = s; }
#pragma unroll
        for (int rr = 0; rr < 4; ++rr) { const float rstd = __builtin_amdgcn_rsqf(wave_sum(ss[rr]) * (1.0f / DM) + EPS);
#pragma unroll
            for (int q = 0; q < 4; ++q) { const f32x4v o = (v[rr][q] * rstd) * gm[q] + sh[q];
                u32x2v w; w.x = pk2(o.x, o.y); w.y = pk2(o.z, o.w);
                *(u32x2v*)(h + (size_t)(row0 + rr) * DM + 4 * lane + 256 * q) = w; } }
    }
}
__device__ __forceinline__ void phase_final(const unsigned short* xb, float* y, const float* g, const float* ss, int lane, int wave) {
    const int gw = blockIdx.x * 8 + wave, NGW = gridDim.x * 8;
    f32x4v gg[4];
#pragma unroll
    for (int q = 0; q < 4; ++q) gg[q] = *(const f32x4v*)(g + 4 * lane + 256 * q);
    for (int it = gw; it < MTOK / 4; it += NGW) {
        u32x2v v[4][4]; float rs[4];
#pragma unroll
        for (int rr = 0; rr < 4; ++rr) { const int row = it + rr * (MTOK / 4); rs[rr] = __builtin_amdgcn_rsqf(ss[row] * (1.0f / DM) + EPS);
#pragma unroll
            for (int q = 0; q < 4; ++q) v[rr][q] = *(const u32x2v*)(xb + (size_t)row * DM + 4 * lane + 256 * q); }
#pragma unroll
        for (int rr = 0; rr < 4; ++rr) { const int row = it + rr * (MTOK / 4);
#pragma unroll
            for (int q = 0; q < 4; ++q) { const f32x4v x = {bf_lo(v[rr][q].x), bf_hi(v[rr][q].x), bf_lo(v[rr][q].y), bf_hi(v[rr][q].y)};
                *(f32x4v*)(y + (size_t)row * DM + 4 * lane + 256 * q) = (x * rs[rr]) * gg[q]; } }
    }
}
__device__ __forceinline__ void phase_mixer(const unsigned short* P, unsigned short* MX, const float* conv_w, const float* conv_b, int lane, int wave) {
    const int gw = blockIdx.x * 8 + wave, NGW = gridDim.x * 8;
    const int c0 = 8 * lane, half = 1 << (lane >> 4);
    for (int it = gw; it < 2 * (MTOK / 8); it += NGW) {
        const int type = it & 1, row0 = (it >> 1) * 8;
        int t0, L; if (row0 < NCTX) { t0 = row0 & (LCTX - 1); L = LCTX; } else { t0 = (row0 - NCTX) & (LLAT - 1); L = LLAT; }
        const unsigned short* pr = P + (size_t)row0 * EVIN;
        if (type == 0) {
            float S[8] = {0.f, 0.f, 0.f, 0.f, 0.f, 0.f, 0.f, 0.f}, f[8];
#pragma unroll
            for (int k = 0; k < 16; ++k) { const int s = t0 - half + k; const float wgt = (k < 2 * half && s >= 0 && s < L) ? 1.f : 0.f; const int sc = min(max(s, 0), L - 1);
                ld8f(pr + (ptrdiff_t)(sc - t0) * EVIN + c0, f);
#pragma unroll
                for (int i = 0; i < 8; ++i) S[i] += wgt * f[i]; }
#pragma unroll
            for (int r = 0; r < 8; ++r) { const int t = t0 + r; const int lo = max(t - half, 0), hi = min(t + half, L); const float inv = 1.0f / (float)(hi - lo);
                ld8f(pr + (size_t)r * EVIN + c0, f);
                u32x4v o; o.x = pk2(S[0] * inv - f[0], S[1] * inv - f[1]); o.y = pk2(S[2] * inv - f[2], S[3] * inv - f[3]); o.z = pk2(S[4] * inv - f[4], S[5] * inv - f[5]); o.w = pk2(S[6] * inv - f[6], S[7] * inv - f[7]);
                *(u32x4v*)(MX + (size_t)(row0 + r) * DM + c0) = o;
                if (r < 7) {
                    { const int s = t + half; const float wgt = s < L ? 1.f : 0.f; ld8f(pr + (ptrdiff_t)(min(s, L - 1) - t0) * EVIN + c0, f);
#pragma unroll
                      for (int i = 0; i < 8; ++i) S[i] += wgt * f[i]; }
                    { const int s = t - half; const float wgt = s >= 0 ? 1.f : 0.f; ld8f(pr + (ptrdiff_t)(max(s, 0) - t0) * EVIN + c0, f);
#pragma unroll
                      for (int i = 0; i < 8; ++i) S[i] -= wgt * f[i]; } } }
        } else {
            float cw0[8], cw1[8], cw2[8], cb[8];
#pragma unroll
            for (int i = 0; i < 8; ++i) { cw0[i] = conv_w[c0 + i]; cw1[i] = conv_w[512 + c0 + i]; cw2[i] = conv_w[1024 + c0 + i]; cb[i] = conv_b[c0 + i]; }
            float zp[8], zc[8], zn[8], a[8], b[8];
            if (t0 > 0) { ld8f(pr - EVIN + 1024 + c0, a); ld8f(pr - EVIN + 1536 + c0, b);
#pragma unroll
                for (int i = 0; i < 8; ++i) zp[i] = a[i] * b[i]; }
            else {
#pragma unroll
                for (int i = 0; i < 8; ++i) zp[i] = 0.f; }
            ld8f(pr + 1024 + c0, a); ld8f(pr + 1536 + c0, b);
#pragma unroll
            for (int i = 0; i < 8; ++i) zc[i] = a[i] * b[i];
#pragma unroll
            for (int r = 0; r < 8; ++r) { const int t = t0 + r;
                if (t + 1 < L) { ld8f(pr + (size_t)(r + 1) * EVIN + 1024 + c0, a); ld8f(pr + (size_t)(r + 1) * EVIN + 1536 + c0, b);
#pragma unroll
                    for (int i = 0; i < 8; ++i) zn[i] = a[i] * b[i]; }
                else {
#pragma unroll
                    for (int i = 0; i < 8; ++i) zn[i] = 0.f; }
                ld8f(pr + (size_t)r * EVIN + 512 + c0, a);
                float y[8];
#pragma unroll
                for (int i = 0; i < 8; ++i) y[i] = a[i] * (zp[i] * cw0[i] + zc[i] * cw1[i] + zn[i] * cw2[i] + cb[i]);
                u32x4v o; o.x = pk2(y[0], y[1]); o.y = pk2(y[2], y[3]); o.z = pk2(y[4], y[5]); o.w = pk2(y[6], y[7]);
                *(u32x4v*)(MX + (size_t)(row0 + r) * DM + 512 + c0) = o;
#pragma unroll
                for (int i = 0; i < 8; ++i) { zp[i] = zc[i]; zc[i] = zn[i]; } }
        }
    }
}
__device__ __forceinline__ void phase_qknorm(const Params& p, int lane, int wave) {
    unsigned char* ws = p.ws;
    const unsigned short* QKV = (const unsigned short*)(ws + WS_QKV);
    unsigned short* Q = (unsigned short*)(ws + WS_Q); unsigned short* KLAT = (unsigned short*)(ws + WS_KLAT); unsigned short* VLAT = (unsigned short*)(ws + WS_VLAT);
    unsigned short* KCTX = (unsigned short*)(ws + WS_KCTX); unsigned short* VCTX = (unsigned short*)(ws + WS_VCTX);
    float* nck = p.out + (size_t)MTOK * DM; float* ncv = nck + (size_t)16 * 256 * 256;
    const int gw = blockIdx.x * 8 + wave, NGW = gridDim.x * 8;
    const int i8 = 8 * (lane & 15), hsel = lane >> 4;
    const bool colaxis = (i8 >> 6) != 0, second = ((i8 >> 5) & 1) != 0;
    float qg[8], kg[8], invf[8];
#pragma unroll
    for (int q = 0; q < 8; ++q) { qg[q] = p.in[16][i8 + q]; kg[q] = p.in[17][i8 + q]; invf[q] = __builtin_amdgcn_exp2f(-(float)((i8 & 31) + q) * (13.287712379549449f / 32.0f)); }
    for (int row = gw; row < MTOK; row += NGW) {
        const unsigned short* r = QKV + (size_t)row * NQKV + 8 * lane;
        const u32x4v w0 = *(const u32x4v*)(r), w1 = *(const u32x4v*)(r + 512), w2 = *(const u32x4v*)(r + 1024);
        const bool lat = row >= NCTX; int b, t; float cs[8], sn[8];
        if (lat) { const int rr = row - NCTX; b = rr >> 12; t = rr & 4095; const float pos = (float)(colaxis ? (t & 63) : (t >> 6));
#pragma unroll
            for (int q = 0; q < 8; ++q) { const float ang = pos * invf[q]; cs[q] = __cosf(ang); sn[q] = __sinf(ang); if (!second) sn[q] = -sn[q]; } }
        else { b = row >> 8; t = row & 255;
#pragma unroll
            for (int q = 0; q < 8; ++q) { cs[q] = 1.f; sn[q] = 0.f; } }
#pragma unroll
        for (int c = 0; c < 3; ++c) {
            const u32x4v w = c == 0 ? w0 : c == 1 ? w1 : w2;
            float x[8] = {bf_lo(w.x), bf_hi(w.x), bf_lo(w.y), bf_hi(w.y), bf_lo(w.z), bf_hi(w.z), bf_lo(w.w), bf_hi(w.w)};
            float s = 0.f;
#pragma unroll
            for (int q = 0; q < 8; ++q) s += x[q] * x[q];
            s += __shfl_xor(s, 1); s += __shfl_xor(s, 2); s += __shfl_xor(s, 4); s += __shfl_xor(s, 8);
            const float rstd = __builtin_amdgcn_rsqf(s * (1.0f / 128.0f) + EPS);
            float o[8];
#pragma unroll
            for (int q = 0; q < 8; ++q) { const float y = x[q] * rstd * (c < 2 ? qg[q] : kg[q]); const float yp = __shfl_xor(y, 4); o[q] = y * cs[q] + yp * sn[q]; }
            if (c < 2) { u32x4v ow; ow.x = pk2(o[0], o[1]); ow.y = pk2(o[2], o[3]); ow.z = pk2(o[4], o[5]); ow.w = pk2(o[6], o[7]);
                *(u32x4v*)(Q + (size_t)row * DM + c * 512 + 8 * lane) = ow; }
            else {
                const int kh = hsel & 1; const bool isv = hsel >= 2;
                u32x4v ow = w;
                if (!isv) { ow.x = pk2(o[0], o[1]); ow.y = pk2(o[2], o[3]); ow.z = pk2(o[4], o[5]); ow.w = pk2(o[6], o[7]); }
                if (lat) { unsigned short* dst = (isv ? VLAT : KLAT) + ((size_t)(b * 2 + kh) * SKV + PAST + t) * 128 + i8; *(u32x4v*)dst = ow; }
                else { unsigned short* dst = (isv ? VCTX : KCTX) + ((size_t)(b * 2 + kh) * LCTX + t) * 128 + i8; *(u32x4v*)dst = ow;
                    float* od = (isv ? ncv : nck) + ((size_t)(b * LCTX + t) * 2 + kh) * 128 + i8;
                    f32x4v f0, f1;
                    if (isv) { f0 = (f32x4v){x[0], x[1], x[2], x[3]}; f1 = (f32x4v){x[4], x[5], x[6], x[7]}; } else { f0 = (f32x4v){o[0], o[1], o[2], o[3]}; f1 = (f32x4v){o[4], o[5], o[6], o[7]}; }
                    *(f32x4v*)od = f0; *(f32x4v*)(od + 4) = f1; }
            }
        }
    }
    for (int it = gw; it < 2 * 4 * PAST; it += NGW) {
        const int which = it >> 11, q = it & 2047, b = q >> 9, s = q & 511, kh = lane >> 5;
        const f32x4v v = *(const f32x4v*)((which ? p.in[3] : p.in[2]) + (size_t)(b * PAST + s) * 256 + 4 * lane);
        u32x2v w; w.x = pk2(v.x, v.y); w.y = pk2(v.z, v.w);
        *(u32x2v*)((which ? VLAT : KLAT) + ((size_t)(b * 2 + kh) * SKV + s) * 128 + 4 * (lane & 31)) = w;
    }
}
__device__ __forceinline__ void phase_attention(const Params& p, char* lds) {
    unsigned char* ws = p.ws;
    const bf16* Q = (const bf16*)(ws + WS_Q); bf16* O = (bf16*)(ws + WS_O);
    const bf16* KLAT = (const bf16*)(ws + WS_KLAT); const bf16* VLAT = (const bf16*)(ws + WS_VLAT); const bf16* KCTX = (const bf16*)(ws + WS_KCTX); const bf16* VCTX = (const bf16*)(ws + WS_VCTX);
    for (int L = blockIdx.x; L < 128 + 512; L += gridDim.x) {
        if (L < 128) { const int b = L >> 3, h = L & 7; const size_t q0 = (size_t)(b * LCTX) * DM + h * 128, k0 = (size_t)(b * 2 + (h >> 2)) * LCTX * 128;
            attn::attn_dense_body<bf16>(Q + q0, KCTX + k0, VCTX + k0, O + q0, LCTX, lds); }
        else { const int u = L - 128, bk = u & 7, w = u >> 3, hq = w >> 4, qb = w & 15, b = bk >> 1, kvh = bk & 1, h = kvh * 4 + hq;
            const size_t q0 = (size_t)(NCTX + b * LLAT + qb * 256) * DM + h * 128, k0 = (size_t)(b * 2 + kvh) * SKV * 128;
            attn::attn_dense_body<bf16>(Q + q0, KLAT + k0, VLAT + k0, O + q0, SKV, lds); }
        __syncthreads();
    }
}

#define XB_TMO      128
#define XB_XCNT(j)  (256  + 64 * (j))
#define XB_XSUB(j)  (1280 + 64 * (j))
#define XB_XGEN(j)  (2304 + 64 * (j))
#define XB_TOP      3328
#define XB_TOPGEN   3392
#define XCD_BAR_WORDS 3456
#define XB_SPIN_CAP (1u << 18)

__device__ __forceinline__ unsigned xb_ld(unsigned* p)              { return __hip_atomic_load(p, __ATOMIC_RELAXED, __HIP_MEMORY_SCOPE_AGENT); }
__device__ __forceinline__ unsigned xb_add(unsigned* p, unsigned v) { return __hip_atomic_fetch_add(p, v, __ATOMIC_RELAXED, __HIP_MEMORY_SCOPE_AGENT); }
__device__ __forceinline__ unsigned xb_xcc_id() { return (unsigned)__builtin_amdgcn_s_getreg((3 << 11) | 20) & 0xFu; }
#define XB_SPIN(cond, bar) do { unsigned _sp = 0; while (cond) { __builtin_amdgcn_s_sleep(1); \
    if ((++_sp & 255u) == 0u) { if (xb_ld(&(bar)[XB_TMO])) break; if (_sp > XB_SPIN_CAP) { atomicAdd(&(bar)[XB_TMO], 1u); break; } } } } while (0)

struct XcdBarrier {
    unsigned* bar; unsigned x;
    volatile LAS unsigned* st;
};

__device__ __forceinline__ XcdBarrier xcd_barrier_post(unsigned* bar, volatile LAS unsigned* st) {
    XcdBarrier b; b.bar = bar; b.x = xb_xcc_id(); b.st = st;
    if (threadIdx.x == 0) (void)xb_add(&bar[XB_XCNT(b.x)], 1u);
    return b;
}
__device__ __forceinline__ void xcd_barrier_complete(unsigned* bar, unsigned x, unsigned& nloc, unsigned& nx) {
    const unsigned G = gridDim.x * gridDim.y * gridDim.z;
    unsigned sum, cnt, mine, sp = 0u;
    for (;;) {
        sum = 0u; cnt = 0u; mine = 0u;
#pragma unroll
        for (unsigned j = 0; j < 16; ++j) { const unsigned c = xb_ld(&bar[XB_XCNT(j)]); sum += c; cnt += (c > 0u) ? 1u : 0u; mine = (j == x) ? c : mine; }
        if (sum == G) break;
        __builtin_amdgcn_s_sleep(1);
        if ((++sp & 255u) == 0u) { if (xb_ld(&bar[XB_TMO])) break; if (sp > XB_SPIN_CAP) { atomicAdd(&bar[XB_TMO], 1u); break; } }
    }
    nloc = mine > 0u ? mine : 1u; nx = cnt > 0u ? cnt : 1u;
}

__device__ __forceinline__ void xcd_barrier(const XcdBarrier& b) {
    asm volatile("s_waitcnt vmcnt(0)" ::: "memory");
    __syncthreads();
    if (threadIdx.x == 0) {
        unsigned* bar = b.bar;
        __builtin_amdgcn_s_waitcnt(0);
        unsigned nloc = b.st[0], nx = b.st[1];
        if (nloc == 0u) { xcd_barrier_complete(bar, b.x, nloc, nx); b.st[0] = nloc; b.st[1] = nx; }
        const unsigned old = xb_add(&bar[XB_XSUB(b.x)], 1u);
        const unsigned gen = old / nloc;
        if (old + 1u == (gen + 1u) * nloc) {
            __builtin_amdgcn_fence(__ATOMIC_RELEASE, "agent");
            asm volatile("s_waitcnt vmcnt(0)" ::: "memory");
            const unsigned og = xb_add(&bar[XB_TOP], 1u);
            const unsigned tg = og / nx;
            if (og + 1u == (tg + 1u) * nx) xb_add(&bar[XB_TOPGEN], 1u);
            else XB_SPIN(xb_ld(&bar[XB_TOPGEN]) == tg, bar);
            __builtin_amdgcn_fence(__ATOMIC_ACQUIRE, "agent");
            xb_add(&bar[XB_XGEN(b.x)], 1u);
            asm volatile("s_waitcnt vmcnt(0)" ::: "memory");
        } else {
            XB_SPIN(xb_ld(&bar[XB_XGEN(b.x)]) == gen, bar);
            __builtin_amdgcn_fence(__ATOMIC_ACQUIRE, "agent");
            asm volatile("s_waitcnt vmcnt(0)" ::: "memory");
        }
    }
    __syncthreads();
}

template <int ph> __device__ __forceinline__ void run_phase(const Params& p, unsigned char* lds, int tid, int lane, int wave) {
    unsigned char* ws = p.ws;
    const float* mods = (const float*)(ws + WS_MODS); const float* gp = (const float*)(ws + WS_GP); float* ss = (float*)(ws + WS_SS);
    const float* sWf1 = (const float*)(ws + WS_SWF1); const float* sWqkv = (const float*)(ws + WS_SWQKV);
    float* xo = p.out;
    typedef pg8::bf16_t bt;
    if constexpr (ph == 0) phase_prep(p, (LAS unsigned char*)lds, tid, lane, wave);
    else if constexpr (ph == 1) phase_p1(p, tid, lane, wave);
    else if constexpr (ph == 2) {
        pg8::Gemm g{(const bt*)(ws + WS_H), (const bt*)(ws + WS_WIN), MTOK, EVIN, DM}; pg8::HalfOrder S; S.init(gridDim.x, blockIdx.x, EVIN / 256);
        pg8::EpiStoreN<false> E{(bt*)(ws + WS_P), EVIN, nullptr, nullptr, 0};
        pg8::gemm_phase<pg8::EpiStoreN<false>, pg8::HalfOrder, true, true>((LAS unsigned char*)lds, g, S, E); }
    else if constexpr (ph == 3) phase_mixer((const unsigned short*)(ws + WS_P), (unsigned short*)(ws + WS_MX), p.in[12], p.in[13], lane, wave);
    else if constexpr (ph == 4 || ph == 6 || ph == 10 || ph == 12) {
        constexpr int l = ph >= 10; constexpr bool ffn = (ph == 6 || ph == 12); constexpr int K = ffn ? DFF : DM; constexpr int site = ph == 4 ? 0 : ph == 6 ? 1 : ph == 10 ? 2 : 3;
        const unsigned char* A = ws + (ffn ? WS_ACT : (ph == 4 ? WS_MX : WS_O));
        const unsigned char* Bt = ws + (ffn ? WS_WF2 + l * WF2_STRIDE : (ph == 4 ? WS_WOUT : WS_WO));
        pg8::Gemm g{(const bt*)A, (const bt*)Bt, MTOK, DM, K}; pg8::HalfOrder S; S.init(gridDim.x, blockIdx.x);
        typedef pg8::EpiResNorm<(site < 3), (ph == 4)> Epi;
        Epi E{p.in[0], p.in[1], (bt*)(ws + WS_XB), mods + (size_t)l * 5 * 6144 + (ffn ? 5 : 2) * 1024, gp + (site < 3 ? site : 0) * 5120, (bt*)(ws + WS_H), ss + site * MTOK};
        pg8::gemm_phase<Epi, pg8::HalfOrder, true, true>((LAS unsigned char*)lds, g, S, E); }
    else if constexpr (ph == 5 || ph == 11) { constexpr int l = ph == 11;
        pg8::Gemm g{(const bt*)(ws + WS_H), (const bt*)(ws + WS_WF1 + l * WF1_STRIDE), MTOK, 2 * DFF, DM}; pg8::StaticOrder S; S.init(MTOK, 2 * DFF, gridDim.x, blockIdx.x);
        pg8::EpiSwigluN E{(bt*)(ws + WS_ACT), DFF, ss + (l ? 2 : 0) * MTOK, sWf1 + l * 5 * 2 * DFF, 2 * DFF};
        pg8::gemm_phase<pg8::EpiSwigluN, pg8::StaticOrder, true, true>((LAS unsigned char*)lds, g, S, E); }
    else if constexpr (ph == 7) {
        pg8::Gemm g{(const bt*)(ws + WS_H), (const bt*)(ws + WS_WQKV), MTOK, NQKV, DM}; pg8::StaticOrder S; S.init(MTOK, NQKV, gridDim.x, blockIdx.x);
        pg8::EpiStoreN<true> E{(bt*)(ws + WS_QKV), NQKV, ss + 1 * MTOK, sWqkv, NQKV};
        pg8::gemm_phase<pg8::EpiStoreN<true>, pg8::StaticOrder, true, true>((LAS unsigned char*)lds, g, S, E); }
    else if constexpr (ph == 8) phase_qknorm(p, lane, wave);
    else if constexpr (ph == 9) phase_attention(p, (char*)lds);
    else if constexpr (ph == 13) phase_final((const unsigned short*)(ws + WS_XB), xo, p.in[21], ss + 3 * MTOK, lane, wave);
}
__global__ void __launch_bounds__(512, 2) mega_fwd(Params p) {
    extern __shared__ __attribute__((aligned(16))) unsigned char lds[];
    cg::grid_group grid = cg::this_grid();
    const int tid = threadIdx.x, lane = tid & 63, wave = __builtin_amdgcn_readfirstlane(tid >> 6);
    const bool multi = p.ph_hi - p.ph_lo > 1, use_cg = gridDim.x > 1024u;
    if (tid < 2) ((LAS unsigned*)(lds + 131072))[tid] = 0u;
    __syncthreads();
    XcdBarrier bar; bar.bar = (unsigned*)(p.ws + WS_BAR); bar.x = 0; bar.st = nullptr;
    if (multi && !use_cg) bar = xcd_barrier_post((unsigned*)(p.ws + WS_BAR), (volatile LAS unsigned*)(lds + 131072));
#define SEAM(k) do { if (use_cg) grid.sync(); else xcd_barrier(bar); } while (0)
#define PHASE(k) if (p.ph_lo <= (k) && (k) < p.ph_hi) { run_phase<(k)>(p, lds, tid, lane, wave); if ((k) + 1 < p.ph_hi) SEAM(k); }
    PHASE(0) PHASE(1) PHASE(2) PHASE(3) PHASE(4) PHASE(5) PHASE(6) PHASE(7) PHASE(8) PHASE(9) PHASE(10) PHASE(11) PHASE(12) PHASE(13)
#undef PHASE
}

#ifndef MK_SPLIT
#define MK_SPLIT 0
#endif
extern "C" void kernel_launch(void* const* d_in, const int* in_sizes, int n_in, void* d_out, int out_size, void* d_ws, size_t ws_size, hipStream_t stream) {
    static int grid_blocks = 0;
    if (grid_blocks == 0) {
        if (n_in != 22 || ws_size < WS_END) { fprintf(stderr, "kernel_launch: unexpected n_in %d / ws_size %zu\n", n_in, ws_size); grid_blocks = -1; return; }
        int dev = 0, cus = 0, per_cu = 0;
        (void)hipGetDevice(&dev); (void)hipDeviceGetAttribute(&cus, hipDeviceAttributeMultiprocessorCount, dev);
        if (hipFuncSetAttribute((const void*)mega_fwd, hipFuncAttributeMaxDynamicSharedMemorySize, LDS_BYTES) != hipSuccess) { fprintf(stderr, "kernel_launch: hipFuncSetAttribute failed\n"); grid_blocks = -1; return; }
        if (hipOccupancyMaxActiveBlocksPerMultiprocessor(&per_cu, (const void*)mega_fwd, 512, LDS_BYTES) != hipSuccess || per_cu < 1) { fprintf(stderr, "kernel_launch: occupancy query gave %d\n", per_cu); grid_blocks = -1; return; }
        grid_blocks = cus * per_cu;
    }
    if (grid_blocks < 0) return;
    if (hipMemsetAsync((char*)d_ws + WS_ZERO_BEGIN, 0, WS_ZERO_BYTES, stream) != hipSuccess) { fprintf(stderr, "kernel_launch: hipMemsetAsync failed\n"); return; }
    Params p{};
    for (int i = 0; i < 22; ++i) p.in[i] = (const float*)d_in[i];
    p.out = (float*)d_out; p.ws = (unsigned char*)d_ws;
#if MK_SPLIT
    for (int ph = 0; ph < NPHASE; ++ph) {
        p.ph_lo = ph; p.ph_hi = ph + 1; void* args[] = {&p};
        hipError_t e = hipLaunchCooperativeKernel((const void*)mega_fwd, dim3(grid_blocks), dim3(512), args, LDS_BYTES, stream);
        if (e != hipSuccess) { fprintf(stderr, "cooperative launch failed: %s (grid %d)\n", hipGetErrorString(e), grid_blocks); return; }
    }
#else
    p.ph_lo = 0; p.ph_hi = NPHASE; void* args[] = {&p};
    hipError_t e = hipLaunchCooperativeKernel((const void*)mega_fwd, dim3(grid_blocks), dim3(512), args, LDS_BYTES, stream);
    if (e != hipSuccess) fprintf(stderr, "cooperative launch failed: %s (grid %d)\n", hipGetErrorString(e), grid_blocks);
#endif
}
```

```cpp
#include <hip/hip_runtime.h>
#include <hip/hip_cooperative_groups.h>
#include <hip/hip_bf16.h>
#include <cstdio>
#include <cstdint>
namespace cg = cooperative_groups;

namespace pg8 {
#define PG8_LAS __attribute__((address_space(3)))
typedef unsigned short bf16_t;
typedef short bf16x8 __attribute__((ext_vector_type(8)));
typedef float f32x4 __attribute__((ext_vector_type(4)));
typedef unsigned u32x4 __attribute__((ext_vector_type(4)));
constexpr int BM = 256, BK = 64, HALF = 128, HTB = HALF * BK * 2  , STAGE_BYTES = 8 * HTB, NXCD = 8, WGM = 8;

__host__ __device__ __forceinline__ int lds_byte(int r, int c) { const int st = (r >> 4) * 2 + (c >> 5), rr = r & 15, cc = c & 31, ob = rr * 64 + cc * 2; return st * 1024 + (ob ^ (((ob >> 9) & 1) << 5)); }
__host__ __device__ __forceinline__ void stage_rc(int b, int& R, int& C) { const int st = b / 1024, sb = b % 1024, swz = sb ^ (((sb >> 9) & 1) << 5); R = (st >> 1) * 16 + swz / 64; C = (st & 1) * 32 + (swz % 64) / 2; }
__host__ __device__ __forceinline__ int perm32(int rho) { const int n = rho >> 4, i = rho & 15; return 8 * (i >> 2) + 4 * n + (i & 3); }

struct Unit { int pm, pn, hf; };
struct Gemm { const bf16_t* A; const bf16_t* Bt; int M, N, K; };

struct StaticOrder {
    int nM, nN, nwg, G, c;
    __host__ __device__ void init(int M, int N, int G_, int c_) { nM = M / BM; nN = N / BM; nwg = nM * nN; G = G_; c = c_; }
    __host__ __device__ bool next(int i, Unit& u) const {
        const long L = (long)i * G + c; if (L >= nwg) return false;
        int wgid = (int)L; { const int q = nwg / NXCD, r = nwg % NXCD, xcd = wgid % NXCD, off = wgid / NXCD; wgid = (xcd < r ? xcd * (q + 1) : r * (q + 1) + (xcd - r) * q) + off; }
        const int nig = WGM * nN, gid = wgid / nig, fm = gid * WGM, gsz = (nM - fm) < WGM ? (nM - fm) : WGM;
        u.pm = fm + ((wgid % nig) % gsz); u.pn = (wgid % nig) / gsz; u.hf = 0; return true;
    }
    __device__ __forceinline__ void a_ready(const Unit&) const {}
    __device__ __forceinline__ void done(const Unit&) const {}
};
struct HalfOrder {
    int G, c, ncol;
    __host__ __device__ void init(int G_, int c_, int ncol_ = 4) { G = G_; c = c_; ncol = ncol_; }
    __host__ __device__ __forceinline__ bool next(int i, Unit& u) const {
        const int L = i * G + c, nhalf = 32 * ncol; if (L >= nhalf + 64 * ncol) return false;
        const bool full = L >= nhalf; const int Lf = L - nhalf, x = Lf & 7, slot = Lf >> 3, h = L;
        u.pm = full ? 16 + x * 8 + slot / ncol : h / (2 * ncol); u.pn = full ? slot % ncol : h % (2 * ncol); u.hf = full ? 0 : 1;
        return true;
    }
    __device__ __forceinline__ void a_ready(const Unit&) const {}
    __device__ __forceinline__ void done(const Unit&) const {}
};

__device__ __forceinline__ unsigned cvt_pk_bf16(float lo, float hi) { unsigned r; asm volatile("v_cvt_pk_bf16_f32 %0, %1, %2" : "=v"(r) : "v"(lo), "v"(hi)); return r; }
__device__ __forceinline__ int cond_of(int pm) { return pm < 16 ? 0 : 1 + ((pm - 16) >> 4); }
template <bool NORM> struct EpiStoreN {
    static constexpr bool PERM = true, AFTER_DRAIN = false;
    bf16_t* O; int ldc; const float* ss; const float* sW; int ldw;
    __device__ __forceinline__ void operator()(const f32x4 (&acc)[2][2][4][2], const Unit& u, int wr, int wc, int fr, int fq) const {
        const int row0 = u.pm * BM + wr * 64 + fr, col0 = u.pn * (u.hf ? HALF : BM) + wc * 32 + 8 * fq; const int nbj = u.hf ? 1 : 2;
        f32x4 bv[2][2];
        if constexpr (NORM) { const float* bp = sW + (size_t)cond_of(u.pm) * ldw + col0;
#pragma unroll
            for (int bj = 0; bj < 2; ++bj)
#pragma unroll
                for (int n = 0; n < 2; ++n) bv[bj][n] = *(const f32x4*)(bp + bj * HALF + 4 * n); }
#pragma unroll
        for (int ai = 0; ai < 2; ++ai)
#pragma unroll
            for (int m = 0; m < 4; ++m) { const int r = row0 + ai * HALF + m * 16; bf16_t* rowp = O + (size_t)r * ldc + col0;
                float rs = 1.f; if constexpr (NORM) rs = __builtin_amdgcn_rsqf(ss[r] * (1.0f / 1024.0f) + 1e-6f);
#pragma unroll
                for (int bj = 0; bj < 2; ++bj) { if (bj >= nbj) continue; f32x4 v0 = acc[ai][bj][m][0], v1 = acc[ai][bj][m][1];
                    if constexpr (NORM) { v0 = v0 * rs + bv[bj][0]; v1 = v1 * rs + bv[bj][1]; }
                    u32x4 w; w.x = cvt_pk_bf16(v0[0], v0[1]); w.y = cvt_pk_bf16(v0[2], v0[3]); w.z = cvt_pk_bf16(v1[0], v1[1]); w.w = cvt_pk_bf16(v1[2], v1[3]);
                    *(u32x4*)(rowp + bj * HALF) = w; } }
    }
};
__device__ __forceinline__ float silu_mul(float a, float b) { return a * __builtin_amdgcn_rcpf(1.0f + __builtin_amdgcn_exp2f(-1.4426950408889634f * a)) * b; }
struct EpiSwigluN {
    static constexpr bool PERM = true, AFTER_DRAIN = false;
    bf16_t* O; int ldc; const float* ss; const float* sW; int ldw;
    __device__ __forceinline__ void operator()(const f32x4 (&acc)[2][2][4][2], const Unit& u, int wr, int wc, int fr, int fq) const {
        const int row0 = u.pm * BM + wr * 64 + fr, col0 = u.pn * HALF + wc * 32 + 8 * fq;
        const float* bp = sW + (size_t)cond_of(u.pm) * ldw + u.pn * BM + wc * 32 + 8 * fq;
        const f32x4 ba0 = *(const f32x4*)(bp), ba1 = *(const f32x4*)(bp + 4), bb0 = *(const f32x4*)(bp + HALF), bb1 = *(const f32x4*)(bp + HALF + 4);
#pragma unroll
        for (int ai = 0; ai < 2; ++ai)
#pragma unroll
            for (int m = 0; m < 4; ++m) { const int r = row0 + ai * HALF + m * 16; bf16_t* rowp = O + (size_t)r * ldc + col0;
                const float rs = __builtin_amdgcn_rsqf(ss[r] * (1.0f / 1024.0f) + 1e-6f);
                const f32x4 a0 = acc[ai][0][m][0] * rs + ba0, a1 = acc[ai][0][m][1] * rs + ba1, b0 = acc[ai][1][m][0] * rs + bb0, b1 = acc[ai][1][m][1] * rs + bb1;
                u32x4 w; w.x = cvt_pk_bf16(silu_mul(a0[0], b0[0]), silu_mul(a0[1], b0[1])); w.y = cvt_pk_bf16(silu_mul(a0[2], b0[2]), silu_mul(a0[3], b0[3]));
                w.z = cvt_pk_bf16(silu_mul(a1[0], b1[0]), silu_mul(a1[1], b1[1])); w.w = cvt_pk_bf16(silu_mul(a1[2], b1[2]), silu_mul(a1[3], b1[3]));
                *(u32x4*)rowp = w; }
    }
};
template <bool HB, bool FIRST> struct EpiResNorm {
    static constexpr bool PERM = true, AFTER_DRAIN = false;
    const float* base_ctx; const float* base_lat; bf16_t* xb; const float* gate; const float* gp; bf16_t* hb; float* ss;
    __device__ __forceinline__ void operator()(const f32x4 (&acc)[2][2][4][2], const Unit& u, int wr, int wc, int fr, int fq) const {
        const int j = cond_of(u.pm);
        const float* base = u.pm < 16 ? base_ctx + (size_t)u.pm * BM * 1024 : base_lat + (size_t)(u.pm - 16) * BM * 1024;
        const int col0 = u.pn * (u.hf ? HALF : BM) + wc * 32 + 8 * fq, rl0 = wr * 64 + fr; const int nbj = u.hf ? 1 : 2;
        f32x4 gv[2][2], pv[2][2];
#pragma unroll
        for (int bj = 0; bj < 2; ++bj)
#pragma unroll
            for (int n = 0; n < 2; ++n) { if (bj >= nbj) continue; gv[bj][n] = *(const f32x4*)(gate + (size_t)j * 6144 + col0 + bj * HALF + n * 4);
                if constexpr (HB) pv[bj][n] = *(const f32x4*)(gp + (size_t)j * 1024 + col0 + bj * HALF + n * 4); }
        bf16_t* outp = xb + (size_t)u.pm * BM * 1024; bf16_t* hbp = hb + (size_t)u.pm * BM * 1024; float* ssp = ss + u.pm * BM;
#pragma unroll
        for (int ai = 0; ai < 2; ++ai)
#pragma unroll
            for (int m = 0; m < 4; ++m) { const int rl = rl0 + ai * HALF + m * 16; const size_t off = (size_t)rl * 1024 + col0; float s = 0.f;
#pragma unroll
                for (int bj = 0; bj < 2; ++bj) { if (bj >= nbj) continue;
                    f32x4 b0, b1;
                    if constexpr (FIRST) { b0 = *(const f32x4*)(base + off + bj * HALF); b1 = *(const f32x4*)(base + off + bj * HALF + 4); }
                    else { const u32x4 bw = *(const u32x4*)(outp + off + bj * HALF);
                        b0 = (f32x4){__builtin_bit_cast(float, bw.x << 16), __builtin_bit_cast(float, bw.x & 0xffff0000u), __builtin_bit_cast(float, bw.y << 16), __builtin_bit_cast(float, bw.y & 0xffff0000u)};
                        b1 = (f32x4){__builtin_bit_cast(float, bw.z << 16), __builtin_bit_cast(float, bw.z & 0xffff0000u), __builtin_bit_cast(float, bw.w << 16), __builtin_bit_cast(float, bw.w & 0xffff0000u)}; }
                    const f32x4 o0 = b0 + gv[bj][0] * acc[ai][bj][m][0], o1 = b1 + gv[bj][1] * acc[ai][bj][m][1];
                    { u32x4 ow; ow.x = cvt_pk_bf16(o0[0], o0[1]); ow.y = cvt_pk_bf16(o0[2], o0[3]); ow.z = cvt_pk_bf16(o1[0], o1[1]); ow.w = cvt_pk_bf16(o1[2], o1[3]); *(u32x4*)(outp + off + bj * HALF) = ow; }
                    s += ((o0[0] * o0[0] + o0[1] * o0[1]) + (o0[2] * o0[2] + o0[3] * o0[3])) + ((o1[0] * o1[0] + o1[1] * o1[1]) + (o1[2] * o1[2] + o1[3] * o1[3]));
                    if constexpr (HB) { const f32x4 h0 = o0 * pv[bj][0], h1 = o1 * pv[bj][1]; u32x4 w; w.x = cvt_pk_bf16(h0[0], h0[1]); w.y = cvt_pk_bf16(h0[2], h0[3]); w.z = cvt_pk_bf16(h1[0], h1[1]); w.w = cvt_pk_bf16(h1[2], h1[3]); *(u32x4*)(hbp + off + bj * HALF) = w; } }
                s += __shfl_xor(s, 16); s += __shfl_xor(s, 32);
                if (fq == 0) __hip_atomic_fetch_add(ssp + rl, s, __ATOMIC_RELAXED, __HIP_MEMORY_SCOPE_AGENT); }
    }
};

template <class Epi, class Sched, bool ALIGN_EPI = false, bool SP2 = false>
__device__ __forceinline__ void gemm_phase(PG8_LAS unsigned char* lds, const Gemm g, const Sched& S, const Epi& E) {
    const int tid = threadIdx.x, wid = __builtin_amdgcn_readfirstlane(tid >> 6), lane = tid & 63, wr = wid >> 2, wc = wid & 3, fr = lane & 15, fq = lane >> 4;
    const int K = g.K, nt = K / BK;
    unsigned voffA[2], voffB[2];
#pragma unroll
    for (int i = 0; i < 2; ++i) { int R, C; stage_rc(tid * 16 + i * 8192, R, C); const int Rb = Epi::PERM ? ((R & ~31) + perm32(R & 31)) : R;
        voffA[i] = (unsigned)(R * K + C) * 2u; voffB[i] = (unsigned)(Rb * K + C) * 2u; }
    const size_t kstep = (size_t)(BK * 2);
    const size_t hstep = (size_t)HALF * K * 2;
    const size_t tstep = 2 * hstep;
    const unsigned ldsw = (unsigned)wid * 1024u;
    const int aoff = lds_byte(wr * 64 + fr, fq * 8), boff = lds_byte(wc * 32 + fr, fq * 8);
#define PG8_SA(b, h) (((b) * 2 + (h)) * HTB)
#define PG8_SB(b, h) ((4 + (b) * 2 + (h)) * HTB)
#define PG8_STAGE(bufoff, gbase, voff) do { _Pragma("unroll") for (int _i = 0; _i < 2; ++_i) \
        __builtin_amdgcn_global_load_lds((const unsigned*)((const char*)(gbase) + (voff)[_i]), (PG8_LAS unsigned*)(lds + (bufoff) + ldsw + _i * 8192), 16, 0, 0); } while (0)
#define PG8_LDA(dst, b, h) do { _Pragma("unroll") for (int m = 0; m < 4; ++m) _Pragma("unroll") for (int k = 0; k < 2; ++k) dst[m][k] = *(const PG8_LAS bf16x8*)(lds + PG8_SA(b, h) + aoff + m * 2048 + k * 1024); } while (0)
#define PG8_LDB(dst, b, h) do { _Pragma("unroll") for (int n = 0; n < 2; ++n) _Pragma("unroll") for (int k = 0; k < 2; ++k) dst[n][k] = *(const PG8_LAS bf16x8*)(lds + PG8_SB(b, h) + boff + n * 2048 + k * 1024); } while (0)
#define PG8_MMA(ai, bj, At, Bt) do { __builtin_amdgcn_s_setprio(1); _Pragma("unroll") for (int m = 0; m < 4; ++m) _Pragma("unroll") for (int n = 0; n < 2; ++n) _Pragma("unroll") for (int k = 0; k < 2; ++k) \
        acc[ai][bj][m][n] = __builtin_amdgcn_mfma_f32_16x16x32_bf16(Bt[n][k], At[m][k], acc[ai][bj][m][n], 0, 0, 0); __builtin_amdgcn_s_setprio(0); } while (0)
#define PG8_WAIT_V(n) asm volatile("s_waitcnt vmcnt(" #n ")" ::: "memory")
#define PG8_WAIT_L(n) asm volatile("s_waitcnt lgkmcnt(" #n ")" ::: "memory")
#define PG8_BAR __builtin_amdgcn_s_barrier()
#define PG8_SCHED __builtin_amdgcn_sched_barrier(0)
    Unit cur, nxt; int ui = 0;
    if (!S.next(0, cur)) return;
    f32x4 acc[2][2][4][2];
#pragma unroll
    for (int a = 0; a < 2; ++a)
#pragma unroll
        for (int b = 0; b < 2; ++b)
#pragma unroll
            for (int m = 0; m < 4; ++m)
#pragma unroll
                for (int n = 0; n < 2; ++n) acc[a][b][m][n] = (f32x4){0.f, 0.f, 0.f, 0.f};
    bf16x8 At[4][2], B0[2][2], B1[2][2];
    const char* cA = (const char*)g.A + (size_t)cur.pm * tstep; const char* cB = (const char*)g.Bt + (size_t)cur.pn * (cur.hf ? hstep : tstep);
    S.a_ready(cur);
    if constexpr (SP2) {
        PG8_STAGE(PG8_SB(0, 0), cB, voffB); PG8_STAGE(PG8_SB(0, 1), cB + hstep, voffB); PG8_STAGE(PG8_SA(0, 0), cA, voffA); PG8_STAGE(PG8_SA(0, 1), cA + hstep, voffA);
        if (wr == 1) PG8_BAR;
        PG8_WAIT_V(2); PG8_BAR;
        PG8_STAGE(PG8_SB(1, 0), cB + kstep, voffB); PG8_STAGE(PG8_SA(1, 0), cA + kstep, voffA); PG8_STAGE(PG8_SB(1, 1), cB + hstep + kstep, voffB);
        PG8_WAIT_V(6); PG8_BAR;
    } else {
        PG8_STAGE(PG8_SB(0, 0), cB, voffB); PG8_STAGE(PG8_SA(0, 0), cA, voffA); PG8_STAGE(PG8_SB(0, 1), cB + hstep, voffB); PG8_STAGE(PG8_SA(0, 1), cA + hstep, voffA);
        if (wr == 1) PG8_BAR;
        PG8_WAIT_V(4); PG8_BAR;
        PG8_STAGE(PG8_SB(1, 0), cB + kstep, voffB); PG8_STAGE(PG8_SA(1, 0), cA + kstep, voffA); PG8_STAGE(PG8_SB(1, 1), cB + hstep + kstep, voffB);
        PG8_WAIT_V(6); PG8_BAR;
    }
    for (;;) {
        const bool has_next = S.next(ui + 1, nxt);
        const char* nA = has_next ? (const char*)g.A + (size_t)nxt.pm * tstep : cA; const char* nB = has_next ? (const char*)g.Bt + (size_t)nxt.pn * (nxt.hf ? hstep : tstep) : cB;
        const bool fullu = cur.hf == 0;
        if (fullu) {
        for (int t = 0; t < nt; t += 2) {
            const bool last = (t == nt - 2);
            const char* a1 = cA + (size_t)(t + 1) * kstep;
            const char* a2 = last ? nA : cA + (size_t)(t + 2) * kstep; const char* b2 = last ? nB : cB + (size_t)(t + 2) * kstep;
            const char* a3 = a2 + kstep; const char* b3 = b2 + kstep;
            if (last && has_next) S.a_ready(nxt);
            if constexpr (SP2) {
            PG8_LDB(B0, 0, 0); PG8_LDB(B1, 0, 1); PG8_SCHED; PG8_LDA(At, 0, 0); PG8_STAGE(PG8_SA(1, 1), a1 + hstep, voffA);
            PG8_WAIT_V(8); PG8_WAIT_L(0); PG8_BAR; PG8_MMA(0, 0, At, B0); PG8_MMA(0, 1, At, B1); PG8_BAR; PG8_SCHED;
            PG8_LDA(At, 0, 1); PG8_STAGE(PG8_SB(0, 0), b2, voffB); PG8_STAGE(PG8_SB(0, 1), b2 + hstep, voffB); PG8_STAGE(PG8_SA(0, 0), a2, voffA);
            PG8_WAIT_V(8); PG8_WAIT_L(0); PG8_BAR; PG8_MMA(1, 0, At, B0); PG8_MMA(1, 1, At, B1); PG8_BAR; PG8_SCHED;
            PG8_LDB(B0, 1, 0); PG8_LDB(B1, 1, 1); PG8_SCHED; PG8_LDA(At, 1, 0); PG8_STAGE(PG8_SA(0, 1), a2 + hstep, voffA);
            PG8_WAIT_V(8); PG8_WAIT_L(0); PG8_BAR; PG8_MMA(0, 0, At, B0); PG8_MMA(0, 1, At, B1); PG8_BAR; PG8_SCHED;
            PG8_LDA(At, 1, 1); PG8_STAGE(PG8_SB(1, 0), b3, voffB); PG8_STAGE(PG8_SB(1, 1), b3 + hstep, voffB); PG8_STAGE(PG8_SA(1, 0), a3, voffA);
            PG8_WAIT_V(8); PG8_WAIT_L(0); PG8_BAR; PG8_MMA(1, 0, At, B0); PG8_MMA(1, 1, At, B1); PG8_BAR; PG8_SCHED;
            } else {
            PG8_LDB(B0, 0, 0); PG8_SCHED; PG8_LDA(At, 0, 0); PG8_STAGE(PG8_SA(1, 1), a1 + hstep, voffA);
            PG8_WAIT_L(8); PG8_BAR; PG8_WAIT_L(0); PG8_MMA(0, 0, At, B0); PG8_BAR; PG8_SCHED;
            PG8_LDB(B1, 0, 1); PG8_STAGE(PG8_SB(0, 0), b2, voffB);
            PG8_BAR; PG8_WAIT_L(0); PG8_MMA(0, 1, At, B1); PG8_BAR;
            PG8_LDA(At, 0, 1); PG8_STAGE(PG8_SA(0, 0), a2, voffA);
            PG8_BAR; PG8_WAIT_L(0); PG8_MMA(1, 0, At, B0); PG8_BAR; PG8_SCHED;
            PG8_STAGE(PG8_SB(0, 1), b2 + hstep, voffB);
            PG8_WAIT_V(6); PG8_BAR; PG8_MMA(1, 1, At, B1); PG8_BAR;
            PG8_LDB(B0, 1, 0); PG8_SCHED; PG8_LDA(At, 1, 0); PG8_STAGE(PG8_SA(0, 1), a2 + hstep, voffA);
            PG8_WAIT_L(8); PG8_BAR; PG8_WAIT_L(0); PG8_MMA(0, 0, At, B0); PG8_BAR; PG8_SCHED;
            PG8_LDB(B1, 1, 1); PG8_STAGE(PG8_SB(1, 0), b3, voffB);
            PG8_BAR; PG8_WAIT_L(0); PG8_MMA(0, 1, At, B1); PG8_BAR;
            PG8_LDA(At, 1, 1); PG8_STAGE(PG8_SA(1, 0), a3, voffA);
            PG8_BAR; PG8_WAIT_L(0); PG8_MMA(1, 0, At, B0); PG8_BAR; PG8_SCHED;
            PG8_STAGE(PG8_SB(1, 1), b3 + hstep, voffB);
            PG8_WAIT_V(6); PG8_BAR; PG8_MMA(1, 1, At, B1); PG8_BAR;
            }
        }
        } else {
        for (int t = 0; t < nt; t += 2) {
            const bool last = (t == nt - 2);
            const char* a1 = cA + (size_t)(t + 1) * kstep;
            const char* a2 = last ? nA : cA + (size_t)(t + 2) * kstep; const char* b2 = last ? nB : cB + (size_t)(t + 2) * kstep;
            const char* a3 = a2 + kstep; const char* b3 = b2 + kstep;
            if (last && has_next) S.a_ready(nxt);
            if constexpr (SP2) {
            PG8_LDB(B0, 0, 0); PG8_LDB(B1, 0, 1); PG8_SCHED; PG8_LDA(At, 0, 0); PG8_STAGE(PG8_SA(1, 1), a1 + hstep, voffA);
            PG8_WAIT_V(8); PG8_WAIT_L(0); PG8_BAR; PG8_MMA(0, 0, At, B0);  PG8_BAR; PG8_SCHED;
            PG8_LDA(At, 0, 1); PG8_STAGE(PG8_SB(0, 0), b2, voffB); PG8_STAGE(PG8_SB(0, 1), b2 + hstep, voffB); PG8_STAGE(PG8_SA(0, 0), a2, voffA);
            PG8_WAIT_V(8); PG8_WAIT_L(0); PG8_BAR; PG8_MMA(1, 0, At, B0);  PG8_BAR; PG8_SCHED;
            PG8_LDB(B0, 1, 0); PG8_LDB(B1, 1, 1); PG8_SCHED; PG8_LDA(At, 1, 0); PG8_STAGE(PG8_SA(0, 1), a2 + hstep, voffA);
            PG8_WAIT_V(8); PG8_WAIT_L(0); PG8_BAR; PG8_MMA(0, 0, At, B0);  PG8_BAR; PG8_SCHED;
            PG8_LDA(At, 1, 1); PG8_STAGE(PG8_SB(1, 0), b3, voffB); PG8_STAGE(PG8_SB(1, 1), b3 + hstep, voffB); PG8_STAGE(PG8_SA(1, 0), a3, voffA);
            PG8_WAIT_V(8); PG8_WAIT_L(0); PG8_BAR; PG8_MMA(1, 0, At, B0);  PG8_BAR; PG8_SCHED;
            } else {
            PG8_LDB(B0, 0, 0); PG8_SCHED; PG8_LDA(At, 0, 0); PG8_STAGE(PG8_SA(1, 1), a1 + hstep, voffA);
            PG8_WAIT_L(8); PG8_BAR; PG8_WAIT_L(0); PG8_MMA(0, 0, At, B0); PG8_BAR; PG8_SCHED;
            PG8_LDB(B1, 0, 1); PG8_STAGE(PG8_SB(0, 0), b2, voffB);
            PG8_BAR; PG8_WAIT_L(0); PG8_MMA(0, 1, At, B1); PG8_BAR;
            PG8_LDA(At, 0, 1); PG8_STAGE(PG8_SA(0, 0), a2, voffA);
            PG8_BAR; PG8_WAIT_L(0); PG8_MMA(1, 0, At, B0); PG8_BAR; PG8_SCHED;
            PG8_STAGE(PG8_SB(0, 1), b2 + hstep, voffB);
            PG8_WAIT_V(6); PG8_BAR; PG8_MMA(1, 1, At, B1); PG8_BAR;
            PG8_LDB(B0, 1, 0); PG8_SCHED; PG8_LDA(At, 1, 0); PG8_STAGE(PG8_SA(0, 1), a2 + hstep, voffA);
            PG8_WAIT_L(8); PG8_BAR; PG8_WAIT_L(0); PG8_MMA(0, 0, At, B0); PG8_BAR; PG8_SCHED;
            PG8_LDB(B1, 1, 1); PG8_STAGE(PG8_SB(1, 0), b3, voffB);
            PG8_BAR; PG8_WAIT_L(0); PG8_MMA(0, 1, At, B1); PG8_BAR;
            PG8_LDA(At, 1, 1); PG8_STAGE(PG8_SA(1, 0), a3, voffA);
            PG8_BAR; PG8_WAIT_L(0); PG8_MMA(1, 0, At, B0); PG8_BAR; PG8_SCHED;
            PG8_STAGE(PG8_SB(1, 1), b3 + hstep, voffB);
            PG8_WAIT_V(6); PG8_BAR; PG8_MMA(1, 1, At, B1); PG8_BAR;
            }
        }
        }
        if constexpr (ALIGN_EPI) { if (wr == 0) PG8_BAR; }
        if constexpr (!Epi::AFTER_DRAIN) { E(acc, cur, wr, wc, fr, fq); S.done(cur); }
        if (!has_next) break;
#pragma unroll
        for (int a = 0; a < 2; ++a)
#pragma unroll
            for (int b = 0; b < 2; ++b)
#pragma unroll
                for (int m = 0; m < 4; ++m)
#pragma unroll
                    for (int n = 0; n < 2; ++n) acc[a][b][m][n] = (f32x4){0.f, 0.f, 0.f, 0.f};
        cur = nxt; cA = nA; cB = nB; ++ui;
        if constexpr (ALIGN_EPI) { if (wr == 1) PG8_BAR; }
    }
    PG8_WAIT_V(0);
    if constexpr (!ALIGN_EPI) { if (wr == 0) PG8_BAR; }
    PG8_BAR;
    if constexpr (Epi::AFTER_DRAIN) { E.fused(acc, cur, wr, wc, fr, fq, lds, wid, lane); S.done(cur); }
#undef PG8_SA
#undef PG8_SB
#undef PG8_STAGE
#undef PG8_LDA
#undef PG8_LDB
#undef PG8_MMA
#undef PG8_WAIT_V
#undef PG8_WAIT_L
#undef PG8_BAR
#undef PG8_SCHED
}
}
namespace attn {
using bf16 = __hip_bfloat16;
constexpr int   D = 128, NW = 8, QBLK = 32, KVBLK = 64;
constexpr float SCALE = 0.088388347648318440f;
constexpr float THR = 8.f;
constexpr int SDEPTH = 2;
constexpr int LDQ = 1024, LDK = 128, LDO = 1024;
constexpr size_t SHM_V = KVBLK * D * 2, SHM_K = KVBLK * D * 2, SHM_ATTN = 2 * SHM_V + 2 * SHM_K + NW * 64 * 4;
using bf16x8 = __attribute__((ext_vector_type(8))) short;
using s16x4  = __attribute__((ext_vector_type(4))) short;
using f32x16 = __attribute__((ext_vector_type(16))) float;
using f32x8  = __attribute__((ext_vector_type(8))) float;
using u32x4  = __attribute__((ext_vector_type(4))) unsigned;
#define KSWZ(row, colB) ((row) * 256 + ((colB) ^ (((row) & 7) << 4)))
#define SBAR() __builtin_amdgcn_sched_barrier(0)
__device__ __forceinline__ int crow(int r, int hi) { return (r & 3) + 8 * (r >> 2) + 4 * hi; }
__device__ __forceinline__ unsigned cvtpk(float lo, float hi) {
  unsigned r; asm volatile("v_cvt_pk_bf16_f32 %0, %1, %2" : "=v"(r) : "v"(lo), "v"(hi)); return r;
}
template <typename TIn> struct Stage;
template <> struct Stage<bf16>  { using T = bf16x8;
  __device__ static __forceinline__ T ld8(const bf16* p) { return *reinterpret_cast<const bf16x8*>(p); }
  __device__ static __forceinline__ bf16x8 tobf(T x) { return x; } };
template <> struct Stage<float> { using T = f32x8;
  __device__ static __forceinline__ T ld8(const float* p) { return *reinterpret_cast<const f32x8*>(p); }
  __device__ static __forceinline__ bf16x8 tobf(T x) {
    u32x4 w = {cvtpk(x[0], x[1]), cvtpk(x[2], x[3]), cvtpk(x[4], x[5]), cvtpk(x[6], x[7])}; return *reinterpret_cast<bf16x8*>(&w); } };

__device__ __forceinline__ void partialSM(f32x16& p0, f32x16& p1, float& m_reg, float& mn, float& alpha) {
  constexpr float C = SCALE * 1.4426950408889634f;
  float pmax = p0[0]; for (int r = 1; r < 16; ++r) pmax = fmaxf(pmax, p0[r]); for (int r = 0; r < 16; ++r) pmax = fmaxf(pmax, p1[r]);
  { auto rr = __builtin_amdgcn_permlane32_swap(__float_as_uint(pmax), __float_as_uint(pmax), false, false);
    pmax = fmaxf(__uint_as_float(rr[0]), __uint_as_float(rr[1])); }
  if (__builtin_expect(__all(pmax - m_reg <= THR / SCALE), 1)) { mn = m_reg; alpha = 1.f; }
  else { mn = fmaxf(m_reg, pmax); alpha = __builtin_amdgcn_exp2f((m_reg - mn) * C); m_reg = mn; }
  float mnC = -mn * C;
  for (int r = 0; r < 16; ++r) p0[r] = fmaf(p0[r], C, mnC); for (int r = 0; r < 16; ++r) p1[r] = fmaf(p1[r], C, mnC);
  for (int r = 0; r < 16; ++r) p0[r] = __builtin_amdgcn_exp2f(p0[r]);
}
__device__ __forceinline__ void finishSM(f32x16& p0, f32x16& p1, float alpha, float& l_reg, bf16x8& pa0, bf16x8& pa1, bf16x8& pa2, bf16x8& pa3) {
  for (int r = 0; r < 16; ++r) p1[r] = __builtin_amdgcn_exp2f(p1[r]);
  float ps = 0; for (int r = 0; r < 16; ++r) ps += p0[r]; for (int r = 0; r < 16; ++r) ps += p1[r];
  { auto rr = __builtin_amdgcn_permlane32_swap(__float_as_uint(ps), __float_as_uint(ps), false, false);
    ps = __uint_as_float(rr[0]) + __uint_as_float(rr[1]); }
  l_reg = l_reg * alpha + ps;
#define PK4(P, BASE, OUT) do { unsigned a0 = cvtpk(P[BASE + 0], P[BASE + 1]), a1 = cvtpk(P[BASE + 2], P[BASE + 3]);   \
    unsigned b0 = cvtpk(P[BASE + 4], P[BASE + 5]), b1 = cvtpk(P[BASE + 6], P[BASE + 7]);                              \
    auto r0 = __builtin_amdgcn_permlane32_swap(a0, b0, false, false); auto r1 = __builtin_amdgcn_permlane32_swap(a1, b1, false, false); \
    u32x4 w = {r0[0], r1[0], r0[1], r1[1]}; OUT = *reinterpret_cast<bf16x8*>(&w); } while (0)
  PK4(p0, 0, pa0); PK4(p0, 8, pa1); PK4(p1, 0, pa2); PK4(p1, 8, pa3);
#undef PK4
}
__device__ __forceinline__ void qkt(f32x16& p0, f32x16& p1, const bf16* Ks, const bf16x8* qr, int r32, int hi) {
  p0 = f32x16{}; p1 = f32x16{};
  for (int d0 = 0; d0 < 8; ++d0) { int cb = (d0 * 16 + hi * 8) * 2;
    bf16x8 b0 = *reinterpret_cast<const bf16x8*>((const char*)Ks + KSWZ(r32, cb));
    bf16x8 b1 = *reinterpret_cast<const bf16x8*>((const char*)Ks + KSWZ(32 + r32, cb));
    p0 = __builtin_amdgcn_mfma_f32_32x32x16_bf16(b0, qr[d0], p0, 0, 0, 0);
    p1 = __builtin_amdgcn_mfma_f32_32x32x16_bf16(b1, qr[d0], p1, 0, 0, 0); }
}
__device__ __forceinline__ int v_st(int k, int c) { const int kk = (k & ~0xC) | ((k & 4) << 1) | ((k & 8) >> 1); return ((kk >> 3) * 4 + (c >> 5)) * 512 + ((kk & 7) * 32 + (c & 31)) * 2; }
__device__ __forceinline__ int v_rd_base(int lane) { return ((lane & 3) << 3) | (((lane >> 2) & 3) << 6) | (((lane >> 4) & 1) << 5) | (((lane >> 5) & 1) << 8); }
constexpr int v_rd_off(int d0, int ks, int half) { return d0 * 512 + ks * 4096 + half * 2048; }
template <int OFF> __device__ __forceinline__ s16x4 tr_read(int vb) {
  s16x4 r; asm volatile("ds_read_b64_tr_b16 %0, %1 offset:%2" : "=&v"(r) : "v"(vb), "i"(OFF) : "memory"); return r;
}
template <int D0> __device__ __forceinline__ void pv_one(f32x16& od, int vb, bf16x8 pa0, bf16x8 pa1, bf16x8 pa2, bf16x8 pa3) {
  const s16x4 l0 = tr_read<v_rd_off(D0, 0, 0)>(vb), h0 = tr_read<v_rd_off(D0, 0, 1)>(vb), l1 = tr_read<v_rd_off(D0, 1, 0)>(vb), h1 = tr_read<v_rd_off(D0, 1, 1)>(vb);
  const s16x4 l2 = tr_read<v_rd_off(D0, 2, 0)>(vb), h2 = tr_read<v_rd_off(D0, 2, 1)>(vb), l3 = tr_read<v_rd_off(D0, 3, 0)>(vb), h3 = tr_read<v_rd_off(D0, 3, 1)>(vb);
  asm volatile("s_waitcnt lgkmcnt(0)" ::: "memory"); SBAR();
#define PK(L, H) (bf16x8){L[0], L[1], L[2], L[3], H[0], H[1], H[2], H[3]}
  od = __builtin_amdgcn_mfma_f32_32x32x16_bf16(pa0, PK(l0, h0), od, 0, 0, 0);
  od = __builtin_amdgcn_mfma_f32_32x32x16_bf16(pa1, PK(l1, h1), od, 0, 0, 0);
  od = __builtin_amdgcn_mfma_f32_32x32x16_bf16(pa2, PK(l2, h2), od, 0, 0, 0);
  od = __builtin_amdgcn_mfma_f32_32x32x16_bf16(pa3, PK(l3, h3), od, 0, 0, 0);
#undef PK
}
__device__ __forceinline__ void pv_d0(f32x16* o, int vb, bf16x8 pa0, bf16x8 pa1, bf16x8 pa2, bf16x8 pa3) {
  pv_one<0>(o[0], vb, pa0, pa1, pa2, pa3); pv_one<1>(o[1], vb, pa0, pa1, pa2, pa3); pv_one<2>(o[2], vb, pa0, pa1, pa2, pa3); pv_one<3>(o[3], vb, pa0, pa1, pa2, pa3);
}

template <typename TQ>
__device__ __forceinline__ void attn_dense_body(const TQ* __restrict__ Qb, const bf16* __restrict__ Kh, const bf16* __restrict__ Vh,
                                                bf16* __restrict__ Ob, int seq, char* lds) {
  using St = Stage<bf16>; using SQ = Stage<TQ>;
  const int tid = threadIdx.x, wid = tid >> 6, lane = tid & 63, r32 = lane & 31, hi = lane >> 5;
  bf16* V_lds = (bf16*)lds; bf16* K_lds = (bf16*)(lds + 2 * SHM_V);
  float* ws = (float*)(lds + 2 * SHM_V + 2 * SHM_K) + wid * 64; float* li_l = ws; float* al_l = ws + 32;
  float m_reg = -1e30f, l_reg = 0; f32x16 o[4] = {}; bf16x8 qr[8];
  const TQ* Qw = Qb + (long)(wid * QBLK + r32) * LDQ + hi * 8;
#pragma unroll
  for (int d0 = 0; d0 < 8; ++d0) qr[d0] = SQ::tobf(SQ::ld8(Qw + d0 * 16));
  const int sr = tid >> 4, sc = (tid & 15) * 8, vst0 = v_st(sr, sc), vst1 = v_st(32 + sr, sc);
  const int vb0 = (int)(uintptr_t)V_lds + v_rd_base(lane);
  struct { typename St::T vs0, vs1, ks0, ks1; } sr_[SDEPTH];
#define SLOAD(i, k0) do { sr_[i].vs0 = St::ld8(&Vh[(long)((k0) + sr) * LDK + sc]); sr_[i].vs1 = St::ld8(&Vh[(long)((k0) + 32 + sr) * LDK + sc]); \
    sr_[i].ks0 = St::ld8(&Kh[(long)((k0) + sr) * LDK + sc]); sr_[i].ks1 = St::ld8(&Kh[(long)((k0) + 32 + sr) * LDK + sc]); } while (0)
#define SWRITE(b, i) do { *(bf16x8*)((char*)V_lds + (b) * SHM_V + vst0) = St::tobf(sr_[i].vs0);          \
    *(bf16x8*)((char*)V_lds + (b) * SHM_V + vst1) = St::tobf(sr_[i].vs1); int kc = sc * 2;               \
    *(bf16x8*)((char*)K_lds + (b) * SHM_K + KSWZ(sr, kc)) = St::tobf(sr_[i].ks0);                       \
    *(bf16x8*)((char*)K_lds + (b) * SHM_K + KSWZ(32 + sr, kc)) = St::tobf(sr_[i].ks1); } while (0)
#define SWAIT() do { if constexpr (SDEPTH == 2) asm volatile("s_waitcnt vmcnt(4)" ::: "memory"); else asm volatile("s_waitcnt vmcnt(0)" ::: "memory"); } while (0)
#define RESC(a) do { if (__any((a) < 1.f)) { if (hi == 0) al_l[r32] = (a); asm volatile("s_waitcnt lgkmcnt(0)" ::: "memory"); \
    for (int d = 0; d < 4; ++d) for (int r = 0; r < 16; ++r) o[d][r] *= al_l[crow(r, hi)]; } } while (0)
  f32x16 pA0, pA1, pB0, pB1; float mnA, mnB, alA, alB; bf16x8 pa0, pa1, pa2, pa3; const int NT = seq / KVBLK;
  constexpr int SE = 0, SO = SDEPTH - 1;
  SLOAD(SE, 0); asm volatile("s_waitcnt vmcnt(0)" ::: "memory"); SWRITE(0, SE); __syncthreads();
  qkt(pA0, pA1, K_lds, qr, r32, hi); partialSM(pA0, pA1, m_reg, mnA, alA);
  SLOAD(SO, KVBLK); if constexpr (SDEPTH == 2) { if (2 < NT) SLOAD(SE, 2 * KVBLK); }
  SWAIT(); SWRITE(1, SO); __syncthreads();
  for (int j = 1; j + 1 < NT; j += 2) {
    SBAR(); qkt(pB0, pB1, (bf16*)((char*)K_lds + SHM_K), qr, r32, hi);
    finishSM(pA0, pA1, alA, l_reg, pa0, pa1, pa2, pa3); SBAR();
    SLOAD(SO, (j + SDEPTH) * KVBLK); SBAR();
    pv_d0(o, vb0, pa0, pa1, pa2, pa3); partialSM(pB0, pB1, m_reg, mnB, alB);
    __syncthreads(); SWAIT(); SWRITE(0, SE);
    RESC(alB); __syncthreads();
    SBAR(); qkt(pA0, pA1, K_lds, qr, r32, hi);
    finishSM(pB0, pB1, alB, l_reg, pa0, pa1, pa2, pa3); SBAR();
    if (SDEPTH == 1 || j + 3 < NT) SLOAD(SE, (j + 1 + SDEPTH) * KVBLK); SBAR();
    pv_d0(o, vb0 + (int)SHM_V, pa0, pa1, pa2, pa3); partialSM(pA0, pA1, m_reg, mnA, alA);
    __syncthreads(); SWAIT(); SWRITE(1, SO);
    RESC(alA); __syncthreads();
  }
  SBAR(); qkt(pB0, pB1, (bf16*)((char*)K_lds + SHM_K), qr, r32, hi);
  finishSM(pA0, pA1, alA, l_reg, pa0, pa1, pa2, pa3); SBAR();
  pv_d0(o, vb0, pa0, pa1, pa2, pa3); partialSM(pB0, pB1, m_reg, mnB, alB);
  __syncthreads(); RESC(alB);
  finishSM(pB0, pB1, alB, l_reg, pa0, pa1, pa2, pa3); SBAR();
  pv_d0(o, vb0 + (int)SHM_V, pa0, pa1, pa2, pa3);
  if (hi == 0) li_l[r32] = l_reg; asm volatile("s_waitcnt lgkmcnt(0)" ::: "memory");
  float rli[16];
#pragma unroll
  for (int r = 0; r < 16; ++r) rli[r] = __builtin_amdgcn_rcpf(li_l[crow(r, hi)]);
  bf16* Ow = Ob + (long)(wid * QBLK) * LDO;
#pragma unroll
  for (int r = 0; r < 16; ++r) { int orow = crow(r, hi);
    for (int d0 = 0; d0 < 4; ++d0) Ow[(long)orow * LDO + d0 * 32 + r32] = __float2bfloat16(o[d0][r] * rli[r]); }
#undef SLOAD
#undef SWRITE
#undef SWAIT
#undef RESC
}
}
#define LAS __attribute__((address_space(3)))
typedef __hip_bfloat16 bf16;
typedef float f32x4v __attribute__((ext_vector_type(4)));
typedef unsigned u32x4v __attribute__((ext_vector_type(4)));
typedef unsigned u32x2v __attribute__((ext_vector_type(2)));
constexpr int DM = 1024, NCTX = 4096, NLAT = 16384, MTOK = NCTX + NLAT, DFF = 2816, NQKV = 1536, EVIN = 2048, LCTX = 256, LLAT = 4096, PAST = 512, SKV = PAST + LLAT;
constexpr float EPS = 1e-6f;
constexpr size_t MiB = 1u << 20;
constexpr size_t WS_MODS = 0;
constexpr size_t WS_GP = 256 * 1024, WS_SWF1 = 384 * 1024, WS_SWQKV = 640 * 1024, WS_SS = 672 * 1024;
constexpr size_t WS_WIN = 1 * MiB, WS_WOUT = 5 * MiB, WS_WQKV = 7 * MiB, WS_WO = 10 * MiB, WS_WF1 = 12 * MiB, WF1_STRIDE = 11 * MiB, WS_WF2 = 34 * MiB, WF2_STRIDE = (size_t)DM * DFF * 2;
constexpr size_t WS_H = 46 * MiB;
constexpr size_t WS_B = 86 * MiB;
constexpr size_t WS_P = WS_B, WS_MX = WS_B + 80 * MiB;
constexpr size_t WS_ACT = WS_B;
constexpr size_t WS_O = WS_B;
constexpr size_t WS_QKV = WS_B, WS_Q = WS_B + 60 * MiB, WS_KLAT = WS_B + 100 * MiB, WS_VLAT = WS_B + 109 * MiB, WS_KCTX = WS_B + 118 * MiB, WS_VCTX = WS_B + 120 * MiB;
constexpr size_t WS_XB = 208 * MiB, WS_END = 248 * MiB;
constexpr size_t WS_BAR = 992 * 1024, WS_ZERO_BEGIN = WS_SS, WS_ZERO_BYTES = 1 * MiB - WS_SS;
constexpr int LDS_BYTES = 135168;
constexpr int NPHASE = 14;

struct Params { const float* in[22]; float* out; unsigned char* ws; int ph_lo, ph_hi; };

__device__ __forceinline__ float wave_sum(float v) {
#pragma unroll
    for (int o = 1; o < 64; o <<= 1) v += __shfl_xor(v, o);
    return v;
}
__device__ __forceinline__ unsigned f2bf(float f) { unsigned u = __builtin_bit_cast(unsigned, f); return (u + 0x7fffu + ((u >> 16) & 1u)) >> 16; }
__device__ __forceinline__ unsigned pk2(float lo, float hi) { return f2bf(lo) | (f2bf(hi) << 16); }
__device__ __forceinline__ float bf_lo(unsigned w) { return __builtin_bit_cast(float, w << 16); }
__device__ __forceinline__ float bf_hi(unsigned w) { return __builtin_bit_cast(float, w & 0xffff0000u); }
__device__ __forceinline__ float bf1(unsigned short h) { return __builtin_bit_cast(float, (unsigned)h << 16); }

__device__ __forceinline__ void ld8f(const unsigned short* ptr, float* f) { const u32x4v w = *(const u32x4v*)ptr; f[0] = bf_lo(w.x); f[1] = bf_hi(w.x); f[2] = bf_lo(w.y); f[3] = bf_hi(w.y); f[4] = bf_lo(w.z); f[5] = bf_hi(w.z); f[6] = bf_lo(w.w); f[7] = bf_hi(w.w); }
__device__ __forceinline__ void transpose_item(const float* W, int N, int k0, int n0, unsigned short* WT, int ldk, int dst_row0, int dst_k0, LAS float* scr, int lane) {
    float tv[32];
#pragma unroll
    for (int i = 0; i < 32; ++i) tv[i] = W[(size_t)(k0 + 2 * i + (lane >> 5)) * N + n0 + (lane & 31)];
#pragma unroll
    for (int i = 0; i < 32; ++i) scr[(2 * i + (lane >> 5)) * 33 + (lane & 31)] = tv[i];
    asm volatile("s_waitcnt lgkmcnt(0)" ::: "memory");
    const int c = lane & 7;
#pragma unroll
    for (int j = 0; j < 4; ++j) { const int n = (lane >> 3) + 8 * j; const LAS float* s = scr + (8 * c) * 33 + n;
        u32x4v o; o.x = pk2(s[0 * 33], s[1 * 33]); o.y = pk2(s[2 * 33], s[3 * 33]); o.z = pk2(s[4 * 33], s[5 * 33]); o.w = pk2(s[6 * 33], s[7 * 33]);
        *(u32x4v*)(WT + (size_t)(dst_row0 + n) * ldk + dst_k0 + k0 + 8 * c) = o; }
    asm volatile("s_waitcnt lgkmcnt(0)" ::: "memory");
}

__device__ __forceinline__ void phase_prep(const Params& p, LAS unsigned char* lds, int tid, int lane, int wave) {
    unsigned char* ws = p.ws;
    {
        LAS float* sc = (LAS float*)lds;
        LAS float* red = (LAS float*)(lds + 20480);
        const float* cl = p.in[4]; const float* cctx = p.in[5]; const float* w_ada = p.in[6]; const float* b_ada = p.in[7];
        float* mods = (float*)(ws + WS_MODS);
        if ((int)blockIdx.x < 192) {
            for (int idx = tid; idx < 5 * 1024; idx += 512) { const int j = idx >> 10, k = idx & 1023; const float v = j == 0 ? cctx[k] : cl[(j - 1) * 1024 + k]; sc[idx] = v / (1.0f + __expf(-v)); }
            __syncthreads();
            for (int item = blockIdx.x; item < 192; item += gridDim.x) {
                const int l = item / 96, n0 = (item % 96) * 64;
                float a0 = 0.f, a1 = 0.f, a2 = 0.f, a3 = 0.f, a4 = 0.f;
                const float* wp = w_ada + ((size_t)l * 1024 + wave * 128) * 6144 + n0 + lane;
#pragma unroll 16
                for (int k = 0; k < 128; ++k) { const float wv = wp[(size_t)k * 6144]; const int kk = wave * 128 + k;
                    a0 += sc[kk] * wv; a1 += sc[1024 + kk] * wv; a2 += sc[2048 + kk] * wv; a3 += sc[3072 + kk] * wv; a4 += sc[4096 + kk] * wv; }
                red[(wave * 5 + 0) * 64 + lane] = a0; red[(wave * 5 + 1) * 64 + lane] = a1; red[(wave * 5 + 2) * 64 + lane] = a2; red[(wave * 5 + 3) * 64 + lane] = a3; red[(wave * 5 + 4) * 64 + lane] = a4;
                __syncthreads();
                if (tid < 320) { const int j = tid >> 6, ln = tid & 63; float s = b_ada[l * 6144 + n0 + ln];
#pragma unroll
                    for (int w = 0; w < 8; ++w) s += red[(w * 5 + j) * 64 + ln];
                    mods[(size_t)(l * 5 + j) * 6144 + n0 + ln] = s; }
                __syncthreads();
            }
        }
    }
    {
        LAS float* scr = (LAS float*)(lds + 32768 + wave * 8704);
        const int gw = blockIdx.x * 8 + wave, NGW = gridDim.x * 8;
        constexpr int I_IN = 16 * 64, I_QKV = 16 * 48, I_O = 16 * 32, I_OUT = 8 * 32, I_F1 = 16 * 176, I_F2 = 44 * 32, I_FOLD = 1024;
        constexpr int NITEMS = I_IN + I_QKV + I_O + I_OUT + 2 * I_F1 + 2 * I_F2 + I_FOLD;
        for (int it = gw; it < NITEMS; it += NGW) {
            int r = it;
            if (r < I_IN) { const int kb = r / 64, nb = r % 64; transpose_item(p.in[9], EVIN, kb * 64, nb * 32, (unsigned short*)(ws + WS_WIN), 1024, nb * 32, 0, scr, lane); continue; } r -= I_IN;
            if (r < I_QKV) { const int kb = r / 48, nb = r % 48; transpose_item(p.in[15], NQKV, kb * 64, nb * 32, (unsigned short*)(ws + WS_WQKV), 1024, nb * 32, 0, scr, lane); continue; } r -= I_QKV;
            if (r < I_O) { const int kb = r / 32, nb = r % 32; transpose_item(p.in[18], DM, kb * 64, nb * 32, (unsigned short*)(ws + WS_WO), 1024, nb * 32, 0, scr, lane); continue; } r -= I_O;
            if (r < I_OUT) { const int kb = r / 32, nb = r % 32; transpose_item(p.in[14] + (size_t)512 * 1024, DM, kb * 64, nb * 32, (unsigned short*)(ws + WS_WOUT), 1024, nb * 32, 512, scr, lane); continue; } r -= I_OUT;
            if (r < 2 * I_F1) { const int l = r / I_F1, q = r % I_F1, kb = q / 176, nb = q % 176, n0 = nb * 32;
                const int part = n0 >= DFF, jj = n0 - part * DFF, drow = (jj >> 7) * 256 + part * 128 + (jj & 127);
                transpose_item(p.in[19] + (size_t)l * DM * 2 * DFF, 2 * DFF, kb * 64, n0, (unsigned short*)(ws + WS_WF1 + l * WF1_STRIDE), 1024, drow, 0, scr, lane); continue; } r -= 2 * I_F1;
            if (r < 2 * I_F2) { const int l = r / I_F2, q = r % I_F2, kb = q / 32, nb = q % 32;
                transpose_item(p.in[20] + (size_t)l * DFF * DM, DM, kb * 64, nb * 32, (unsigned short*)(ws + WS_WF2 + l * WF2_STRIDE), DFF, nb * 32, 0, scr, lane); continue; } r -= 2 * I_F2;
            {
                const int g = r >> 8, cc = (r >> 4) & 15, nb = r & 15, n = nb * 64 + lane;
                const float* pw = p.in[10] + ((size_t)g * 128 + cc * 8) * 128; const float* psc = p.in[11] + g * 128; const float* wo = p.in[14] + (size_t)(g * 128) * 1024 + n;
                float a[8] = {0.f, 0.f, 0.f, 0.f, 0.f, 0.f, 0.f, 0.f};
                for (int d = 0; d < 128; ++d) { const float wv = psc[d] * wo[(size_t)d * 1024];
#pragma unroll
                    for (int c = 0; c < 8; ++c) a[c] += pw[c * 128 + d] * wv; }
                u32x4v o; o.x = pk2(a[0], a[1]); o.y = pk2(a[2], a[3]); o.z = pk2(a[4], a[5]); o.w = pk2(a[6], a[7]);
                *(u32x4v*)((unsigned short*)(ws + WS_WOUT) + (size_t)n * 1024 + g * 128 + cc * 8) = o;
            }
        }
    }
}

__device__ __forceinline__ void phase_p1(const Params& p, int tid, int lane, int wave) {
    unsigned char* ws = p.ws;
    const float* mods = (const float*)(ws + WS_MODS); const float* norm_g = p.in[8];
    const int gw = blockIdx.x * 8 + wave, NGW = gridDim.x * 8;
    {   float* gp = (float*)(ws + WS_GP);
        for (int idx = blockIdx.x * 512 + tid; idx < 3 * 5 * 1024; idx += gridDim.x * 512) { const int site = idx / 5120, j = (idx >> 10) % 5, c = idx & 1023, l = site >= 1, nrm = site != 1;
            gp[idx] = norm_g[(l * 2 + nrm) * 1024 + c] * (1.0f + mods[(size_t)(l * 5 + j) * 6144 + (nrm ? 4 : 1) * 1024 + c]); } }
#pragma unroll 1
    for (int site = 0; site < 3; ++site) {
        const int N = site == 1 ? NQKV : 2 * DFF, l = site >= 1, chunk = site == 1 ? 0 : 3;
        const unsigned short* Wt = (const unsigned short*)(ws + (site == 0 ? WS_WF1 : site == 1 ? WS_WQKV : WS_WF1 + WF1_STRIDE));
        float* dst = site == 1 ? (float*)(ws + WS_SWQKV) : (float*)(ws + WS_SWF1) + (site == 2) * 5 * 2 * DFF;
        if (gw < N) {
            float sh[5][16];
#pragma unroll
            for (int j = 0; j < 5; ++j) { const float* sp = mods + (size_t)(l * 5 + j) * 6144 + chunk * 1024 + 8 * lane;
#pragma unroll
                for (int q = 0; q < 4; ++q) { const f32x4v v = *(const f32x4v*)(sp + (q >> 1) * 512 + (q & 1) * 4); sh[j][4 * q] = v.x; sh[j][4 * q + 1] = v.y; sh[j][4 * q + 2] = v.z; sh[j][4 * q + 3] = v.w; } }
            for (int col = gw; col < N; col += NGW) {
                float f[16]; ld8f(Wt + (size_t)col * 1024 + 8 * lane, f); ld8f(Wt + (size_t)col * 1024 + 512 + 8 * lane, f + 8);
                float a[5];
#pragma unroll
                for (int j = 0; j < 5; ++j) { float s = 0.f;
#pragma unroll
                    for (int q = 0; q < 16; ++q) s += sh[j][q] * f[q];
                    a[j] = wave_sum(s); }
                if (lane == 0) {
#pragma unroll
                    for (int j = 0; j < 5; ++j) dst[(size_t)j * N + col] = a[j]; }
            }
        }
    }
    const float* xc = p.in[0]; const float* xl = p.in[1]; unsigned short* h = (unsigned short*)(ws + WS_H);
    for (int it = gw; it < MTOK / 4; it += NGW) {
        f32x4v v[4][4]; float ss[4];
#pragma unroll
        for (int rr = 0; rr < 4; ++rr) { const int row = it + rr * (MTOK / 4); const float* xr = row < NCTX ? xc + (size_t)row * DM : xl + (size_t)(row - NCTX) * DM;
#pragma unroll
            for (int q = 0; q < 4; ++q) v[rr][q] = *(const f32x4v*)(xr + 4 * lane + 256 * q); }
#pragma unroll
        for (int rr = 0; rr < 4; ++rr) { float s = 0.f;
#pragma unroll
            for (int q = 0; q < 4; ++q) s += (v[rr][q].x * v[rr][q].x + v[rr][q].y * v[rr][q].y) + (v[rr][q].z * v[rr][q].z + v[rr][q].w * v[rr][q].w);
            ss[rr] = s; }
#pragma unroll
        for (int rr = 0; rr < 4; ++rr) { const int row = it + rr * (MTOK / 4); const int j = row < NCTX ? 0 : 1 + ((row - NCTX) >> 12);
            const float rstd = __builtin_amdgcn_rsqf(wave_sum(ss[rr]) * (1.0f / DM) + EPS);
            const float* shp = mods + (size_t)j * 6144; const float* scp = shp + 1024;
#pragma unroll
            for (int q = 0; q < 4; ++q) { const int c = 4 * lane + 256 * q;
                const f32x4v gg = *(const f32x4v*)(norm_g + c), sc = *(const f32x4v*)(scp + c), shv = *(const f32x4v*)(shp + c);
                const f32x4v o = (v[rr][q] * rstd) * gg * (sc + 1.0f) + shv;
                u32x2v w; w.x = pk2(o.x, o.y); w.y = pk2(o.z, o.w);
                *(u32x2v*)(h + (size_t)row * DM + c) = w; } }
    }
}
__device__ __forceinline__ void phase_final(const unsigned short* xb, float* y, const float* g, const float* ss, int lane, int wave) {
    const int gw = blockIdx.x * 8 + wave, NGW = gridDim.x * 8;
    f32x4v gg[4];
#pragma unroll
    for (int q = 0; q < 4; ++q) gg[q] = *(const f32x4v*)(g + 4 * lane + 256 * q);
    for (int it = gw; it < MTOK / 4; it += NGW) {
        u32x2v v[4][4]; float rs[4];
#pragma unroll
        for (int rr = 0; rr < 4; ++rr) { const int row = it + rr * (MTOK / 4); rs[rr] = __builtin_amdgcn_rsqf(ss[row] * (1.0f / DM) + EPS);
#pragma unroll
            for (int q = 0; q < 4; ++q) v[rr][q] = *(const u32x2v*)(xb + (size_t)row * DM + 4 * lane + 256 * q); }
#pragma unroll
        for (int rr = 0; rr < 4; ++rr) { const int row = it + rr * (MTOK / 4);
#pragma unroll
            for (int q = 0; q < 4; ++q) { const f32x4v x = {bf_lo(v[rr][q].x), bf_hi(v[rr][q].x), bf_lo(v[rr][q].y), bf_hi(v[rr][q].y)};
                *(f32x4v*)(y + (size_t)row * DM + 4 * lane + 256 * q) = (x * rs[rr]) * gg[q]; } }
    }
}
__device__ __forceinline__ void phase_mixer(const unsigned short* P, unsigned short* MX, const float* conv_w, const float* conv_b, int lane, int wave) {
    const int gw = blockIdx.x * 8 + wave, NGW = gridDim.x * 8;
    const int c0 = 8 * lane, half = 1 << (lane >> 4);
    for (int it = gw; it < 2 * (MTOK / 8); it += NGW) {
        const int type = it & 1, row0 = (it >> 1) * 8;
        int t0, L; if (row0 < NCTX) { t0 = row0 & (LCTX - 1); L = LCTX; } else { t0 = (row0 - NCTX) & (LLAT - 1); L = LLAT; }
        const unsigned short* pr = P + (size_t)row0 * EVIN;
        if (type == 0) {
            float S[8] = {0.f, 0.f, 0.f, 0.f, 0.f, 0.f, 0.f, 0.f}, f[8];
#pragma unroll
            for (int k = 0; k < 16; ++k) { const int s = t0 - half + k; const float wgt = (k < 2 * half && s >= 0 && s < L) ? 1.f : 0.f; const int sc = min(max(s, 0), L - 1);
                ld8f(pr + (ptrdiff_t)(sc - t0) * EVIN + c0, f);
#pragma unroll
                for (int i = 0; i < 8; ++i) S[i] += wgt * f[i]; }
#pragma unroll
            for (int r = 0; r < 8; ++r) { const int t = t0 + r; const int lo = max(t - half, 0), hi = min(t + half, L); const float inv = 1.0f / (float)(hi - lo);
                ld8f(pr + (size_t)r * EVIN + c0, f);
                u32x4v o; o.x = pk2(S[0] * inv - f[0], S[1] * inv - f[1]); o.y = pk2(S[2] * inv - f[2], S[3] * inv - f[3]); o.z = pk2(S[4] * inv - f[4], S[5] * inv - f[5]); o.w = pk2(S[6] * inv - f[6], S[7] * inv - f[7]);
                *(u32x4v*)(MX + (size_t)(row0 + r) * DM + c0) = o;
                if (r < 7) {
                    { const int s = t + half; const float wgt = s < L ? 1.f : 0.f; ld8f(pr + (ptrdiff_t)(min(s, L - 1) - t0) * EVIN + c0, f);
#pragma unroll
                      for (int i = 0; i < 8; ++i) S[i] += wgt * f[i]; }
                    { const int s = t - half; const float wgt = s >= 0 ? 1.f : 0.f; ld8f(pr + (ptrdiff_t)(max(s, 0) - t0) * EVIN + c0, f);
#pragma unroll
                      for (int i = 0; i < 8; ++i) S[i] -= wgt * f[i]; } } }
        } else {
            float cw0[8], cw1[8], cw2[8], cb[8];
#pragma unroll
            for (int i = 0; i < 8; ++i) { cw0[i] = conv_w[c0 + i]; cw1[i] = conv_w[512 + c0 + i]; cw2[i] = conv_w[1024 + c0 + i]; cb[i] = conv_b[c0 + i]; }
            float zp[8], zc[8], zn[8], a[8], b[8];
            if (t0 > 0) { ld8f(pr - EVIN + 1024 + c0, a); ld8f(pr - EVIN + 1536 + c0, b);
#pragma unroll
                for (int i = 0; i < 8; ++i) zp[i] = a[i] * b[i]; }
            else {
#pragma unroll
                for (int i = 0; i < 8; ++i) zp[i] = 0.f; }
            ld8f(pr + 1024 + c0, a); ld8f(pr + 1536 + c0, b);
#pragma unroll
            for (int i = 0; i < 8; ++i) zc[i] = a[i] * b[i];
#pragma unroll
            for (int r = 0; r < 8; ++r) { const int t = t0 + r;
                if (t + 1 < L) { ld8f(pr + (size_t)(r + 1) * EVIN + 1024 + c0, a); ld8f(pr + (size_t)(r + 1) * EVIN + 1536 + c0, b);
#pragma unroll
                    for (int i = 0; i < 8; ++i) zn[i] = a[i] * b[i]; }
                else {
#pragma unroll
                    for (int i = 0; i < 8; ++i) zn[i] = 0.f; }
                ld8f(pr + (size_t)r * EVIN + 512 + c0, a);
                float y[8];
#pragma unroll
                for (int i = 0; i < 8; ++i) y[i] = a[i] * (zp[i] * cw0[i] + zc[i] * cw1[i] + zn[i] * cw2[i] + cb[i]);
                u32x4v o; o.x = pk2(y[0], y[1]); o.y = pk2(y[2], y[3]); o.z = pk2(y[4], y[5]); o.w = pk2(y[6], y[7]);
                *(u32x4v*)(MX + (size_t)(row0 + r) * DM + 512 + c0) = o;
#pragma unroll
                for (int i = 0; i < 8; ++i) { zp[i] = zc[i]; zc[i] = zn[i]; } }
        }
    }
}
__device__ __forceinline__ void phase_qknorm(const Params& p, int lane, int wave) {
    unsigned char* ws = p.ws;
    const unsigned short* QKV = (const unsigned short*)(ws + WS_QKV);
    unsigned short* Q = (unsigned short*)(ws + WS_Q); unsigned short* KLAT = (unsigned short*)(ws + WS_KLAT); unsigned short* VLAT = (unsigned short*)(ws + WS_VLAT);
    unsigned short* KCTX = (unsigned short*)(ws + WS_KCTX); unsigned short* VCTX = (unsigned short*)(ws + WS_VCTX);
    float* nck = p.out + (size_t)MTOK * DM; float* ncv = nck + (size_t)16 * 256 * 256;
    const int gw = blockIdx.x * 8 + wave, NGW = gridDim.x * 8;
    const int i8 = 8 * (lane & 15), hsel = lane >> 4;
    const bool colaxis = (i8 >> 6) != 0, second = ((i8 >> 5) & 1) != 0;
    float qg[8], kg[8], invf[8];
#pragma unroll
    for (int q = 0; q < 8; ++q) { qg[q] = p.in[16][i8 + q]; kg[q] = p.in[17][i8 + q]; invf[q] = __builtin_amdgcn_exp2f(-(float)((i8 & 31) + q) * (13.287712379549449f / 32.0f)); }
    for (int row = gw; row < MTOK; row += NGW) {
        const unsigned short* r = QKV + (size_t)row * NQKV + 8 * lane;
        const u32x4v w0 = *(const u32x4v*)(r), w1 = *(const u32x4v*)(r + 512), w2 = *(const u32x4v*)(r + 1024);
        const bool lat = row >= NCTX; int b, t; float cs[8], sn[8];
        if (lat) { const int rr = row - NCTX; b = rr >> 12; t = rr & 4095; const float pos = (float)(colaxis ? (t & 63) : (t >> 6));
#pragma unroll
            for (int q = 0; q < 8; ++q) { const float ang = pos * invf[q]; cs[q] = __cosf(ang); sn[q] = __sinf(ang); if (!second) sn[q] = -sn[q]; } }
        else { b = row >> 8; t = row & 255;
#pragma unroll
            for (int q = 0; q < 8; ++q) { cs[q] = 1.f; sn[q] = 0.f; } }
#pragma unroll
        for (int c = 0; c < 3; ++c) {
            const u32x4v w = c == 0 ? w0 : c == 1 ? w1 : w2;
            float x[8] = {bf_lo(w.x), bf_hi(w.x), bf_lo(w.y), bf_hi(w.y), bf_lo(w.z), bf_hi(w.z), bf_lo(w.w), bf_hi(w.w)};
            float s = 0.f;
#pragma unroll
            for (int q = 0; q < 8; ++q) s += x[q] * x[q];
            s += __shfl_xor(s, 1); s += __shfl_xor(s, 2); s += __shfl_xor(s, 4); s += __shfl_xor(s, 8);
            const float rstd = __builtin_amdgcn_rsqf(s * (1.0f / 128.0f) + EPS);
            float o[8];
#pragma unroll
            for (int q = 0; q < 8; ++q) { const float y = x[q] * rstd * (c < 2 ? qg[q] : kg[q]); const float yp = __shfl_xor(y, 4); o[q] = y * cs[q] + yp * sn[q]; }
            if (c < 2) { u32x4v ow; ow.x = pk2(o[0], o[1]); ow.y = pk2(o[2], o[3]); ow.z = pk2(o[4], o[5]); ow.w = pk2(o[6], o[7]);
                *(u32x4v*)(Q + (size_t)row * DM + c * 512 + 8 * lane) = ow; }
            else {
                const int kh = hsel & 1; const bool isv = hsel >= 2;
                u32x4v ow = w;
                if (!isv) { ow.x = pk2(o[0], o[1]); ow.y = pk2(o[2], o[3]); ow.z = pk2(o[4], o[5]); ow.w = pk2(o[6], o[7]); }
                if (lat) { unsigned short* dst = (isv ? VLAT : KLAT) + ((size_t)(b * 2 + kh) * SKV + PAST + t) * 128 + i8; *(u32x4v*)dst = ow; }
                else { unsigned short* dst = (isv ? VCTX : KCTX) + ((size_t)(b * 2 + kh) * LCTX + t) * 128 + i8; *(u32x4v*)dst = ow;
                    float* od = (isv ? ncv : nck) + ((size_t)(b * LCTX + t) * 2 + kh) * 128 + i8;
                    f32x4v f0, f1;
                    if (isv) { f0 = (f32x4v){x[0], x[1], x[2], x[3]}; f1 = (f32x4v){x[4], x[5], x[6], x[7]}; } else { f0 = (f32x4v){o[0], o[1], o[2], o[3]}; f1 = (f32x4v){o[4], o[5], o[6], o[7]}; }
                    *(f32x4v*)od = f0; *(f32x4v*)(od + 4) = f1; }
            }
        }
    }
    for (int it = gw; it < 2 * 4 * PAST; it += NGW) {
        const int which = it >> 11, q = it & 2047, b = q >> 9, s = q & 511, kh = lane >> 5;
        const f32x4v v = *(const f32x4v*)((which ? p.in[3] : p.in[2]) + (size_t)(b * PAST + s) * 256 + 4 * lane);
        u32x2v w; w.x = pk2(v.x, v.y); w.y = pk2(v.z, v.w);
        *(u32x2v*)((which ? VLAT : KLAT) + ((size_t)(b * 2 + kh) * SKV + s) * 128 + 4 * (lane & 31)) = w;
    }
}
__device__ __forceinline__ void phase_attention(const Params& p, char* lds) {
    unsigned char* ws = p.ws;
    const bf16* Q = (const bf16*)(ws + WS_Q); bf16* O = (bf16*)(ws + WS_O);
    const bf16* KLAT = (const bf16*)(ws + WS_KLAT); const bf16* VLAT = (const bf16*)(ws + WS_VLAT); const bf16* KCTX = (const bf16*)(ws + WS_KCTX); const bf16* VCTX = (const bf16*)(ws + WS_VCTX);
    for (int L = blockIdx.x; L < 128 + 512; L += gridDim.x) {
        const bf16* Qp; const bf16* Kp; const bf16* Vp; bf16* Op; int seq;
        if (L < 128) { const int b = L >> 3, h = L & 7; const size_t q0 = (size_t)(b * LCTX) * DM + h * 128, k0 = (size_t)(b * 2 + (h >> 2)) * LCTX * 128;
            Qp = Q + q0; Kp = KCTX + k0; Vp = VCTX + k0; Op = O + q0; seq = LCTX; }
        else { const int u = L - 128, bk = u & 7, w = u >> 3, hq = w >> 4, qb = w & 15, b = bk >> 1, kvh = bk & 1, h = kvh * 4 + hq;
            const size_t q0 = (size_t)(NCTX + b * LLAT + qb * 256) * DM + h * 128, k0 = (size_t)(b * 2 + kvh) * SKV * 128;
            Qp = Q + q0; Kp = KLAT + k0; Vp = VLAT + k0; Op = O + q0; seq = SKV; }
        attn::attn_dense_body<bf16>(Qp, Kp, Vp, Op, seq, lds);
        __syncthreads();
    }
}

#define XB_TMO      128
#define XB_XCNT(j)  (256  + 64 * (j))
#define XB_XSUB(j)  (1280 + 64 * (j))
#define XB_XGEN(j)  (2304 + 64 * (j))
#define XB_TOP      3328
#define XB_TOPGEN   3392
#define XCD_BAR_WORDS 3456
#define XB_SPIN_CAP (1u << 18)

__device__ __forceinline__ unsigned xb_ld(unsigned* p)              { return __hip_atomic_load(p, __ATOMIC_RELAXED, __HIP_MEMORY_SCOPE_AGENT); }
__device__ __forceinline__ unsigned xb_add(unsigned* p, unsigned v) { return __hip_atomic_fetch_add(p, v, __ATOMIC_RELAXED, __HIP_MEMORY_SCOPE_AGENT); }
__device__ __forceinline__ unsigned xb_xcc_id() { return (unsigned)__builtin_amdgcn_s_getreg((3 << 11) | 20) & 0xFu; }
#define XB_SPIN(cond, bar) do { unsigned _sp = 0; while (cond) { __builtin_amdgcn_s_sleep(1); \
    if ((++_sp & 255u) == 0u) { if (xb_ld(&(bar)[XB_TMO])) break; if (_sp > XB_SPIN_CAP) { atomicAdd(&(bar)[XB_TMO], 1u); break; } } } } while (0)

struct XcdBarrier {
    unsigned* bar; unsigned x;
    volatile LAS unsigned* st;
};

__device__ __forceinline__ XcdBarrier xcd_barrier_post(unsigned* bar, volatile LAS unsigned* st) {
    XcdBarrier b; b.bar = bar; b.x = xb_xcc_id(); b.st = st;
    if (threadIdx.x == 0) (void)xb_add(&bar[XB_XCNT(b.x)], 1u);
    return b;
}
__device__ __forceinline__ void xcd_barrier_complete(unsigned* bar, unsigned x, unsigned& nloc, unsigned& nx) {
    const unsigned G = gridDim.x * gridDim.y * gridDim.z;
    unsigned sum, cnt, mine, sp = 0u;
    for (;;) {
        sum = 0u; cnt = 0u; mine = 0u;
#pragma unroll
        for (unsigned j = 0; j < 16; ++j) { const unsigned c = xb_ld(&bar[XB_XCNT(j)]); sum += c; cnt += (c > 0u) ? 1u : 0u; mine = (j == x) ? c : mine; }
        if (sum == G) break;
        __builtin_amdgcn_s_sleep(1);
        if ((++sp & 255u) == 0u) { if (xb_ld(&bar[XB_TMO])) break; if (sp > XB_SPIN_CAP) { atomicAdd(&bar[XB_TMO], 1u); break; } }
    }
    nloc = mine > 0u ? mine : 1u; nx = cnt > 0u ? cnt : 1u;
}

__device__ __forceinline__ void xcd_barrier(const XcdBarrier& b) {
    asm volatile("s_waitcnt vmcnt(0)" ::: "memory");
    __syncthreads();
    if (threadIdx.x == 0) {
        unsigned* bar = b.bar;
        __builtin_amdgcn_s_waitcnt(0);
        unsigned nloc = b.st[0], nx = b.st[1];
        if (nloc == 0u) { xcd_barrier_complete(bar, b.x, nloc, nx); b.st[0] = nloc; b.st[1] = nx; }
        const unsigned old = xb_add(&bar[XB_XSUB(b.x)], 1u);
        const unsigned gen = old / nloc;
        if (old + 1u == (gen + 1u) * nloc) {
            __builtin_amdgcn_fence(__ATOMIC_RELEASE, "agent");
            asm volatile("s_waitcnt vmcnt(0)" ::: "memory");
            const unsigned og = xb_add(&bar[XB_TOP], 1u);
            const unsigned tg = og / nx;
            if (og + 1u == (tg + 1u) * nx) xb_add(&bar[XB_TOPGEN], 1u);
            else XB_SPIN(xb_ld(&bar[XB_TOPGEN]) == tg, bar);
            __builtin_amdgcn_fence(__ATOMIC_ACQUIRE, "agent");
            xb_add(&bar[XB_XGEN(b.x)], 1u);
            asm volatile("s_waitcnt vmcnt(0)" ::: "memory");
        } else {
            XB_SPIN(xb_ld(&bar[XB_XGEN(b.x)]) == gen, bar);
            __builtin_amdgcn_fence(__ATOMIC_ACQUIRE, "agent");
            asm volatile("s_waitcnt vmcnt(0)" ::: "memory");
        }
    }
    __syncthreads();
}

template <int ph> __device__ __forceinline__ void run_phase(const Params& p, unsigned char* lds, int tid, int lane, int wave) {
    unsigned char* ws = p.ws;
    const float* mods = (const float*)(ws + WS_MODS); const float* gp = (const float*)(ws + WS_GP); float* ss = (float*)(ws + WS_SS);
    const float* sWf1 = (const float*)(ws + WS_SWF1); const float* sWqkv = (const float*)(ws + WS_SWQKV);
    float* xo = p.out;
    typedef pg8::bf16_t bt;
    if constexpr (ph == 0) phase_prep(p, (LAS unsigned char*)lds, tid, lane, wave);
    else if constexpr (ph == 1) phase_p1(p, tid, lane, wave);
    else if constexpr (ph == 2) {
        pg8::Gemm g{(const bt*)(ws + WS_H), (const bt*)(ws + WS_WIN), MTOK, EVIN, DM}; pg8::HalfOrder S; S.init(gridDim.x, blockIdx.x, EVIN / 256);
        pg8::EpiStoreN<false> E{(bt*)(ws + WS_P), EVIN, nullptr, nullptr, 0};
        pg8::gemm_phase<pg8::EpiStoreN<false>, pg8::HalfOrder, true, true>((LAS unsigned char*)lds, g, S, E); }
    else if constexpr (ph == 3) phase_mixer((const unsigned short*)(ws + WS_P), (unsigned short*)(ws + WS_MX), p.in[12], p.in[13], lane, wave);
    else if constexpr (ph == 4 || ph == 6 || ph == 10 || ph == 12) {
        constexpr int l = ph >= 10; constexpr bool ffn = (ph == 6 || ph == 12); constexpr int K = ffn ? DFF : DM; constexpr int site = ph == 4 ? 0 : ph == 6 ? 1 : ph == 10 ? 2 : 3;
        const unsigned char* A = ws + (ffn ? WS_ACT : (ph == 4 ? WS_MX : WS_O));
        const unsigned char* Bt = ws + (ffn ? WS_WF2 + l * WF2_STRIDE : (ph == 4 ? WS_WOUT : WS_WO));
        pg8::Gemm g{(const bt*)A, (const bt*)Bt, MTOK, DM, K}; pg8::HalfOrder S; S.init(gridDim.x, blockIdx.x);
        typedef pg8::EpiResNorm<(site < 3), (ph == 4)> Epi;
        Epi E{p.in[0], p.in[1], (bt*)(ws + WS_XB), mods + (size_t)l * 5 * 6144 + (ffn ? 5 : 2) * 1024, gp + (site < 3 ? site : 0) * 5120, (bt*)(ws + WS_H), ss + site * MTOK};
        pg8::gemm_phase<Epi, pg8::HalfOrder, true, true>((LAS unsigned char*)lds, g, S, E); }
    else if constexpr (ph == 5 || ph == 11) { constexpr int l = ph == 11;
        pg8::Gemm g{(const bt*)(ws + WS_H), (const bt*)(ws + WS_WF1 + l * WF1_STRIDE), MTOK, 2 * DFF, DM}; pg8::StaticOrder S; S.init(MTOK, 2 * DFF, gridDim.x, blockIdx.x);
        pg8::EpiSwigluN E{(bt*)(ws + WS_ACT), DFF, ss + (l ? 2 : 0) * MTOK, sWf1 + l * 5 * 2 * DFF, 2 * DFF};
        pg8::gemm_phase<pg8::EpiSwigluN, pg8::StaticOrder, true, true>((LAS unsigned char*)lds, g, S, E); }
    else if constexpr (ph == 7) {
        pg8::Gemm g{(const bt*)(ws + WS_H), (const bt*)(ws + WS_WQKV), MTOK, NQKV, DM}; pg8::StaticOrder S; S.init(MTOK, NQKV, gridDim.x, blockIdx.x);
        pg8::EpiStoreN<true> E{(bt*)(ws + WS_QKV), NQKV, ss + 1 * MTOK, sWqkv, NQKV};
        pg8::gemm_phase<pg8::EpiStoreN<true>, pg8::StaticOrder, true, true>((LAS unsigned char*)lds, g, S, E); }
    else if constexpr (ph == 8) phase_qknorm(p, lane, wave);
    else if constexpr (ph == 9) phase_attention(p, (char*)lds);
    else if constexpr (ph == 13) phase_final((const unsigned short*)(ws + WS_XB), xo, p.in[21], ss + 3 * MTOK, lane, wave);
}
__global__ void __launch_bounds__(512, 2) mega_fwd(Params p) {
    extern __shared__ __attribute__((aligned(16))) unsigned char lds[];
    cg::grid_group grid = cg::this_grid();
    const int tid = threadIdx.x, lane = tid & 63, wave = __builtin_amdgcn_readfirstlane(tid >> 6);
    const bool multi = p.ph_hi - p.ph_lo > 1, use_cg = gridDim.x > 1024u;
    if (tid < 2) ((LAS unsigned*)(lds + 131072))[tid] = 0u;
    __syncthreads();
    XcdBarrier bar; bar.bar = (unsigned*)(p.ws + WS_BAR); bar.x = 0; bar.st = nullptr;
    if (multi && !use_cg) bar = xcd_barrier_post((unsigned*)(p.ws + WS_BAR), (volatile LAS unsigned*)(lds + 131072));
#define SEAM(k) do { if (use_cg) grid.sync(); else xcd_barrier(bar); } while (0)
#define PHASE(k) if (p.ph_lo <= (k) && (k) < p.ph_hi) { run_phase<(k)>(p, lds, tid, lane, wave); if ((k) + 1 < p.ph_hi) SEAM(k); }
    PHASE(0) PHASE(1) PHASE(2) PHASE(3) PHASE(4) PHASE(5) PHASE(6) PHASE(7) PHASE(8) PHASE(9) PHASE(10) PHASE(11) PHASE(12) PHASE(13)
#undef PHASE
}

#ifndef MK_SPLIT
#define MK_SPLIT 0
#endif
extern "C" void kernel_launch(void* const* d_in, const int* in_sizes, int n_in, void* d_out, int out_size, void* d_ws, size_t ws_size, hipStream_t stream) {
    static int grid_blocks = 0;
    if (grid_blocks == 0) {
        if (n_in != 22 || ws_size < WS_END) { fprintf(stderr, "kernel_launch: unexpected n_in %d / ws_size %zu\n", n_in, ws_size); grid_blocks = -1; return; }
        int dev = 0, cus = 0, per_cu = 0;
        (void)hipGetDevice(&dev); (void)hipDeviceGetAttribute(&cus, hipDeviceAttributeMultiprocessorCount, dev);
        if (hipFuncSetAttribute((const void*)mega_fwd, hipFuncAttributeMaxDynamicSharedMemorySize, LDS_BYTES) != hipSuccess) { fprintf(stderr, "kernel_launch: hipFuncSetAttribute failed\n"); grid_blocks = -1; return; }
        if (hipOccupancyMaxActiveBlocksPerMultiprocessor(&per_cu, (const void*)mega_fwd, 512, LDS_BYTES) != hipSuccess || per_cu < 1) { fprintf(stderr, "kernel_launch: occupancy query gave %d\n", per_cu); grid_blocks = -1; return; }
        grid_blocks = cus * per_cu;
    }
    if (grid_blocks < 0) return;
    if (hipMemsetAsync((char*)d_ws + WS_ZERO_BEGIN, 0, WS_ZERO_BYTES, stream) != hipSuccess) { fprintf(stderr, "kernel_launch: hipMemsetAsync failed\n"); return; }
    Params p{};
    for (int i = 0; i < 22; ++i) p.in[i] = (const float*)d_in[i];
    p.out = (float*)d_out; p.ws = (unsigned char*)d_ws;
#if MK_SPLIT
    for (int ph = 0; ph < NPHASE; ++ph) {
        p.ph_lo = ph; p.ph_hi = ph + 1; void* args[] = {&p};
        hipError_t e = hipLaunchCooperativeKernel((const void*)mega_fwd, dim3(grid_blocks), dim3(512), args, LDS_BYTES, stream);
        if (e != hipSuccess) { fprintf(stderr, "cooperative launch failed: %s (grid %d)\n", hipGetErrorString(e), grid_blocks); return; }
    }
#else
    p.ph_lo = 0; p.ph_hi = NPHASE; void* args[] = {&p};
    hipError_t e = hipLaunchCooperativeKernel((const void*)mega_fwd, dim3(grid_blocks), dim3(512), args, LDS_BYTES, stream);
    if (e != hipSuccess) fprintf(stderr, "cooperative launch failed: %s (grid %d)\n", hipGetErrorString(e), grid_blocks);
#endif
}
```

```cpp
#include <hip/hip_runtime.h>
#include <hip/hip_cooperative_groups.h>
#include <hip/hip_bf16.h>
#include <cstdio>
#include <cstdint>
namespace cg = cooperative_groups;

namespace pg8 {
#define PG8_LAS __attribute__((address_space(3)))
typedef unsigned short bf16_t;
typedef short bf16x8 __attribute__((ext_vector_type(8)));
typedef float f32x4 __attribute__((ext_vector_type(4)));
typedef unsigned u32x4 __attribute__((ext_vector_type(4)));
constexpr int BM = 256, BK = 64, HALF = 128, HTB = HALF * BK * 2  , STAGE_BYTES = 8 * HTB, NXCD = 8, WGM = 8;

__host__ __device__ __forceinline__ int lds_byte(int r, int c) { const int st = (r >> 4) * 2 + (c >> 5), rr = r & 15, cc = c & 31, ob = rr * 64 + cc * 2; return st * 1024 + (ob ^ (((ob >> 9) & 1) << 5)); }
__host__ __device__ __forceinline__ void stage_rc(int b, int& R, int& C) { const int st = b / 1024, sb = b % 1024, swz = sb ^ (((sb >> 9) & 1) << 5); R = (st >> 1) * 16 + swz / 64; C = (st & 1) * 32 + (swz % 64) / 2; }
__host__ __device__ __forceinline__ int perm32(int rho) { const int n = rho >> 4, i = rho & 15; return 8 * (i >> 2) + 4 * n + (i & 3); }

struct Unit { int pm, pn, hf; };
struct Gemm { const bf16_t* A; const bf16_t* Bt; int M, N, K; };

struct StaticOrder {
    int nM, nN, nwg, G, c;
    __host__ __device__ void init(int M, int N, int G_, int c_) { nM = M / BM; nN = N / BM; nwg = nM * nN; G = G_; c = c_; }
    __host__ __device__ bool next(int i, Unit& u) const {
        const long L = (long)i * G + c; if (L >= nwg) return false;
        int wgid = (int)L; { const int q = nwg / NXCD, r = nwg % NXCD, xcd = wgid % NXCD, off = wgid / NXCD; wgid = (xcd < r ? xcd * (q + 1) : r * (q + 1) + (xcd - r) * q) + off; }
        const int nig = WGM * nN, gid = wgid / nig, fm = gid * WGM, gsz = (nM - fm) < WGM ? (nM - fm) : WGM;
        u.pm = fm + ((wgid % nig) % gsz); u.pn = (wgid % nig) / gsz; u.hf = 0; return true;
    }
    __device__ __forceinline__ void a_ready(const Unit&) const {}
    __device__ __forceinline__ void done(const Unit&) const {}
};
struct HalfOrder {
    int G, c, ncol;
    __host__ __device__ void init(int G_, int c_, int ncol_ = 4) { G = G_; c = c_; ncol = ncol_; }
    __host__ __device__ __forceinline__ bool next(int i, Unit& u) const {
        const int L = i * G + c, nhalf = 32 * ncol; if (L >= nhalf + 64 * ncol) return false;
        const bool full = L >= nhalf; const int Lf = L - nhalf, x = Lf & 7, slot = Lf >> 3, h = L;
        u.pm = full ? 16 + x * 8 + slot / ncol : h / (2 * ncol); u.pn = full ? slot % ncol : h % (2 * ncol); u.hf = full ? 0 : 1;
        return true;
    }
    __device__ __forceinline__ void a_ready(const Unit&) const {}
    __device__ __forceinline__ void done(const Unit&) const {}
};

__device__ __forceinline__ unsigned cvt_pk_bf16(float lo, float hi) { unsigned r; asm volatile("v_cvt_pk_bf16_f32 %0, %1, %2" : "=v"(r) : "v"(lo), "v"(hi)); return r; }
__device__ __forceinline__ int cond_of(int pm) { return pm < 16 ? 0 : 1 + ((pm - 16) >> 4); }
template <bool NORM> struct EpiStoreN {
    static constexpr bool PERM = true, AFTER_DRAIN = false;
    bf16_t* O; int ldc; const float* ss; const float* sW; int ldw;
    __device__ __forceinline__ void operator()(const f32x4 (&acc)[2][2][4][2], const Unit& u, int wr, int wc, int fr, int fq) const {
        const int row0 = u.pm * BM + wr * 64 + fr, col0 = u.pn * (u.hf ? HALF : BM) + wc * 32 + 8 * fq; const int nbj = u.hf ? 1 : 2;
        f32x4 bv[2][2];
        if constexpr (NORM) { const float* bp = sW + (size_t)cond_of(u.pm) * ldw + col0;
#pragma unroll
            for (int bj = 0; bj < 2; ++bj)
#pragma unroll
                for (int n = 0; n < 2; ++n) bv[bj][n] = *(const f32x4*)(bp + bj * HALF + 4 * n); }
#pragma unroll
        for (int ai = 0; ai < 2; ++ai)
#pragma unroll
            for (int m = 0; m < 4; ++m) { const int r = row0 + ai * HALF + m * 16; bf16_t* rowp = O + (size_t)r * ldc + col0;
                float rs = 1.f; if constexpr (NORM) rs = __builtin_amdgcn_rsqf(ss[r] * (1.0f / 1024.0f) + 1e-6f);
#pragma unroll
                for (int bj = 0; bj < 2; ++bj) { if (bj >= nbj) continue; f32x4 v0 = acc[ai][bj][m][0], v1 = acc[ai][bj][m][1];
                    if constexpr (NORM) { v0 = v0 * rs + bv[bj][0]; v1 = v1 * rs + bv[bj][1]; }
                    u32x4 w; w.x = cvt_pk_bf16(v0[0], v0[1]); w.y = cvt_pk_bf16(v0[2], v0[3]); w.z = cvt_pk_bf16(v1[0], v1[1]); w.w = cvt_pk_bf16(v1[2], v1[3]);
                    *(u32x4*)(rowp + bj * HALF) = w; } }
    }
};
__device__ __forceinline__ float silu_mul(float a, float b) { return a * __builtin_amdgcn_rcpf(1.0f + __builtin_amdgcn_exp2f(-1.4426950408889634f * a)) * b; }
struct EpiSwigluN {
    static constexpr bool PERM = true, AFTER_DRAIN = false;
    bf16_t* O; int ldc; const float* ss; const float* sW; int ldw;
    __device__ __forceinline__ void operator()(const f32x4 (&acc)[2][2][4][2], const Unit& u, int wr, int wc, int fr, int fq) const {
        const int row0 = u.pm * BM + wr * 64 + fr, col0 = u.pn * HALF + wc * 32 + 8 * fq;
        const float* bp = sW + (size_t)cond_of(u.pm) * ldw + u.pn * BM + wc * 32 + 8 * fq;
        const f32x4 ba0 = *(const f32x4*)(bp), ba1 = *(const f32x4*)(bp + 4), bb0 = *(const f32x4*)(bp + HALF), bb1 = *(const f32x4*)(bp + HALF + 4);
#pragma unroll
        for (int ai = 0; ai < 2; ++ai)
#pragma unroll
            for (int m = 0; m < 4; ++m) { const int r = row0 + ai * HALF + m * 16; bf16_t* rowp = O + (size_t)r * ldc + col0;
                const float rs = __builtin_amdgcn_rsqf(ss[r] * (1.0f / 1024.0f) + 1e-6f);
                const f32x4 a0 = acc[ai][0][m][0] * rs + ba0, a1 = acc[ai][0][m][1] * rs + ba1, b0 = acc[ai][1][m][0] * rs + bb0, b1 = acc[ai][1][m][1] * rs + bb1;
                u32x4 w; w.x = cvt_pk_bf16(silu_mul(a0[0], b0[0]), silu_mul(a0[1], b0[1])); w.y = cvt_pk_bf16(silu_mul(a0[2], b0[2]), silu_mul(a0[3], b0[3]));
                w.z = cvt_pk_bf16(silu_mul(a1[0], b1[0]), silu_mul(a1[1], b1[1])); w.w = cvt_pk_bf16(silu_mul(a1[2], b1[2]), silu_mul(a1[3], b1[3]));
                *(u32x4*)rowp = w; }
    }
};
template <bool HB, bool FIRST> struct EpiResNorm {
    static constexpr bool PERM = true, AFTER_DRAIN = false;
    const float* base_ctx; const float* base_lat; bf16_t* xb; const float* gate; const float* gp; bf16_t* hb; float* ss;
    __device__ __forceinline__ void operator()(const f32x4 (&acc)[2][2][4][2], const Unit& u, int wr, int wc, int fr, int fq) const {
        const int j = cond_of(u.pm);
        const float* base = u.pm < 16 ? base_ctx + (size_t)u.pm * BM * 1024 : base_lat + (size_t)(u.pm - 16) * BM * 1024;
        const int col0 = u.pn * (u.hf ? HALF : BM) + wc * 32 + 8 * fq, rl0 = wr * 64 + fr; const int nbj = u.hf ? 1 : 2;
        f32x4 gv[2][2], pv[2][2];
#pragma unroll
        for (int bj = 0; bj < 2; ++bj)
#pragma unroll
            for (int n = 0; n < 2; ++n) { if (bj >= nbj) continue; gv[bj][n] = *(const f32x4*)(gate + (size_t)j * 6144 + col0 + bj * HALF + n * 4);
                if constexpr (HB) pv[bj][n] = *(const f32x4*)(gp + (size_t)j * 1024 + col0 + bj * HALF + n * 4); }
        bf16_t* outp = xb + (size_t)u.pm * BM * 1024; bf16_t* hbp = hb + (size_t)u.pm * BM * 1024; float* ssp = ss + u.pm * BM;
#pragma unroll
        for (int ai = 0; ai < 2; ++ai)
#pragma unroll
            for (int m = 0; m < 4; ++m) { const int rl = rl0 + ai * HALF + m * 16; const size_t off = (size_t)rl * 1024 + col0; float s = 0.f;
#pragma unroll
                for (int bj = 0; bj < 2; ++bj) { if (bj >= nbj) continue;
                    f32x4 b0, b1;
                    if constexpr (FIRST) { b0 = *(const f32x4*)(base + off + bj * HALF); b1 = *(const f32x4*)(base + off + bj * HALF + 4); }
                    else { const u32x4 bw = *(const u32x4*)(outp + off + bj * HALF);
                        b0 = (f32x4){__builtin_bit_cast(float, bw.x << 16), __builtin_bit_cast(float, bw.x & 0xffff0000u), __builtin_bit_cast(float, bw.y << 16), __builtin_bit_cast(float, bw.y & 0xffff0000u)};
                        b1 = (f32x4){__builtin_bit_cast(float, bw.z << 16), __builtin_bit_cast(float, bw.z & 0xffff0000u), __builtin_bit_cast(float, bw.w << 16), __builtin_bit_cast(float, bw.w & 0xffff0000u)}; }
                    const f32x4 o0 = b0 + gv[bj][0] * acc[ai][bj][m][0], o1 = b1 + gv[bj][1] * acc[ai][bj][m][1];
                    { u32x4 ow; ow.x = cvt_pk_bf16(o0[0], o0[1]); ow.y = cvt_pk_bf16(o0[2], o0[3]); ow.z = cvt_pk_bf16(o1[0], o1[1]); ow.w = cvt_pk_bf16(o1[2], o1[3]); *(u32x4*)(outp + off + bj * HALF) = ow; }
                    s += ((o0[0] * o0[0] + o0[1] * o0[1]) + (o0[2] * o0[2] + o0[3] * o0[3])) + ((o1[0] * o1[0] + o1[1] * o1[1]) + (o1[2] * o1[2] + o1[3] * o1[3]));
                    if constexpr (HB) { const f32x4 h0 = o0 * pv[bj][0], h1 = o1 * pv[bj][1]; u32x4 w; w.x = cvt_pk_bf16(h0[0], h0[1]); w.y = cvt_pk_bf16(h0[2], h0[3]); w.z = cvt_pk_bf16(h1[0], h1[1]); w.w = cvt_pk_bf16(h1[2], h1[3]); *(u32x4*)(hbp + off + bj * HALF) = w; } }
                s += __shfl_xor(s, 16); s += __shfl_xor(s, 32);
                if (fq == 0) __hip_atomic_fetch_add(ssp + rl, s, __ATOMIC_RELAXED, __HIP_MEMORY_SCOPE_AGENT); }
    }
};

template <class Epi, class Sched, bool ALIGN_EPI = false, bool SP2 = false>
__device__ __forceinline__ void gemm_phase(PG8_LAS unsigned char* lds, const Gemm g, const Sched& S, const Epi& E) {
    const int tid = threadIdx.x, wid = __builtin_amdgcn_readfirstlane(tid >> 6), lane = tid & 63, wr = wid >> 2, wc = wid & 3, fr = lane & 15, fq = lane >> 4;
    const int K = g.K, nt = K / BK;
    unsigned voffA[2], voffB[2];
#pragma unroll
    for (int i = 0; i < 2; ++i) { int R, C; stage_rc(tid * 16 + i * 8192, R, C); const int Rb = Epi::PERM ? ((R & ~31) + perm32(R & 31)) : R;
        voffA[i] = (unsigned)(R * K + C) * 2u; voffB[i] = (unsigned)(Rb * K + C) * 2u; }
    const size_t kstep = (size_t)(BK * 2);
    const size_t hstep = (size_t)HALF * K * 2;
    const size_t tstep = 2 * hstep;
    const unsigned ldsw = (unsigned)wid * 1024u;
    const int aoff = lds_byte(wr * 64 + fr, fq * 8), boff = lds_byte(wc * 32 + fr, fq * 8);
#define PG8_SA(b, h) (((b) * 2 + (h)) * HTB)
#define PG8_SB(b, h) ((4 + (b) * 2 + (h)) * HTB)
#define PG8_STAGE(bufoff, gbase, voff) do { _Pragma("unroll") for (int _i = 0; _i < 2; ++_i) \
        __builtin_amdgcn_global_load_lds((const unsigned*)((const char*)(gbase) + (voff)[_i]), (PG8_LAS unsigned*)(lds + (bufoff) + ldsw + _i * 8192), 16, 0, 0); } while (0)
#define PG8_LDA(dst, b, h) do { _Pragma("unroll") for (int m = 0; m < 4; ++m) _Pragma("unroll") for (int k = 0; k < 2; ++k) dst[m][k] = *(const PG8_LAS bf16x8*)(lds + PG8_SA(b, h) + aoff + m * 2048 + k * 1024); } while (0)
#define PG8_LDB(dst, b, h) do { _Pragma("unroll") for (int n = 0; n < 2; ++n) _Pragma("unroll") for (int k = 0; k < 2; ++k) dst[n][k] = *(const PG8_LAS bf16x8*)(lds + PG8_SB(b, h) + boff + n * 2048 + k * 1024); } while (0)
#define PG8_MMA(ai, bj, At, Bt) do { __builtin_amdgcn_s_setprio(1); _Pragma("unroll") for (int m = 0; m < 4; ++m) _Pragma("unroll") for (int n = 0; n < 2; ++n) _Pragma("unroll") for (int k = 0; k < 2; ++k) \
        acc[ai][bj][m][n] = __builtin_amdgcn_mfma_f32_16x16x32_bf16(Bt[n][k], At[m][k], acc[ai][bj][m][n], 0, 0, 0); __builtin_amdgcn_s_setprio(0); } while (0)
#define PG8_WAIT_V(n) asm volatile("s_waitcnt vmcnt(" #n ")" ::: "memory")
#define PG8_WAIT_L(n) asm volatile("s_waitcnt lgkmcnt(" #n ")" ::: "memory")
#define PG8_BAR __builtin_amdgcn_s_barrier()
#define PG8_SCHED __builtin_amdgcn_sched_barrier(0)
    Unit cur, nxt; int ui = 0;
    if (!S.next(0, cur)) return;
    f32x4 acc[2][2][4][2];
#pragma unroll
    for (int a = 0; a < 2; ++a)
#pragma unroll
        for (int b = 0; b < 2; ++b)
#pragma unroll
            for (int m = 0; m < 4; ++m)
#pragma unroll
                for (int n = 0; n < 2; ++n) acc[a][b][m][n] = (f32x4){0.f, 0.f, 0.f, 0.f};
    bf16x8 At[4][2], B0[2][2], B1[2][2];
    const char* cA = (const char*)g.A + (size_t)cur.pm * tstep; const char* cB = (const char*)g.Bt + (size_t)cur.pn * (cur.hf ? hstep : tstep);
    S.a_ready(cur);
    if constexpr (SP2) {
        PG8_STAGE(PG8_SB(0, 0), cB, voffB); PG8_STAGE(PG8_SB(0, 1), cB + hstep, voffB); PG8_STAGE(PG8_SA(0, 0), cA, voffA); PG8_STAGE(PG8_SA(0, 1), cA + hstep, voffA);
        if (wr == 1) PG8_BAR;
        PG8_WAIT_V(2); PG8_BAR;
        PG8_STAGE(PG8_SB(1, 0), cB + kstep, voffB); PG8_STAGE(PG8_SA(1, 0), cA + kstep, voffA); PG8_STAGE(PG8_SB(1, 1), cB + hstep + kstep, voffB);
        PG8_WAIT_V(6); PG8_BAR;
    } else {
        PG8_STAGE(PG8_SB(0, 0), cB, voffB); PG8_STAGE(PG8_SA(0, 0), cA, voffA); PG8_STAGE(PG8_SB(0, 1), cB + hstep, voffB); PG8_STAGE(PG8_SA(0, 1), cA + hstep, voffA);
        if (wr == 1) PG8_BAR;
        PG8_WAIT_V(4); PG8_BAR;
        PG8_STAGE(PG8_SB(1, 0), cB + kstep, voffB); PG8_STAGE(PG8_SA(1, 0), cA + kstep, voffA); PG8_STAGE(PG8_SB(1, 1), cB + hstep + kstep, voffB);
        PG8_WAIT_V(6); PG8_BAR;
    }
    for (;;) {
        const bool has_next = S.next(ui + 1, nxt);
        const char* nA = has_next ? (const char*)g.A + (size_t)nxt.pm * tstep : cA; const char* nB = has_next ? (const char*)g.Bt + (size_t)nxt.pn * (nxt.hf ? hstep : tstep) : cB;
        const bool fullu = cur.hf == 0;
        if (fullu) {
        for (int t = 0; t < nt; t += 2) {
            const bool last = (t == nt - 2);
            const char* a1 = cA + (size_t)(t + 1) * kstep;
            const char* a2 = last ? nA : cA + (size_t)(t + 2) * kstep; const char* b2 = last ? nB : cB + (size_t)(t + 2) * kstep;
            const char* a3 = a2 + kstep; const char* b3 = b2 + kstep;
            if (last && has_next) S.a_ready(nxt);
            if constexpr (SP2) {
            PG8_LDB(B0, 0, 0); PG8_LDB(B1, 0, 1); PG8_SCHED; PG8_LDA(At, 0, 0); PG8_STAGE(PG8_SA(1, 1), a1 + hstep, voffA);
            PG8_WAIT_V(8); PG8_WAIT_L(0); PG8_BAR; PG8_MMA(0, 0, At, B0); PG8_MMA(0, 1, At, B1); PG8_BAR; PG8_SCHED;
            PG8_LDA(At, 0, 1); PG8_STAGE(PG8_SB(0, 0), b2, voffB); PG8_STAGE(PG8_SB(0, 1), b2 + hstep, voffB); PG8_STAGE(PG8_SA(0, 0), a2, voffA);
            PG8_WAIT_V(8); PG8_WAIT_L(0); PG8_BAR; PG8_MMA(1, 0, At, B0); PG8_MMA(1, 1, At, B1); PG8_BAR; PG8_SCHED;
            PG8_LDB(B0, 1, 0); PG8_LDB(B1, 1, 1); PG8_SCHED; PG8_LDA(At, 1, 0); PG8_STAGE(PG8_SA(0, 1), a2 + hstep, voffA);
            PG8_WAIT_V(8); PG8_WAIT_L(0); PG8_BAR; PG8_MMA(0, 0, At, B0); PG8_MMA(0, 1, At, B1); PG8_BAR; PG8_SCHED;
            PG8_LDA(At, 1, 1); PG8_STAGE(PG8_SB(1, 0), b3, voffB); PG8_STAGE(PG8_SB(1, 1), b3 + hstep, voffB); PG8_STAGE(PG8_SA(1, 0), a3, voffA);
            PG8_WAIT_V(8); PG8_WAIT_L(0); PG8_BAR; PG8_MMA(1, 0, At, B0); PG8_MMA(1, 1, At, B1); PG8_BAR; PG8_SCHED;
            } else {
            PG8_LDB(B0, 0, 0); PG8_SCHED; PG8_LDA(At, 0, 0); PG8_STAGE(PG8_SA(1, 1), a1 + hstep, voffA);
            PG8_WAIT_L(8); PG8_BAR; PG8_WAIT_L(0); PG8_MMA(0, 0, At, B0); PG8_BAR; PG8_SCHED;
            PG8_LDB(B1, 0, 1); PG8_STAGE(PG8_SB(0, 0), b2, voffB);
            PG8_BAR; PG8_WAIT_L(0); PG8_MMA(0, 1, At, B1); PG8_BAR;
            PG8_LDA(At, 0, 1); PG8_STAGE(PG8_SA(0, 0), a2, voffA);
            PG8_BAR; PG8_WAIT_L(0); PG8_MMA(1, 0, At, B0); PG8_BAR; PG8_SCHED;
            PG8_STAGE(PG8_SB(0, 1), b2 + hstep, voffB);
            PG8_WAIT_V(6); PG8_BAR; PG8_MMA(1, 1, At, B1); PG8_BAR;
            PG8_LDB(B0, 1, 0); PG8_SCHED; PG8_LDA(At, 1, 0); PG8_STAGE(PG8_SA(0, 1), a2 + hstep, voffA);
            PG8_WAIT_L(8); PG8_BAR; PG8_WAIT_L(0); PG8_MMA(0, 0, At, B0); PG8_BAR; PG8_SCHED;
            PG8_LDB(B1, 1, 1); PG8_STAGE(PG8_SB(1, 0), b3, voffB);
            PG8_BAR; PG8_WAIT_L(0); PG8_MMA(0, 1, At, B1); PG8_BAR;
            PG8_LDA(At, 1, 1); PG8_STAGE(PG8_SA(1, 0), a3, voffA);
            PG8_BAR; PG8_WAIT_L(0); PG8_MMA(1, 0, At, B0); PG8_BAR; PG8_SCHED;
            PG8_STAGE(PG8_SB(1, 1), b3 + hstep, voffB);
            PG8_WAIT_V(6); PG8_BAR; PG8_MMA(1, 1, At, B1); PG8_BAR;
            }
        }
        } else {
        for (int t = 0; t < nt; t += 2) {
            const bool last = (t == nt - 2);
            const char* a1 = cA + (size_t)(t + 1) * kstep;
            const char* a2 = last ? nA : cA + (size_t)(t + 2) * kstep; const char* b2 = last ? nB : cB + (size_t)(t + 2) * kstep;
            const char* a3 = a2 + kstep; const char* b3 = b2 + kstep;
            if (last && has_next) S.a_ready(nxt);
            if constexpr (SP2) {
            PG8_LDB(B0, 0, 0); PG8_LDB(B1, 0, 1); PG8_SCHED; PG8_LDA(At, 0, 0); PG8_STAGE(PG8_SA(1, 1), a1 + hstep, voffA);
            PG8_WAIT_V(8); PG8_WAIT_L(0); PG8_BAR; PG8_MMA(0, 0, At, B0);  PG8_BAR; PG8_SCHED;
            PG8_LDA(At, 0, 1); PG8_STAGE(PG8_SB(0, 0), b2, voffB); PG8_STAGE(PG8_SB(0, 1), b2 + hstep, voffB); PG8_STAGE(PG8_SA(0, 0), a2, voffA);
            PG8_WAIT_V(8); PG8_WAIT_L(0); PG8_BAR; PG8_MMA(1, 0, At, B0);  PG8_BAR; PG8_SCHED;
            PG8_LDB(B0, 1, 0); PG8_LDB(B1, 1, 1); PG8_SCHED; PG8_LDA(At, 1, 0); PG8_STAGE(PG8_SA(0, 1), a2 + hstep, voffA);
            PG8_WAIT_V(8); PG8_WAIT_L(0); PG8_BAR; PG8_MMA(0, 0, At, B0);  PG8_BAR; PG8_SCHED;
            PG8_LDA(At, 1, 1); PG8_STAGE(PG8_SB(1, 0), b3, voffB); PG8_STAGE(PG8_SB(1, 1), b3 + hstep, voffB); PG8_STAGE(PG8_SA(1, 0), a3, voffA);
            PG8_WAIT_V(8); PG8_WAIT_L(0); PG8_BAR; PG8_MMA(1, 0, At, B0);  PG8_BAR; PG8_SCHED;
            } else {
            PG8_LDB(B0, 0, 0); PG8_SCHED; PG8_LDA(At, 0, 0); PG8_STAGE(PG8_SA(1, 1), a1 + hstep, voffA);
            PG8_WAIT_L(8); PG8_BAR; PG8_WAIT_L(0); PG8_MMA(0, 0, At, B0); PG8_BAR; PG8_SCHED;
            PG8_LDB(B1, 0, 1); PG8_STAGE(PG8_SB(0, 0), b2, voffB);
            PG8_BAR; PG8_WAIT_L(0); PG8_MMA(0, 1, At, B1); PG8_BAR;
            PG8_LDA(At, 0, 1); PG8_STAGE(PG8_SA(0, 0), a2, voffA);
            PG8_BAR; PG8_WAIT_L(0); PG8_MMA(1, 0, At, B0); PG8_BAR; PG8_SCHED;
            PG8_STAGE(PG8_SB(0, 1), b2 + hstep, voffB);
            PG8_WAIT_V(6); PG8_BAR; PG8_MMA(1, 1, At, B1); PG8_BAR;
            PG8_LDB(B0, 1, 0); PG8_SCHED; PG8_LDA(At, 1, 0); PG8_STAGE(PG8_SA(0, 1), a2 + hstep, voffA);
            PG8_WAIT_L(8); PG8_BAR; PG8_WAIT_L(0); PG8_MMA(0, 0, At, B0); PG8_BAR; PG8_SCHED;
            PG8_LDB(B1, 1, 1); PG8_STAGE(PG8_SB(1, 0), b3, voffB);
            PG8_BAR; PG8_WAIT_L(0); PG8_MMA(0, 1, At, B1); PG8_BAR;
            PG8_LDA(At, 1, 1); PG8_STAGE(PG8_SA(1, 0), a3, voffA);
            PG8_BAR; PG8_WAIT_L(0); PG8_MMA(1, 0, At, B0); PG8_BAR; PG8_SCHED;
            PG8_STAGE(PG8_SB(1, 1), b3 + hstep, voffB);
            PG8_WAIT_V(6); PG8_BAR; PG8_MMA(1, 1, At, B1); PG8_BAR;
            }
        }
        }
        if constexpr (ALIGN_EPI) { if (wr == 0) PG8_BAR; }
        if constexpr (!Epi::AFTER_DRAIN) { E(acc, cur, wr, wc, fr, fq); S.done(cur); }
        if (!has_next) break;
#pragma unroll
        for (int a = 0; a < 2; ++a)
#pragma unroll
            for (int b = 0; b < 2; ++b)
#pragma unroll
                for (int m = 0; m < 4; ++m)
#pragma unroll
                    for (int n = 0; n < 2; ++n) acc[a][b][m][n] = (f32x4){0.f, 0.f, 0.f, 0.f};
        cur = nxt; cA = nA; cB = nB; ++ui;
        if constexpr (ALIGN_EPI) { if (wr == 1) PG8_BAR; }
    }
    PG8_WAIT_V(0);
    if constexpr (!ALIGN_EPI) { if (wr == 0) PG8_BAR; }
    PG8_BAR;
    if constexpr (Epi::AFTER_DRAIN) { E.fused(acc, cur, wr, wc, fr, fq, lds, wid, lane); S.done(cur); }
#undef PG8_SA
#undef PG8_SB
#undef PG8_STAGE
#undef PG8_LDA
#undef PG8_LDB
#undef PG8_MMA
#undef PG8_WAIT_V
#undef PG8_WAIT_L
#undef PG8_BAR
#undef PG8_SCHED
}
}
namespace attn {
using bf16 = __hip_bfloat16;
constexpr int   D = 128, NW = 8, QBLK = 32, KVBLK = 64;
constexpr float SCALE = 0.088388347648318440f;
constexpr float THR = 8.f;
constexpr int SDEPTH = 2;
constexpr int LDQ = 1024, LDK = 128, LDO = 1024;
constexpr size_t SHM_V = KVBLK * D * 2, SHM_K = KVBLK * D * 2, SHM_ATTN = 2 * SHM_V + 2 * SHM_K + NW * 64 * 4;
using bf16x8 = __attribute__((ext_vector_type(8))) short;
using s16x4  = __attribute__((ext_vector_type(4))) short;
using f32x16 = __attribute__((ext_vector_type(16))) float;
using f32x8  = __attribute__((ext_vector_type(8))) float;
using u32x4  = __attribute__((ext_vector_type(4))) unsigned;
#define KSWZ(row, colB) ((row) * 256 + ((colB) ^ (((row) & 7) << 4)))
#define SBAR() __builtin_amdgcn_sched_barrier(0)
__device__ __forceinline__ int crow(int r, int hi) { return (r & 3) + 8 * (r >> 2) + 4 * hi; }
__device__ __forceinline__ unsigned cvtpk(float lo, float hi) {
  unsigned r; asm volatile("v_cvt_pk_bf16_f32 %0, %1, %2" : "=v"(r) : "v"(lo), "v"(hi)); return r;
}
template <typename TIn> struct Stage;
template <> struct Stage<bf16>  { using T = bf16x8;
  __device__ static __forceinline__ T ld8(const bf16* p) { return *reinterpret_cast<const bf16x8*>(p); }
  __device__ static __forceinline__ bf16x8 tobf(T x) { return x; } };
template <> struct Stage<float> { using T = f32x8;
  __device__ static __forceinline__ T ld8(const float* p) { return *reinterpret_cast<const f32x8*>(p); }
  __device__ static __forceinline__ bf16x8 tobf(T x) {
    u32x4 w = {cvtpk(x[0], x[1]), cvtpk(x[2], x[3]), cvtpk(x[4], x[5]), cvtpk(x[6], x[7])}; return *reinterpret_cast<bf16x8*>(&w); } };

__device__ __forceinline__ void partialSM(f32x16& p0, f32x16& p1, float& m_reg, float& mn, float& alpha) {
  constexpr float C = SCALE * 1.4426950408889634f;
  float pmax = p0[0]; for (int r = 1; r < 16; ++r) pmax = fmaxf(pmax, p0[r]); for (int r = 0; r < 16; ++r) pmax = fmaxf(pmax, p1[r]);
  { auto rr = __builtin_amdgcn_permlane32_swap(__float_as_uint(pmax), __float_as_uint(pmax), false, false);
    pmax = fmaxf(__uint_as_float(rr[0]), __uint_as_float(rr[1])); }
  if (__builtin_expect(__all(pmax - m_reg <= THR / SCALE), 1)) { mn = m_reg; alpha = 1.f; }
  else { mn = fmaxf(m_reg, pmax); alpha = __builtin_amdgcn_exp2f((m_reg - mn) * C); m_reg = mn; }
  float mnC = -mn * C;
  for (int r = 0; r < 16; ++r) p0[r] = fmaf(p0[r], C, mnC); for (int r = 0; r < 16; ++r) p1[r] = fmaf(p1[r], C, mnC);
  for (int r = 0; r < 16; ++r) p0[r] = __builtin_amdgcn_exp2f(p0[r]);
}
__device__ __forceinline__ void finishSM(f32x16& p0, f32x16& p1, float alpha, float& l_reg, bf16x8& pa0, bf16x8& pa1, bf16x8& pa2, bf16x8& pa3) {
  for (int r = 0; r < 16; ++r) p1[r] = __builtin_amdgcn_exp2f(p1[r]);
  float ps = 0; for (int r = 0; r < 16; ++r) ps += p0[r]; for (int r = 0; r < 16; ++r) ps += p1[r];
  { auto rr = __builtin_amdgcn_permlane32_swap(__float_as_uint(ps), __float_as_uint(ps), false, false);
    ps = __uint_as_float(rr[0]) + __uint_as_float(rr[1]); }
  l_reg = l_reg * alpha + ps;
#define PK4(P, BASE, OUT) do { unsigned a0 = cvtpk(P[BASE + 0], P[BASE + 1]), a1 = cvtpk(P[BASE + 2], P[BASE + 3]);   \
    unsigned b0 = cvtpk(P[BASE + 4], P[BASE + 5]), b1 = cvtpk(P[BASE + 6], P[BASE + 7]);                              \
    auto r0 = __builtin_amdgcn_permlane32_swap(a0, b0, false, false); auto r1 = __builtin_amdgcn_permlane32_swap(a1, b1, false, false); \
    u32x4 w = {r0[0], r1[0], r0[1], r1[1]}; OUT = *reinterpret_cast<bf16x8*>(&w); } while (0)
  PK4(p0, 0, pa0); PK4(p0, 8, pa1); PK4(p1, 0, pa2); PK4(p1, 8, pa3);
#undef PK4
}
__device__ __forceinline__ void qkt(f32x16& p0, f32x16& p1, const bf16* Ks, const bf16x8* qr, int r32, int hi) {
  p0 = f32x16{}; p1 = f32x16{};
  for (int d0 = 0; d0 < 8; ++d0) { int cb = (d0 * 16 + hi * 8) * 2;
    bf16x8 b0 = *reinterpret_cast<const bf16x8*>((const char*)Ks + KSWZ(r32, cb));
    bf16x8 b1 = *reinterpret_cast<const bf16x8*>((const char*)Ks + KSWZ(32 + r32, cb));
    p0 = __builtin_amdgcn_mfma_f32_32x32x16_bf16(b0, qr[d0], p0, 0, 0, 0);
    p1 = __builtin_amdgcn_mfma_f32_32x32x16_bf16(b1, qr[d0], p1, 0, 0, 0); }
}
__device__ __forceinline__ int v_st(int k, int c) { const int kk = (k & ~0xC) | ((k & 4) << 1) | ((k & 8) >> 1); return ((kk >> 3) * 4 + (c >> 5)) * 512 + ((kk & 7) * 32 + (c & 31)) * 2; }
__device__ __forceinline__ int v_rd_base(int lane) { return ((lane & 3) << 3) | (((lane >> 2) & 3) << 6) | (((lane >> 4) & 1) << 5) | (((lane >> 5) & 1) << 8); }
constexpr int v_rd_off(int d0, int ks, int half) { return d0 * 512 + ks * 4096 + half * 2048; }
template <int OFF> __device__ __forceinline__ s16x4 tr_read(int vb) {
  s16x4 r; asm volatile("ds_read_b64_tr_b16 %0, %1 offset:%2" : "=&v"(r) : "v"(vb), "i"(OFF) : "memory"); return r;
}
template <int D0> __device__ __forceinline__ void pv_one(f32x16& od, int vb, bf16x8 pa0, bf16x8 pa1, bf16x8 pa2, bf16x8 pa3) {
  const s16x4 l0 = tr_read<v_rd_off(D0, 0, 0)>(vb), h0 = tr_read<v_rd_off(D0, 0, 1)>(vb), l1 = tr_read<v_rd_off(D0, 1, 0)>(vb), h1 = tr_read<v_rd_off(D0, 1, 1)>(vb);
  const s16x4 l2 = tr_read<v_rd_off(D0, 2, 0)>(vb), h2 = tr_read<v_rd_off(D0, 2, 1)>(vb), l3 = tr_read<v_rd_off(D0, 3, 0)>(vb), h3 = tr_read<v_rd_off(D0, 3, 1)>(vb);
  asm volatile("s_waitcnt lgkmcnt(0)" ::: "memory"); SBAR();
#define PK(L, H) (bf16x8){L[0], L[1], L[2], L[3], H[0], H[1], H[2], H[3]}
  od = __builtin_amdgcn_mfma_f32_32x32x16_bf16(pa0, PK(l0, h0), od, 0, 0, 0);
  od = __builtin_amdgcn_mfma_f32_32x32x16_bf16(pa1, PK(l1, h1), od, 0, 0, 0);
  od = __builtin_amdgcn_mfma_f32_32x32x16_bf16(pa2, PK(l2, h2), od, 0, 0, 0);
  od = __builtin_amdgcn_mfma_f32_32x32x16_bf16(pa3, PK(l3, h3), od, 0, 0, 0);
#undef PK
}
__device__ __forceinline__ void pv_d0(f32x16* o, int vb, bf16x8 pa0, bf16x8 pa1, bf16x8 pa2, bf16x8 pa3) {
  pv_one<0>(o[0], vb, pa0, pa1, pa2, pa3); pv_one<1>(o[1], vb, pa0, pa1, pa2, pa3); pv_one<2>(o[2], vb, pa0, pa1, pa2, pa3); pv_one<3>(o[3], vb, pa0, pa1, pa2, pa3);
}

template <typename TQ>
__device__ __forceinline__ void attn_dense_body(const TQ* __restrict__ Qb, const bf16* __restrict__ Kh, const bf16* __restrict__ Vh,
                                                bf16* __restrict__ Ob, int seq, char* lds) {
  using St = Stage<bf16>; using SQ = Stage<TQ>;
  const int tid = threadIdx.x, wid = tid >> 6, lane = tid & 63, r32 = lane & 31, hi = lane >> 5;
  bf16* V_lds = (bf16*)lds; bf16* K_lds = (bf16*)(lds + 2 * SHM_V);
  float* ws = (float*)(lds + 2 * SHM_V + 2 * SHM_K) + wid * 64; float* li_l = ws; float* al_l = ws + 32;
  float m_reg = -1e30f, l_reg = 0; f32x16 o[4] = {}; bf16x8 qr[8];
  const TQ* Qw = Qb + (long)(wid * QBLK + r32) * LDQ + hi * 8;
#pragma unroll
  for (int d0 = 0; d0 < 8; ++d0) qr[d0] = SQ::tobf(SQ::ld8(Qw + d0 * 16));
  const int sr = tid >> 4, sc = (tid & 15) * 8, vst0 = v_st(sr, sc), vst1 = v_st(32 + sr, sc);
  const int vb0 = (int)(uintptr_t)V_lds + v_rd_base(lane);
  struct { typename St::T vs0, vs1, ks0, ks1; } sr_[SDEPTH];
#define SLOAD(i, k0) do { sr_[i].vs0 = St::ld8(&Vh[(long)((k0) + sr) * LDK + sc]); sr_[i].vs1 = St::ld8(&Vh[(long)((k0) + 32 + sr) * LDK + sc]); \
    sr_[i].ks0 = St::ld8(&Kh[(long)((k0) + sr) * LDK + sc]); sr_[i].ks1 = St::ld8(&Kh[(long)((k0) + 32 + sr) * LDK + sc]); } while (0)
#define SWRITE(b, i) do { *(bf16x8*)((char*)V_lds + (b) * SHM_V + vst0) = St::tobf(sr_[i].vs0);          \
    *(bf16x8*)((char*)V_lds + (b) * SHM_V + vst1) = St::tobf(sr_[i].vs1); int kc = sc * 2;               \
    *(bf16x8*)((char*)K_lds + (b) * SHM_K + KSWZ(sr, kc)) = St::tobf(sr_[i].ks0);                       \
    *(bf16x8*)((char*)K_lds + (b) * SHM_K + KSWZ(32 + sr, kc)) = St::tobf(sr_[i].ks1); } while (0)
#define SWAIT() do { if constexpr (SDEPTH == 2) asm volatile("s_waitcnt vmcnt(4)" ::: "memory"); else asm volatile("s_waitcnt vmcnt(0)" ::: "memory"); } while (0)
#define RESC(a) do { if (__any((a) < 1.f)) { if (hi == 0) al_l[r32] = (a); asm volatile("s_waitcnt lgkmcnt(0)" ::: "memory"); \
    for (int d = 0; d < 4; ++d) for (int r = 0; r < 16; ++r) o[d][r] *= al_l[crow(r, hi)]; } } while (0)
  f32x16 pA0, pA1, pB0, pB1; float mnA, mnB, alA, alB; bf16x8 pa0, pa1, pa2, pa3; const int NT = seq / KVBLK;
  constexpr int SE = 0, SO = SDEPTH - 1;
  SLOAD(SE, 0); asm volatile("s_waitcnt vmcnt(0)" ::: "memory"); SWRITE(0, SE); __syncthreads();
  qkt(pA0, pA1, K_lds, qr, r32, hi); partialSM(pA0, pA1, m_reg, mnA, alA);
  SLOAD(SO, KVBLK); if constexpr (SDEPTH == 2) { if (2 < NT) SLOAD(SE, 2 * KVBLK); }
  SWAIT(); SWRITE(1, SO); __syncthreads();
  for (int j = 1; j + 1 < NT; j += 2) {
    SBAR(); qkt(pB0, pB1, (bf16*)((char*)K_lds + SHM_K), qr, r32, hi);
    finishSM(pA0, pA1, alA, l_reg, pa0, pa1, pa2, pa3); SBAR();
    SLOAD(SO, (j + SDEPTH) * KVBLK); SBAR();
    pv_d0(o, vb0, pa0, pa1, pa2, pa3); partialSM(pB0, pB1, m_reg, mnB, alB);
    __syncthreads(); SWAIT(); SWRITE(0, SE);
    RESC(alB); __syncthreads();
    SBAR(); qkt(pA0, pA1, K_lds, qr, r32, hi);
    finishSM(pB0, pB1, alB, l_reg, pa0, pa1, pa2, pa3); SBAR();
    if (SDEPTH == 1 || j + 3 < NT) SLOAD(SE, (j + 1 + SDEPTH) * KVBLK); SBAR();
    pv_d0(o, vb0 + (int)SHM_V, pa0, pa1, pa2, pa3); partialSM(pA0, pA1, m_reg, mnA, alA);
    __syncthreads(); SWAIT(); SWRITE(1, SO);
    RESC(alA); __syncthreads();
  }
  SBAR(); qkt(pB0, pB1, (bf16*)((char*)K_lds + SHM_K), qr, r32, hi);
  finishSM(pA0, pA1, alA, l_reg, pa0, pa1, pa2, pa3); SBAR();
  pv_d0(o, vb0, pa0, pa1, pa2, pa3); partialSM(pB0, pB1, m_reg, mnB, alB);
  __syncthreads(); RESC(alB);
  finishSM(pB0, pB1, alB, l_reg, pa0, pa1, pa2, pa3); SBAR();
  pv_d0(o, vb0 + (int)SHM_V, pa0, pa1, pa2, pa3);
  if (hi == 0) li_l[r32] = l_reg; asm volatile("s_waitcnt lgkmcnt(0)" ::: "memory");
  float rli[16];
#pragma unroll
  for (int r = 0; r < 16; ++r) rli[r] = __builtin_amdgcn_rcpf(li_l[crow(r, hi)]);
  bf16* Ow = Ob + (long)(wid * QBLK) * LDO;
#pragma unroll
  for (int r = 0; r < 16; ++r) { int orow = crow(r, hi);
    for (int d0 = 0; d0 < 4; ++d0) Ow[(long)orow * LDO + d0 * 32 + r32] = __float2bfloat16(o[d0][r] * rli[r]); }
#undef SLOAD
#undef SWRITE
#undef SWAIT
#undef RESC
}
}
#define LAS __attribute__((address_space(3)))
typedef __hip_bfloat16 bf16;
typedef float f32x4v __attribute__((ext_vector_type(4)));
typedef unsigned u32x4v __attribute__((ext_vector_type(4)));
typedef unsigned u32x2v __attribute__((ext_vector_type(2)));
constexpr int DM = 1024, NCTX = 4096, NLAT = 16384, MTOK = NCTX + NLAT, DFF = 2816, NQKV = 1536, EVIN = 2048, LCTX = 256, LLAT = 4096, PAST = 512, SKV = PAST + LLAT;
constexpr float EPS = 1e-6f;
constexpr size_t MiB = 1u << 20;
constexpr size_t WS_MODS = 0;
constexpr size_t WS_GP = 256 * 1024, WS_SWF1 = 384 * 1024, WS_SWQKV = 640 * 1024, WS_SS = 672 * 1024;
constexpr size_t WS_WIN = 1 * MiB, WS_WOUT = 5 * MiB, WS_WQKV = 7 * MiB, WS_WO = 10 * MiB, WS_WF1 = 12 * MiB, WF1_STRIDE = 11 * MiB, WS_WF2 = 34 * MiB, WF2_STRIDE = (size_t)DM * DFF * 2;
constexpr size_t WS_H = 46 * MiB;
constexpr size_t WS_B = 86 * MiB;
constexpr size_t WS_P = WS_B, WS_MX = WS_B + 80 * MiB;
constexpr size_t WS_ACT = WS_B;
constexpr size_t WS_O = WS_B;
constexpr size_t WS_QKV = WS_B, WS_Q = WS_B + 60 * MiB, WS_KLAT = WS_B + 100 * MiB, WS_VLAT = WS_B + 109 * MiB, WS_KCTX = WS_B + 118 * MiB, WS_VCTX = WS_B + 120 * MiB;
constexpr size_t WS_XB = 208 * MiB, WS_END = 248 * MiB;
constexpr size_t WS_BAR = 992 * 1024, WS_ZERO_BEGIN = WS_SS, WS_ZERO_BYTES = 1 * MiB - WS_SS;
constexpr int LDS_BYTES = 135168;
constexpr int NPHASE = 14;

struct Params { const float* in[22]; float* out; unsigned char* ws; int ph_lo, ph_hi; };

__device__ __forceinline__ float wave_sum(float v) {
#pragma unroll
    for (int o = 1; o < 64; o <<= 1) v += __shfl_xor(v, o);
    return v;
}
__device__ __forceinline__ unsigned f2bf(float f) { unsigned u = __builtin_bit_cast(unsigned, f); return (u + 0x7fffu + ((u >> 16) & 1u)) >> 16; }
__device__ __forceinline__ unsigned pk2(float lo, float hi) { return f2bf(lo) | (f2bf(hi) << 16); }
__device__ __forceinline__ float bf_lo(unsigned w) { return __builtin_bit_cast(float, w << 16); }
__device__ __forceinline__ float bf_hi(unsigned w) { return __builtin_bit_cast(float, w & 0xffff0000u); }
__device__ __forceinline__ float bf1(unsigned short h) { return __builtin_bit_cast(float, (unsigned)h << 16); }

__device__ __forceinline__ void ld8f(const unsigned short* ptr, float* f) { const u32x4v w = *(const u32x4v*)ptr; f[0] = bf_lo(w.x); f[1] = bf_hi(w.x); f[2] = bf_lo(w.y); f[3] = bf_hi(w.y); f[4] = bf_lo(w.z); f[5] = bf_hi(w.z); f[6] = bf_lo(w.w); f[7] = bf_hi(w.w); }
__device__ __forceinline__ void transpose_item(const float* W, int N, int k0, int n0, unsigned short* WT, int ldk, int dst_row0, int dst_k0, LAS float* scr, int lane) {
    float tv[32];
#pragma unroll
    for (int i = 0; i < 32; ++i) tv[i] = __builtin_nontemporal_load(&W[(size_t)(k0 + 2 * i + (lane >> 5)) * N + n0 + (lane & 31)]);
#pragma unroll
    for (int i = 0; i < 32; ++i) scr[(2 * i + (lane >> 5)) * 33 + (lane & 31)] = tv[i];
    asm volatile("s_waitcnt lgkmcnt(0)" ::: "memory");
    const int c = lane & 7;
#pragma unroll
    for (int j = 0; j < 4; ++j) { const int n = (lane >> 3) + 8 * j; const LAS float* s = scr + (8 * c) * 33 + n;
        u32x4v o; o.x = pk2(s[0 * 33], s[1 * 33]); o.y = pk2(s[2 * 33], s[3 * 33]); o.z = pk2(s[4 * 33], s[5 * 33]); o.w = pk2(s[6 * 33], s[7 * 33]);
        *(u32x4v*)(WT + (size_t)(dst_row0 + n) * ldk + dst_k0 + k0 + 8 * c) = o; }
    asm volatile("s_waitcnt lgkmcnt(0)" ::: "memory");
}

__device__ __forceinline__ void phase_prep(const Params& p, LAS unsigned char* lds, int tid, int lane, int wave) {
    unsigned char* ws = p.ws;
    {
        LAS float* sc = (LAS float*)lds;
        LAS float* red = (LAS float*)(lds + 20480);
        const float* cl = p.in[4]; const float* cctx = p.in[5]; const float* w_ada = p.in[6]; const float* b_ada = p.in[7];
        float* mods = (float*)(ws + WS_MODS);
        if ((int)blockIdx.x < 192) {
            for (int idx = tid; idx < 5 * 1024; idx += 512) { const int j = idx >> 10, k = idx & 1023; const float v = j == 0 ? cctx[k] : cl[(j - 1) * 1024 + k]; sc[idx] = v / (1.0f + __expf(-v)); }
            __syncthreads();
            for (int item = blockIdx.x; item < 192; item += gridDim.x) {
                const int l = item / 96, n0 = (item % 96) * 64;
                float a0 = 0.f, a1 = 0.f, a2 = 0.f, a3 = 0.f, a4 = 0.f;
                const float* wp = w_ada + ((size_t)l * 1024 + wave * 128) * 6144 + n0 + lane;
#pragma unroll 16
                for (int k = 0; k < 128; ++k) { const float wv = __builtin_nontemporal_load(&wp[(size_t)k * 6144]); const int kk = wave * 128 + k;
                    a0 += sc[kk] * wv; a1 += sc[1024 + kk] * wv; a2 += sc[2048 + kk] * wv; a3 += sc[3072 + kk] * wv; a4 += sc[4096 + kk] * wv; }
                red[(wave * 5 + 0) * 64 + lane] = a0; red[(wave * 5 + 1) * 64 + lane] = a1; red[(wave * 5 + 2) * 64 + lane] = a2; red[(wave * 5 + 3) * 64 + lane] = a3; red[(wave * 5 + 4) * 64 + lane] = a4;
                __syncthreads();
                if (tid < 320) { const int j = tid >> 6, ln = tid & 63; float s = b_ada[l * 6144 + n0 + ln];
#pragma unroll
                    for (int w = 0; w < 8; ++w) s += red[(w * 5 + j) * 64 + ln];
                    mods[(size_t)(l * 5 + j) * 6144 + n0 + ln] = s; }
                __syncthreads();
            }
        }
    }
    {
        LAS float* scr = (LAS float*)(lds + 32768 + wave * 8704);
        const int gw = blockIdx.x * 8 + wave, NGW = gridDim.x * 8;
        constexpr int I_IN = 16 * 64, I_QKV = 16 * 48, I_O = 16 * 32, I_OUT = 8 * 32, I_F1 = 16 * 176, I_F2 = 44 * 32, I_FOLD = 1024;
        constexpr int NITEMS = I_IN + I_QKV + I_O + I_OUT + 2 * I_F1 + 2 * I_F2 + I_FOLD;
        for (int it = gw; it < NITEMS; it += NGW) {
            int r = it;
            if (r < I_IN) { const int kb = r / 64, nb = r % 64; transpose_item(p.in[9], EVIN, kb * 64, nb * 32, (unsigned short*)(ws + WS_WIN), 1024, nb * 32, 0, scr, lane); continue; } r -= I_IN;
            if (r < I_QKV) { const int kb = r / 48, nb = r % 48; transpose_item(p.in[15], NQKV, kb * 64, nb * 32, (unsigned short*)(ws + WS_WQKV), 1024, nb * 32, 0, scr, lane); continue; } r -= I_QKV;
            if (r < I_O) { const int kb = r / 32, nb = r % 32; transpose_item(p.in[18], DM, kb * 64, nb * 32, (unsigned short*)(ws + WS_WO), 1024, nb * 32, 0, scr, lane); continue; } r -= I_O;
            if (r < I_OUT) { const int kb = r / 32, nb = r % 32; transpose_item(p.in[14] + (size_t)512 * 1024, DM, kb * 64, nb * 32, (unsigned short*)(ws + WS_WOUT), 1024, nb * 32, 512, scr, lane); continue; } r -= I_OUT;
            if (r < 2 * I_F1) { const int l = r / I_F1, q = r % I_F1, kb = q / 176, nb = q % 176, n0 = nb * 32;
                const int part = n0 >= DFF, jj = n0 - part * DFF, drow = (jj >> 7) * 256 + part * 128 + (jj & 127);
                transpose_item(p.in[19] + (size_t)l * DM * 2 * DFF, 2 * DFF, kb * 64, n0, (unsigned short*)(ws + WS_WF1 + l * WF1_STRIDE), 1024, drow, 0, scr, lane); continue; } r -= 2 * I_F1;
            if (r < 2 * I_F2) { const int l = r / I_F2, q = r % I_F2, kb = q / 32, nb = q % 32;
                transpose_item(p.in[20] + (size_t)l * DFF * DM, DM, kb * 64, nb * 32, (unsigned short*)(ws + WS_WF2 + l * WF2_STRIDE), DFF, nb * 32, 0, scr, lane); continue; } r -= 2 * I_F2;
            {
                const int g = r >> 8, cc = (r >> 4) & 15, nb = r & 15, n = nb * 64 + lane;
                const float* pw = p.in[10] + ((size_t)g * 128 + cc * 8) * 128; const float* psc = p.in[11] + g * 128; const float* wo = p.in[14] + (size_t)(g * 128) * 1024 + n;
                float a[8] = {0.f, 0.f, 0.f, 0.f, 0.f, 0.f, 0.f, 0.f};
                for (int d = 0; d < 128; ++d) { const float wv = psc[d] * wo[(size_t)d * 1024];
#pragma unroll
                    for (int c = 0; c < 8; ++c) a[c] += pw[c * 128 + d] * wv; }
                u32x4v o; o.x = pk2(a[0], a[1]); o.y = pk2(a[2], a[3]); o.z = pk2(a[4], a[5]); o.w = pk2(a[6], a[7]);
                *(u32x4v*)((unsigned short*)(ws + WS_WOUT) + (size_t)n * 1024 + g * 128 + cc * 8) = o;
            }
        }
    }
}

__device__ __forceinline__ void phase_p1(const Params& p, int tid, int lane, int wave) {
    unsigned char* ws = p.ws;
    const float* mods = (const float*)(ws + WS_MODS); const float* norm_g = p.in[8];
    const int gw = blockIdx.x * 8 + wave, NGW = gridDim.x * 8;
    {   float* gp = (float*)(ws + WS_GP);
        for (int idx = blockIdx.x * 512 + tid; idx < 3 * 5 * 1024; idx += gridDim.x * 512) { const int site = idx / 5120, j = (idx >> 10) % 5, c = idx & 1023, l = site >= 1, nrm = site != 1;
            gp[idx] = norm_g[(l * 2 + nrm) * 1024 + c] * (1.0f + mods[(size_t)(l * 5 + j) * 6144 + (nrm ? 4 : 1) * 1024 + c]); } }
#pragma unroll 1
    for (int site = 0; site < 3; ++site) {
        const int N = site == 1 ? NQKV : 2 * DFF, l = site >= 1, chunk = site == 1 ? 0 : 3;
        const unsigned short* Wt = (const unsigned short*)(ws + (site == 0 ? WS_WF1 : site == 1 ? WS_WQKV : WS_WF1 + WF1_STRIDE));
        float* dst = site == 1 ? (float*)(ws + WS_SWQKV) : (float*)(ws + WS_SWF1) + (site == 2) * 5 * 2 * DFF;
        if (gw < N) {
            float sh[5][16];
#pragma unroll
            for (int j = 0; j < 5; ++j) { const float* sp = mods + (size_t)(l * 5 + j) * 6144 + chunk * 1024 + 8 * lane;
#pragma unroll
                for (int q = 0; q < 4; ++q) { const f32x4v v = *(const f32x4v*)(sp + (q >> 1) * 512 + (q & 1) * 4); sh[j][4 * q] = v.x; sh[j][4 * q + 1] = v.y; sh[j][4 * q + 2] = v.z; sh[j][4 * q + 3] = v.w; } }
            for (int col = gw; col < N; col += NGW) {
                float f[16]; ld8f(Wt + (size_t)col * 1024 + 8 * lane, f); ld8f(Wt + (size_t)col * 1024 + 512 + 8 * lane, f + 8);
                float a[5];
#pragma unroll
                for (int j = 0; j < 5; ++j) { float s = 0.f;
#pragma unroll
                    for (int q = 0; q < 16; ++q) s += sh[j][q] * f[q];
                    a[j] = wave_sum(s); }
                if (lane == 0) {
#pragma unroll
                    for (int j = 0; j < 5; ++j) dst[(size_t)j * N + col] = a[j]; }
            }
        }
    }
    const float* xc = p.in[0]; const float* xl = p.in[1]; unsigned short* h = (unsigned short*)(ws + WS_H);
    for (int it = gw; it < MTOK / 4; it += NGW) {
        f32x4v v[4][4]; float ss[4];
#pragma unroll
        for (int rr = 0; rr < 4; ++rr) { const int row = it + rr * (MTOK / 4); const float* xr = row < NCTX ? xc + (size_t)row * DM : xl + (size_t)(row - NCTX) * DM;
#pragma unroll
            for (int q = 0; q < 4; ++q) v[rr][q] = *(const f32x4v*)(xr + 4 * lane + 256 * q); }
#pragma unroll
        for (int rr = 0; rr < 4; ++rr) { float s = 0.f;
#pragma unroll
            for (int q = 0; q < 4; ++q) s += (v[rr][q].x * v[rr][q].x + v[rr][q].y * v[rr][q].y) + (v[rr][q].z * v[rr][q].z + v[rr][q].w * v[rr][q].w);
            ss[rr] = s; }
#pragma unroll
        for (int rr = 0; rr < 4; ++rr) { const int row = it + rr * (MTOK / 4); const int j = row < NCTX ? 0 : 1 + ((row - NCTX) >> 12);
            const float rstd = __builtin_amdgcn_rsqf(wave_sum(ss[rr]) * (1.0f / DM) + EPS);
            const float* shp = mods + (size_t)j * 6144; const float* scp = shp + 1024;
#pragma unroll
            for (int q = 0; q < 4; ++q) { const int c = 4 * lane + 256 * q;
                const f32x4v gg = *(const f32x4v*)(norm_g + c), sc = *(const f32x4v*)(scp + c), shv = *(const f32x4v*)(shp + c);
                const f32x4v o = (v[rr][q] * rstd) * gg * (sc + 1.0f) + shv;
                u32x2v w; w.x = pk2(o.x, o.y); w.y = pk2(o.z, o.w);
                *(u32x2v*)(h + (size_t)row * DM + c) = w; } }
    }
}
__device__ __forceinline__ void phase_final(const unsigned short* xb, float* y, const float* g, const float* ss, int lane, int wave) {
    const int gw = blockIdx.x * 8 + wave, NGW = gridDim.x * 8;
    f32x4v gg[4];
#pragma unroll
    for (int q = 0; q < 4; ++q) gg[q] = *(const f32x4v*)(g + 4 * lane + 256 * q);
    for (int it = gw; it < MTOK / 4; it += NGW) {
        u32x2v v[4][4]; float rs[4];
#pragma unroll
        for (int rr = 0; rr < 4; ++rr) { const int row = it + rr * (MTOK / 4); rs[rr] = __builtin_amdgcn_rsqf(ss[row] * (1.0f / DM) + EPS);
#pragma unroll
            for (int q = 0; q < 4; ++q) v[rr][q] = *(const u32x2v*)(xb + (size_t)row * DM + 4 * lane + 256 * q); }
#pragma unroll
        for (int rr = 0; rr < 4; ++rr) { const int row = it + rr * (MTOK / 4);
#pragma unroll
            for (int q = 0; q < 4; ++q) { const f32x4v x = {bf_lo(v[rr][q].x), bf_hi(v[rr][q].x), bf_lo(v[rr][q].y), bf_hi(v[rr][q].y)};
                *(f32x4v*)(y + (size_t)row * DM + 4 * lane + 256 * q) = (x * rs[rr]) * gg[q]; } }
    }
}
__device__ __forceinline__ void phase_mixer(const unsigned short* P, unsigned short* MX, const float* conv_w, const float* conv_b, int lane, int wave) {
    const int gw = blockIdx.x * 8 + wave, NGW = gridDim.x * 8;
    const int c0 = 8 * lane, half = 1 << (lane >> 4);
    for (int it = gw; it < 2 * (MTOK / 8); it += NGW) {
        const int type = it & 1, row0 = (it >> 1) * 8;
        int t0, L; if (row0 < NCTX) { t0 = row0 & (LCTX - 1); L = LCTX; } else { t0 = (row0 - NCTX) & (LLAT - 1); L = LLAT; }
        const unsigned short* pr = P + (size_t)row0 * EVIN;
        if (type == 0) {
            float S[8] = {0.f, 0.f, 0.f, 0.f, 0.f, 0.f, 0.f, 0.f}, f[8];
#pragma unroll
            for (int k = 0; k < 16; ++k) { const int s = t0 - half + k; const float wgt = (k < 2 * half && s >= 0 && s < L) ? 1.f : 0.f; const int sc = min(max(s, 0), L - 1);
                ld8f(pr + (ptrdiff_t)(sc - t0) * EVIN + c0, f);
#pragma unroll
                for (int i = 0; i < 8; ++i) S[i] += wgt * f[i]; }
#pragma unroll
            for (int r = 0; r < 8; ++r) { const int t = t0 + r; const int lo = max(t - half, 0), hi = min(t + half, L); const float inv = 1.0f / (float)(hi - lo);
                ld8f(pr + (size_t)r * EVIN + c0, f);
                u32x4v o; o.x = pk2(S[0] * inv - f[0], S[1] * inv - f[1]); o.y = pk2(S[2] * inv - f[2], S[3] * inv - f[3]); o.z = pk2(S[4] * inv - f[4], S[5] * inv - f[5]); o.w = pk2(S[6] * inv - f[6], S[7] * inv - f[7]);
                *(u32x4v*)(MX + (size_t)(row0 + r) * DM + c0) = o;
                if (r < 7) {
                    { const int s = t + half; const float wgt = s < L ? 1.f : 0.f; ld8f(pr + (ptrdiff_t)(min(s, L - 1) - t0) * EVIN + c0, f);
#pragma unroll
                      for (int i = 0; i < 8; ++i) S[i] += wgt * f[i]; }
                    { const int s = t - half; const float wgt = s >= 0 ? 1.f : 0.f; ld8f(pr + (ptrdiff_t)(max(s, 0) - t0) * EVIN + c0, f);
#pragma unroll
                      for (int i = 0; i < 8; ++i) S[i] -= wgt * f[i]; } } }
        } else {
            float cw0[8], cw1[8], cw2[8], cb[8];
#pragma unroll
            for (int i = 0; i < 8; ++i) { cw0[i] = conv_w[c0 + i]; cw1[i] = conv_w[512 + c0 + i]; cw2[i] = conv_w[1024 + c0 + i]; cb[i] = conv_b[c0 + i]; }
            float zp[8], zc[8], zn[8], a[8], b[8];
            if (t0 > 0) { ld8f(pr - EVIN + 1024 + c0, a); ld8f(pr - EVIN + 1536 + c0, b);
#pragma unroll
                for (int i = 0; i < 8; ++i) zp[i] = a[i] * b[i]; }
            else {
#pragma unroll
                for (int i = 0; i < 8; ++i) zp[i] = 0.f; }
            ld8f(pr + 1024 + c0, a); ld8f(pr + 1536 + c0, b);
#pragma unroll
            for (int i = 0; i < 8; ++i) zc[i] = a[i] * b[i];
#pragma unroll
            for (int r = 0; r < 8; ++r) { const int t = t0 + r;
                if (t + 1 < L) { ld8f(pr + (size_t)(r + 1) * EVIN + 1024 + c0, a); ld8f(pr + (size_t)(r + 1) * EVIN + 1536 + c0, b);
#pragma unroll
                    for (int i = 0; i < 8; ++i) zn[i] = a[i] * b[i]; }
                else {
#pragma unroll
                    for (int i = 0; i < 8; ++i) zn[i] = 0.f; }
                ld8f(pr + (size_t)r * EVIN + 512 + c0, a);
                float y[8];
#pragma unroll
                for (int i = 0; i < 8; ++i) y[i] = a[i] * (zp[i] * cw0[i] + zc[i] * cw1[i] + zn[i] * cw2[i] + cb[i]);
                u32x4v o; o.x = pk2(y[0], y[1]); o.y = pk2(y[2], y[3]); o.z = pk2(y[4], y[5]); o.w = pk2(y[6], y[7]);
                *(u32x4v*)(MX + (size_t)(row0 + r) * DM + 512 + c0) = o;
#pragma unroll
                for (int i = 0; i < 8; ++i) { zp[i] = zc[i]; zc[i] = zn[i]; } }
        }
    }
}
__device__ __forceinline__ void phase_qknorm(const Params& p, int lane, int wave) {
    unsigned char* ws = p.ws;
    const unsigned short* QKV = (const unsigned short*)(ws + WS_QKV);
    unsigned short* Q = (unsigned short*)(ws + WS_Q); unsigned short* KLAT = (unsigned short*)(ws + WS_KLAT); unsigned short* VLAT = (unsigned short*)(ws + WS_VLAT);
    unsigned short* KCTX = (unsigned short*)(ws + WS_KCTX); unsigned short* VCTX = (unsigned short*)(ws + WS_VCTX);
    float* nck = p.out + (size_t)MTOK * DM; float* ncv = nck + (size_t)16 * 256 * 256;
    const int gw = blockIdx.x * 8 + wave, NGW = gridDim.x * 8;
    const int i8 = 8 * (lane & 15), hsel = lane >> 4;
    const bool colaxis = (i8 >> 6) != 0, second = ((i8 >> 5) & 1) != 0;
    float qg[8], kg[8], invf[8];
#pragma unroll
    for (int q = 0; q < 8; ++q) { qg[q] = p.in[16][i8 + q]; kg[q] = p.in[17][i8 + q]; invf[q] = __builtin_amdgcn_exp2f(-(float)((i8 & 31) + q) * (13.287712379549449f / 32.0f)); }
    for (int row = gw; row < MTOK; row += NGW) {
        const unsigned short* r = QKV + (size_t)row * NQKV + 8 * lane;
        const u32x4v w0 = *(const u32x4v*)(r), w1 = *(const u32x4v*)(r + 512), w2 = *(const u32x4v*)(r + 1024);
        const bool lat = row >= NCTX; int b, t; float cs[8], sn[8];
        if (lat) { const int rr = row - NCTX; b = rr >> 12; t = rr & 4095; const float pos = (float)(colaxis ? (t & 63) : (t >> 6));
#pragma unroll
            for (int q = 0; q < 8; ++q) { const float ang = pos * invf[q]; cs[q] = __cosf(ang); sn[q] = __sinf(ang); if (!second) sn[q] = -sn[q]; } }
        else { b = row >> 8; t = row & 255;
#pragma unroll
            for (int q = 0; q < 8; ++q) { cs[q] = 1.f; sn[q] = 0.f; } }
#pragma unroll
        for (int c = 0; c < 3; ++c) {
            const u32x4v w = c == 0 ? w0 : c == 1 ? w1 : w2;
            float x[8] = {bf_lo(w.x), bf_hi(w.x), bf_lo(w.y), bf_hi(w.y), bf_lo(w.z), bf_hi(w.z), bf_lo(w.w), bf_hi(w.w)};
            float s = 0.f;
#pragma unroll
            for (int q = 0; q < 8; ++q) s += x[q] * x[q];
            s += __shfl_xor(s, 1); s += __shfl_xor(s, 2); s += __shfl_xor(s, 4); s += __shfl_xor(s, 8);
            const float rstd = __builtin_amdgcn_rsqf(s * (1.0f / 128.0f) + EPS);
            float o[8];
#pragma unroll
            for (int q = 0; q < 8; ++q) { const float y = x[q] * rstd * (c < 2 ? qg[q] : kg[q]); const float yp = __shfl_xor(y, 4); o[q] = y * cs[q] + yp * sn[q]; }
            if (c < 2) { u32x4v ow; ow.x = pk2(o[0], o[1]); ow.y = pk2(o[2], o[3]); ow.z = pk2(o[4], o[5]); ow.w = pk2(o[6], o[7]);
                *(u32x4v*)(Q + (size_t)row * DM + c * 512 + 8 * lane) = ow; }
            else {
                const int kh = hsel & 1; const bool isv = hsel >= 2;
                u32x4v ow = w;
                if (!isv) { ow.x = pk2(o[0], o[1]); ow.y = pk2(o[2], o[3]); ow.z = pk2(o[4], o[5]); ow.w = pk2(o[6], o[7]); }
                if (lat) { unsigned short* dst = (isv ? VLAT : KLAT) + ((size_t)(b * 2 + kh) * SKV + PAST + t) * 128 + i8; *(u32x4v*)dst = ow; }
                else { unsigned short* dst = (isv ? VCTX : KCTX) + ((size_t)(b * 2 + kh) * LCTX + t) * 128 + i8; *(u32x4v*)dst = ow;
                    float* od = (isv ? ncv : nck) + ((size_t)(b * LCTX + t) * 2 + kh) * 128 + i8;
                    f32x4v f0, f1;
                    if (isv) { f0 = (f32x4v){x[0], x[1], x[2], x[3]}; f1 = (f32x4v){x[4], x[5], x[6], x[7]}; } else { f0 = (f32x4v){o[0], o[1], o[2], o[3]}; f1 = (f32x4v){o[4], o[5], o[6], o[7]}; }
                    *(f32x4v*)od = f0; *(f32x4v*)(od + 4) = f1; }
            }
        }
    }
    for (int it = gw; it < 2 * 4 * PAST; it += NGW) {
        const int which = it >> 11, q = it & 2047, b = q >> 9, s = q & 511, kh = lane >> 5;
        const f32x4v v = *(const f32x4v*)((which ? p.in[3] : p.in[2]) + (size_t)(b * PAST + s) * 256 + 4 * lane);
        u32x2v w; w.x = pk2(v.x, v.y); w.y = pk2(v.z, v.w);
        *(u32x2v*)((which ? VLAT : KLAT) + ((size_t)(b * 2 + kh) * SKV + s) * 128 + 4 * (lane & 31)) = w;
    }
}
__device__ __forceinline__ void phase_attention(const Params& p, char* lds) {
    unsigned char* ws = p.ws;
    const bf16* Q = (const bf16*)(ws + WS_Q); bf16* O = (bf16*)(ws + WS_O);
    const bf16* KLAT = (const bf16*)(ws + WS_KLAT); const bf16* VLAT = (const bf16*)(ws + WS_VLAT); const bf16* KCTX = (const bf16*)(ws + WS_KCTX); const bf16* VCTX = (const bf16*)(ws + WS_VCTX);
    for (int L = blockIdx.x; L < 128 + 512; L += gridDim.x) {
        const bf16* Qp; const bf16* Kp; const bf16* Vp; bf16* Op; int seq;
        if (L < 128) { const int b = L >> 3, h = L & 7; const size_t q0 = (size_t)(b * LCTX) * DM + h * 128, k0 = (size_t)(b * 2 + (h >> 2)) * LCTX * 128;
            Qp = Q + q0; Kp = KCTX + k0; Vp = VCTX + k0; Op = O + q0; seq = LCTX; }
        else { const int u = L - 128, bk = u & 7, w = u >> 3, hq = w >> 4, qb = w & 15, b = bk >> 1, kvh = bk & 1, h = kvh * 4 + hq;
            const size_t q0 = (size_t)(NCTX + b * LLAT + qb * 256) * DM + h * 128, k0 = (size_t)(b * 2 + kvh) * SKV * 128;
            Qp = Q + q0; Kp = KLAT + k0; Vp = VLAT + k0; Op = O + q0; seq = SKV; }
        attn::attn_dense_body<bf16>(Qp, Kp, Vp, Op, seq, lds);
        __syncthreads();
    }
}

#define XB_TMO      128
#define XB_XCNT(j)  (256  + 64 * (j))
#define XB_XSUB(j)  (1280 + 64 * (j))
#define XB_XGEN(j)  (2304 + 64 * (j))
#define XB_TOP      3328
#define XB_TOPGEN   3392
#define XCD_BAR_WORDS 3456
#define XB_SPIN_CAP (1u << 18)

__device__ __forceinline__ unsigned xb_ld(unsigned* p)              { return __hip_atomic_load(p, __ATOMIC_RELAXED, __HIP_MEMORY_SCOPE_AGENT); }
__device__ __forceinline__ unsigned xb_add(unsigned* p, unsigned v) { return __hip_atomic_fetch_add(p, v, __ATOMIC_RELAXED, __HIP_MEMORY_SCOPE_AGENT); }
__device__ __forceinline__ unsigned xb_xcc_id() { return (unsigned)__builtin_amdgcn_s_getreg((3 << 11) | 20) & 0xFu; }
#define XB_SPIN(cond, bar) do { unsigned _sp = 0; while (cond) { __builtin_amdgcn_s_sleep(1); \
    if ((++_sp & 255u) == 0u) { if (xb_ld(&(bar)[XB_TMO])) break; if (_sp > XB_SPIN_CAP) { atomicAdd(&(bar)[XB_TMO], 1u); break; } } } } while (0)

struct XcdBarrier {
    unsigned* bar; unsigned x;
    volatile LAS unsigned* st;
};

__device__ __forceinline__ XcdBarrier xcd_barrier_post(unsigned* bar, volatile LAS unsigned* st) {
    XcdBarrier b; b.bar = bar; b.x = xb_xcc_id(); b.st = st;
    if (threadIdx.x == 0) (void)xb_add(&bar[XB_XCNT(b.x)], 1u);
    return b;
}
__device__ __forceinline__ void xcd_barrier_complete(unsigned* bar, unsigned x, unsigned& nloc, unsigned& nx) {
    const unsigned G = gridDim.x * gridDim.y * gridDim.z;
    unsigned sum, cnt, mine, sp = 0u;
    for (;;) {
        sum = 0u; cnt = 0u; mine = 0u;
#pragma unroll
        for (unsigned j = 0; j < 16; ++j) { const unsigned c = xb_ld(&bar[XB_XCNT(j)]); sum += c; cnt += (c > 0u) ? 1u : 0u; mine = (j == x) ? c : mine; }
        if (sum == G) break;
        __builtin_amdgcn_s_sleep(1);
        if ((++sp & 255u) == 0u) { if (xb_ld(&bar[XB_TMO])) break; if (sp > XB_SPIN_CAP) { atomicAdd(&bar[XB_TMO], 1u); break; } }
    }
    nloc = mine > 0u ? mine : 1u; nx = cnt > 0u ? cnt : 1u;
}

__device__ __forceinline__ void xcd_barrier(const XcdBarrier& b) {
    asm volatile("s_waitcnt vmcnt(0)" ::: "memory");
    __syncthreads();
    if (threadIdx.x == 0) {
        unsigned* bar = b.bar;
        __builtin_amdgcn_s_waitcnt(0);
        unsigned nloc = b.st[0], nx = b.st[1];
        if (nloc == 0u) { xcd_barrier_complete(bar, b.x, nloc, nx); b.st[0] = nloc; b.st[1] = nx; }
        const unsigned old = xb_add(&bar[XB_XSUB(b.x)], 1u);
        const unsigned gen = old / nloc;
        if (old + 1u == (gen + 1u) * nloc) {
            __builtin_amdgcn_fence(__ATOMIC_RELEASE, "agent");
            asm volatile("s_waitcnt vmcnt(0)" ::: "memory");
            const unsigned og = xb_add(&bar[XB_TOP], 1u);
            const unsigned tg = og / nx;
            if (og + 1u == (tg + 1u) * nx) xb_add(&bar[XB_TOPGEN], 1u);
            else XB_SPIN(xb_ld(&bar[XB_TOPGEN]) == tg, bar);
            __builtin_amdgcn_fence(__ATOMIC_ACQUIRE, "agent");
            xb_add(&bar[XB_XGEN(b.x)], 1u);
            asm volatile("s_waitcnt vmcnt(0)" ::: "memory");
        } else {
            XB_SPIN(xb_ld(&bar[XB_XGEN(b.x)]) == gen, bar);
            __builtin_amdgcn_fence(__ATOMIC_ACQUIRE, "agent");
            asm volatile("s_waitcnt vmcnt(0)" ::: "memory");
        }
    }
    __syncthreads();
}

template <int ph> __device__ __forceinline__ void run_phase(const Params& p, unsigned char* lds, int tid, int lane, int wave) {
    unsigned char* ws = p.ws;
    const float* mods = (const float*)(ws + WS_MODS); const float* gp = (const float*)(ws + WS_GP); float* ss = (float*)(ws + WS_SS);
    const float* sWf1 = (const float*)(ws + WS_SWF1); const float* sWqkv = (const float*)(ws + WS_SWQKV);
    float* xo = p.out;
    typedef pg8::bf16_t bt;
    if constexpr (ph == 0) phase_prep(p, (LAS unsigned char*)lds, tid, lane, wave);
    else if constexpr (ph == 1) phase_p1(p, tid, lane, wave);
    else if constexpr (ph == 2) {
        pg8::Gemm g{(const bt*)(ws + WS_H), (const bt*)(ws + WS_WIN), MTOK, EVIN, DM}; pg8::HalfOrder S; S.init(gridDim.x, blockIdx.x, EVIN / 256);
        pg8::EpiStoreN<false> E{(bt*)(ws + WS_P), EVIN, nullptr, nullptr, 0};
        pg8::gemm_phase<pg8::EpiStoreN<false>, pg8::HalfOrder, true, true>((LAS unsigned char*)lds, g, S, E); }
    else if constexpr (ph == 3) phase_mixer((const unsigned short*)(ws + WS_P), (unsigned short*)(ws + WS_MX), p.in[12], p.in[13], lane, wave);
    else if constexpr (ph == 4 || ph == 6 || ph == 10 || ph == 12) {
        constexpr int l = ph >= 10; constexpr bool ffn = (ph == 6 || ph == 12); constexpr int K = ffn ? DFF : DM; constexpr int site = ph == 4 ? 0 : ph == 6 ? 1 : ph == 10 ? 2 : 3;
        const unsigned char* A = ws + (ffn ? WS_ACT : (ph == 4 ? WS_MX : WS_O));
        const unsigned char* Bt = ws + (ffn ? WS_WF2 + l * WF2_STRIDE : (ph == 4 ? WS_WOUT : WS_WO));
        pg8::Gemm g{(const bt*)A, (const bt*)Bt, MTOK, DM, K}; pg8::HalfOrder S; S.init(gridDim.x, blockIdx.x);
        typedef pg8::EpiResNorm<(site < 3), (ph == 4)> Epi;
        Epi E{p.in[0], p.in[1], (bt*)(ws + WS_XB), mods + (size_t)l * 5 * 6144 + (ffn ? 5 : 2) * 1024, gp + (site < 3 ? site : 0) * 5120, (bt*)(ws + WS_H), ss + site * MTOK};
        pg8::gemm_phase<Epi, pg8::HalfOrder, true, true>((LAS unsigned char*)lds, g, S, E); }
    else if constexpr (ph == 5 || ph == 11) { constexpr int l = ph == 11;
        pg8::Gemm g{(const bt*)(ws + WS_H), (const bt*)(ws + WS_WF1 + l * WF1_STRIDE), MTOK, 2 * DFF, DM}; pg8::StaticOrder S; S.init(MTOK, 2 * DFF, gridDim.x, blockIdx.x);
        pg8::EpiSwigluN E{(bt*)(ws + WS_ACT), DFF, ss + (l ? 2 : 0) * MTOK, sWf1 + l * 5 * 2 * DFF, 2 * DFF};
        pg8::gemm_phase<pg8::EpiSwigluN, pg8::StaticOrder, true, true>((LAS unsigned char*)lds, g, S, E); }
    else if constexpr (ph == 7) {
        pg8::Gemm g{(const bt*)(ws + WS_H), (const bt*)(ws + WS_WQKV), MTOK, NQKV, DM}; pg8::StaticOrder S; S.init(MTOK, NQKV, gridDim.x, blockIdx.x);
        pg8::EpiStoreN<true> E{(bt*)(ws + WS_QKV), NQKV, ss + 1 * MTOK, sWqkv, NQKV};
        pg8::gemm_phase<pg8::EpiStoreN<true>, pg8::StaticOrder, true, true>((LAS unsigned char*)lds, g, S, E); }
    else if constexpr (ph == 8) phase_qknorm(p, lane, wave);
    else if constexpr (ph == 9) phase_attention(p, (char*)lds);
    else if constexpr (ph == 13) phase_final((const unsigned short*)(ws + WS_XB), xo, p.in[21], ss + 3 * MTOK, lane, wave);
}
__global__ void __launch_bounds__(512, 2) mega_fwd(Params p) {
    extern __shared__ __attribute__((aligned(16))) unsigned char lds[];
    cg::grid_group grid = cg::this_grid();
    const int tid = threadIdx.x, lane = tid & 63, wave = __builtin_amdgcn_readfirstlane(tid >> 6);
    const bool multi = p.ph_hi - p.ph_lo > 1, use_cg = gridDim.x > 1024u;
    if (tid < 2) ((LAS unsigned*)(lds + 131072))[tid] = 0u;
    __syncthreads();
    XcdBarrier bar; bar.bar = (unsigned*)(p.ws + WS_BAR); bar.x = 0; bar.st = nullptr;
    if (multi && !use_cg) bar = xcd_barrier_post((unsigned*)(p.ws + WS_BAR), (volatile LAS unsigned*)(lds + 131072));
#define SEAM(k) do { if (use_cg) grid.sync(); else xcd_barrier(bar); } while (0)
#define PHASE(k) if (p.ph_lo <= (k) && (k) < p.ph_hi) { run_phase<(k)>(p, lds, tid, lane, wave); if ((k) + 1 < p.ph_hi) SEAM(k); }
    PHASE(0) PHASE(1) PHASE(2) PHASE(3) PHASE(4) PHASE(5) PHASE(6) PHASE(7) PHASE(8) PHASE(9) PHASE(10) PHASE(11) PHASE(12) PHASE(13)
#undef PHASE
}

#ifndef MK_SPLIT
#define MK_SPLIT 0
#endif
extern "C" void kernel_launch(void* const* d_in, const int* in_sizes, int n_in, void* d_out, int out_size, void* d_ws, size_t ws_size, hipStream_t stream) {
    static int grid_blocks = 0;
    if (grid_blocks == 0) {
        if (n_in != 22 || ws_size < WS_END) { fprintf(stderr, "kernel_launch: unexpected n_in %d / ws_size %zu\n", n_in, ws_size); grid_blocks = -1; return; }
        int dev = 0, cus = 0, per_cu = 0;
        (void)hipGetDevice(&dev); (void)hipDeviceGetAttribute(&cus, hipDeviceAttributeMultiprocessorCount, dev);
        if (hipFuncSetAttribute((const void*)mega_fwd, hipFuncAttributeMaxDynamicSharedMemorySize, LDS_BYTES) != hipSuccess) { fprintf(stderr, "kernel_launch: hipFuncSetAttribute failed\n"); grid_blocks = -1; return; }
        if (hipOccupancyMaxActiveBlocksPerMultiprocessor(&per_cu, (const void*)mega_fwd, 512, LDS_BYTES) != hipSuccess || per_cu < 1) { fprintf(stderr, "kernel_launch: occupancy query gave %d\n", per_cu); grid_blocks = -1; return; }
        grid_blocks = cus * per_cu;
    }
    if (grid_blocks < 0) return;
    if (hipMemsetAsync((char*)d_ws + WS_ZERO_BEGIN, 0, WS_ZERO_BYTES, stream) != hipSuccess) { fprintf(stderr, "kernel_launch: hipMemsetAsync failed\n"); return; }
    Params p{};
    for (int i = 0; i < 22; ++i) p.in[i] = (const float*)d_in[i];
    p.out = (float*)d_out; p.ws = (unsigned char*)d_ws;
#if MK_SPLIT
    for (int ph = 0; ph < NPHASE; ++ph) {
        p.ph_lo = ph; p.ph_hi = ph + 1; void* args[] = {&p};
        hipError_t e = hipLaunchCooperativeKernel((const void*)mega_fwd, dim3(grid_blocks), dim3(512), args, LDS_BYTES, stream);
        if (e != hipSuccess) { fprintf(stderr, "cooperative launch failed: %s (grid %d)\n", hipGetErrorString(e), grid_blocks); return; }
    }
#else
    p.ph_lo = 0; p.ph_hi = NPHASE; void* args[] = {&p};
    hipError_t e = hipLaunchCooperativeKernel((const void*)mega_fwd, dim3(grid_blocks), dim3(512), args, LDS_BYTES, stream);
    if (e != hipSuccess) fprintf(stderr, "cooperative launch failed: %s (grid %d)\n", hipGetErrorString(e), grid_blocks);
#endif
}
```

```cpp
#include <hip/hip_runtime.h>
#include <hip/hip_cooperative_groups.h>
#include <hip/hip_bf16.h>
#include <cstdio>
#include <cstdint>
namespace cg = cooperative_groups;

namespace pg8 {
#define PG8_LAS __attribute__((address_space(3)))
typedef unsigned short bf16_t;
typedef short bf16x8 __attribute__((ext_vector_type(8)));
typedef float f32x4 __attribute__((ext_vector_type(4)));
typedef unsigned u32x4 __attribute__((ext_vector_type(4)));
constexpr int BM = 256, BK = 64, HALF = 128, HTB = HALF * BK * 2  , STAGE_BYTES = 8 * HTB, NXCD = 8, WGM = 8;

__host__ __device__ __forceinline__ int lds_byte(int r, int c) { const int st = (r >> 4) * 2 + (c >> 5), rr = r & 15, cc = c & 31, ob = rr * 64 + cc * 2; return st * 1024 + (ob ^ (((ob >> 9) & 1) << 5)); }
__host__ __device__ __forceinline__ void stage_rc(int b, int& R, int& C) { const int st = b / 1024, sb = b % 1024, swz = sb ^ (((sb >> 9) & 1) << 5); R = (st >> 1) * 16 + swz / 64; C = (st & 1) * 32 + (swz % 64) / 2; }
__host__ __device__ __forceinline__ int perm32(int rho) { const int n = rho >> 4, i = rho & 15; return 8 * (i >> 2) + 4 * n + (i & 3); }

struct Unit { int pm, pn, hf; };
struct Gemm { const bf16_t* A; const bf16_t* Bt; int M, N, K; };

struct StaticOrder {
    int nM, nN, nwg, G, c;
    __host__ __device__ void init(int M, int N, int G_, int c_) { nM = M / BM; nN = N / BM; nwg = nM * nN; G = G_; c = c_; }
    __host__ __device__ bool next(int i, Unit& u) const {
        const long L = (long)i * G + c; if (L >= nwg) return false;
        int wgid = (int)L; { const int q = nwg / NXCD, r = nwg % NXCD, xcd = wgid % NXCD, off = wgid / NXCD; wgid = (xcd < r ? xcd * (q + 1) : r * (q + 1) + (xcd - r) * q) + off; }
        const int nig = WGM * nN, gid = wgid / nig, fm = gid * WGM, gsz = (nM - fm) < WGM ? (nM - fm) : WGM;
        u.pm = fm + ((wgid % nig) % gsz); u.pn = (wgid % nig) / gsz; u.hf = 0; return true;
    }
    __device__ __forceinline__ void a_ready(const Unit&) const {}
    __device__ __forceinline__ void done(const Unit&) const {}
};
struct HalfOrder {
    int G, c, ncol;
    __host__ __device__ void init(int G_, int c_, int ncol_ = 4) { G = G_; c = c_; ncol = ncol_; }
    __host__ __device__ __forceinline__ bool next(int i, Unit& u) const {
        const int L = i * G + c, nhalf = 32 * ncol; if (L >= nhalf + 64 * ncol) return false;
        const bool full = L >= nhalf; const int Lf = L - nhalf, x = Lf & 7, slot = Lf >> 3, h = L;
        u.pm = full ? 16 + x * 8 + slot / ncol : h / (2 * ncol); u.pn = full ? slot % ncol : h % (2 * ncol); u.hf = full ? 0 : 1;
        return true;
    }
    __device__ __forceinline__ void a_ready(const Unit&) const {}
    __device__ __forceinline__ void done(const Unit&) const {}
};

__device__ __forceinline__ unsigned cvt_pk_bf16(float lo, float hi) { unsigned r; asm volatile("v_cvt_pk_bf16_f32 %0, %1, %2" : "=v"(r) : "v"(lo), "v"(hi)); return r; }
__device__ __forceinline__ int cond_of(int pm) { return pm < 16 ? 0 : 1 + ((pm - 16) >> 4); }
template <bool NORM> struct EpiStoreN {
    static constexpr bool PERM = true, AFTER_DRAIN = false;
    bf16_t* O; int ldc; const float* ss; const float* sW; int ldw;
    __device__ __forceinline__ void operator()(const f32x4 (&acc)[2][2][4][2], const Unit& u, int wr, int wc, int fr, int fq) const {
        const int row0 = u.pm * BM + wr * 64 + fr, col0 = u.pn * (u.hf ? HALF : BM) + wc * 32 + 8 * fq; const int nbj = u.hf ? 1 : 2;
        f32x4 bv[2][2];
        if constexpr (NORM) { const float* bp = sW + (size_t)cond_of(u.pm) * ldw + col0;
#pragma unroll
            for (int bj = 0; bj < 2; ++bj)
#pragma unroll
                for (int n = 0; n < 2; ++n) bv[bj][n] = *(const f32x4*)(bp + bj * HALF + 4 * n); }
#pragma unroll
        for (int ai = 0; ai < 2; ++ai)
#pragma unroll
            for (int m = 0; m < 4; ++m) { const int r = row0 + ai * HALF + m * 16; bf16_t* rowp = O + (size_t)r * ldc + col0;
                float rs = 1.f; if constexpr (NORM) rs = __builtin_amdgcn_rsqf(ss[r] * (1.0f / 1024.0f) + 1e-6f);
#pragma unroll
                for (int bj = 0; bj < 2; ++bj) { if (bj >= nbj) continue; f32x4 v0 = acc[ai][bj][m][0], v1 = acc[ai][bj][m][1];
                    if constexpr (NORM) { v0 = v0 * rs + bv[bj][0]; v1 = v1 * rs + bv[bj][1]; }
                    u32x4 w; w.x = cvt_pk_bf16(v0[0], v0[1]); w.y = cvt_pk_bf16(v0[2], v0[3]); w.z = cvt_pk_bf16(v1[0], v1[1]); w.w = cvt_pk_bf16(v1[2], v1[3]);
                    *(u32x4*)(rowp + bj * HALF) = w; } }
    }
};
__device__ __forceinline__ float silu_mul(float a, float b) { return a * __builtin_amdgcn_rcpf(1.0f + __builtin_amdgcn_exp2f(-1.4426950408889634f * a)) * b; }
struct EpiSwigluN {
    static constexpr bool PERM = true, AFTER_DRAIN = false;
    bf16_t* O; int ldc; const float* ss; const float* sW; int ldw;
    __device__ __forceinline__ void operator()(const f32x4 (&acc)[2][2][4][2], const Unit& u, int wr, int wc, int fr, int fq) const {
        const int row0 = u.pm * BM + wr * 64 + fr, col0 = u.pn * HALF + wc * 32 + 8 * fq;
        const float* bp = sW + (size_t)cond_of(u.pm) * ldw + u.pn * BM + wc * 32 + 8 * fq;
        const f32x4 ba0 = *(const f32x4*)(bp), ba1 = *(const f32x4*)(bp + 4), bb0 = *(const f32x4*)(bp + HALF), bb1 = *(const f32x4*)(bp + HALF + 4);
#pragma unroll
        for (int ai = 0; ai < 2; ++ai)
#pragma unroll
            for (int m = 0; m < 4; ++m) { const int r = row0 + ai * HALF + m * 16; bf16_t* rowp = O + (size_t)r * ldc + col0;
                const float rs = __builtin_amdgcn_rsqf(ss[r] * (1.0f / 1024.0f) + 1e-6f);
                const f32x4 a0 = acc[ai][0][m][0] * rs + ba0, a1 = acc[ai][0][m][1] * rs + ba1, b0 = acc[ai][1][m][0] * rs + bb0, b1 = acc[ai][1][m][1] * rs + bb1;
                u32x4 w; w.x = cvt_pk_bf16(silu_mul(a0[0], b0[0]), silu_mul(a0[1], b0[1])); w.y = cvt_pk_bf16(silu_mul(a0[2], b0[2]), silu_mul(a0[3], b0[3]));
                w.z = cvt_pk_bf16(silu_mul(a1[0], b1[0]), silu_mul(a1[1], b1[1])); w.w = cvt_pk_bf16(silu_mul(a1[2], b1[2]), silu_mul(a1[3], b1[3]));
                *(u32x4*)rowp = w; }
    }
};
template <bool HB, bool FIRST> struct EpiResNorm {
    static constexpr bool PERM = true, AFTER_DRAIN = false;
    const float* base_ctx; const float* base_lat; bf16_t* xb; const float* gate; const float* gp; bf16_t* hb; float* ss;
    __device__ __forceinline__ void operator()(const f32x4 (&acc)[2][2][4][2], const Unit& u, int wr, int wc, int fr, int fq) const {
        const int j = cond_of(u.pm);
        const float* base = u.pm < 16 ? base_ctx + (size_t)u.pm * BM * 1024 : base_lat + (size_t)(u.pm - 16) * BM * 1024;
        const int col0 = u.pn * (u.hf ? HALF : BM) + wc * 32 + 8 * fq, rl0 = wr * 64 + fr; const int nbj = u.hf ? 1 : 2;
        f32x4 gv[2][2], pv[2][2];
#pragma unroll
        for (int bj = 0; bj < 2; ++bj)
#pragma unroll
            for (int n = 0; n < 2; ++n) { if (bj >= nbj) continue; gv[bj][n] = *(const f32x4*)(gate + (size_t)j * 6144 + col0 + bj * HALF + n * 4);
                if constexpr (HB) pv[bj][n] = *(const f32x4*)(gp + (size_t)j * 1024 + col0 + bj * HALF + n * 4); }
        bf16_t* outp = xb + (size_t)u.pm * BM * 1024; bf16_t* hbp = hb + (size_t)u.pm * BM * 1024; float* ssp = ss + u.pm * BM;
#pragma unroll
        for (int ai = 0; ai < 2; ++ai)
#pragma unroll
            for (int m = 0; m < 4; ++m) { const int rl = rl0 + ai * HALF + m * 16; const size_t off = (size_t)rl * 1024 + col0; float s = 0.f;
#pragma unroll
                for (int bj = 0; bj < 2; ++bj) { if (bj >= nbj) continue;
                    f32x4 b0, b1;
                    if constexpr (FIRST) { b0 = __builtin_nontemporal_load((const f32x4*)(base + off + bj * HALF)); b1 = __builtin_nontemporal_load((const f32x4*)(base + off + bj * HALF + 4)); }
                    else { const u32x4 bw = *(const u32x4*)(outp + off + bj * HALF);
                        b0 = (f32x4){__builtin_bit_cast(float, bw.x << 16), __builtin_bit_cast(float, bw.x & 0xffff0000u), __builtin_bit_cast(float, bw.y << 16), __builtin_bit_cast(float, bw.y & 0xffff0000u)};
                        b1 = (f32x4){__builtin_bit_cast(float, bw.z << 16), __builtin_bit_cast(float, bw.z & 0xffff0000u), __builtin_bit_cast(float, bw.w << 16), __builtin_bit_cast(float, bw.w & 0xffff0000u)}; }
                    const f32x4 o0 = b0 + gv[bj][0] * acc[ai][bj][m][0], o1 = b1 + gv[bj][1] * acc[ai][bj][m][1];
                    { u32x4 ow; ow.x = cvt_pk_bf16(o0[0], o0[1]); ow.y = cvt_pk_bf16(o0[2], o0[3]); ow.z = cvt_pk_bf16(o1[0], o1[1]); ow.w = cvt_pk_bf16(o1[2], o1[3]); *(u32x4*)(outp + off + bj * HALF) = ow; }
                    s += ((o0[0] * o0[0] + o0[1] * o0[1]) + (o0[2] * o0[2] + o0[3] * o0[3])) + ((o1[0] * o1[0] + o1[1] * o1[1]) + (o1[2] * o1[2] + o1[3] * o1[3]));
                    if constexpr (HB) { const f32x4 h0 = o0 * pv[bj][0], h1 = o1 * pv[bj][1]; u32x4 w; w.x = cvt_pk_bf16(h0[0], h0[1]); w.y = cvt_pk_bf16(h0[2], h0[3]); w.z = cvt_pk_bf16(h1[0], h1[1]); w.w = cvt_pk_bf16(h1[2], h1[3]); *(u32x4*)(hbp + off + bj * HALF) = w; } }
                s += __shfl_xor(s, 16); s += __shfl_xor(s, 32);
                if (fq == 0) __hip_atomic_fetch_add(ssp + rl, s, __ATOMIC_RELAXED, __HIP_MEMORY_SCOPE_AGENT); }
    }
};

template <class Epi, class Sched, bool ALIGN_EPI = false, bool SP2 = false>
__device__ __forceinline__ void gemm_phase(PG8_LAS unsigned char* lds, const Gemm g, const Sched& S, const Epi& E) {
    const int tid = threadIdx.x, wid = __builtin_amdgcn_readfirstlane(tid >> 6), lane = tid & 63, wr = wid >> 2, wc = wid & 3, fr = lane & 15, fq = lane >> 4;
    const int K = g.K, nt = K / BK;
    unsigned voffA[2], voffB[2];
#pragma unroll
    for (int i = 0; i < 2; ++i) { int R, C; stage_rc(tid * 16 + i * 8192, R, C); const int Rb = Epi::PERM ? ((R & ~31) + perm32(R & 31)) : R;
        voffA[i] = (unsigned)(R * K + C) * 2u; voffB[i] = (unsigned)(Rb * K + C) * 2u; }
    const size_t kstep = (size_t)(BK * 2);
    const size_t hstep = (size_t)HALF * K * 2;
    const size_t tstep = 2 * hstep;
    const unsigned ldsw = (unsigned)wid * 1024u;
    const int aoff = lds_byte(wr * 64 + fr, fq * 8), boff = lds_byte(wc * 32 + fr, fq * 8);
#define PG8_SA(b, h) (((b) * 2 + (h)) * HTB)
#define PG8_SB(b, h) ((4 + (b) * 2 + (h)) * HTB)
#define PG8_STAGE(bufoff, gbase, voff) do { _Pragma("unroll") for (int _i = 0; _i < 2; ++_i) \
        __builtin_amdgcn_global_load_lds((const unsigned*)((const char*)(gbase) + (voff)[_i]), (PG8_LAS unsigned*)(lds + (bufoff) + ldsw + _i * 8192), 16, 0, 0); } while (0)
#define PG8_LDA(dst, b, h) do { _Pragma("unroll") for (int m = 0; m < 4; ++m) _Pragma("unroll") for (int k = 0; k < 2; ++k) dst[m][k] = *(const PG8_LAS bf16x8*)(lds + PG8_SA(b, h) + aoff + m * 2048 + k * 1024); } while (0)
#define PG8_LDB(dst, b, h) do { _Pragma("unroll") for (int n = 0; n < 2; ++n) _Pragma("unroll") for (int k = 0; k < 2; ++k) dst[n][k] = *(const PG8_LAS bf16x8*)(lds + PG8_SB(b, h) + boff + n * 2048 + k * 1024); } while (0)
#define PG8_MMA(ai, bj, At, Bt) do { __builtin_amdgcn_s_setprio(1); _Pragma("unroll") for (int m = 0; m < 4; ++m) _Pragma("unroll") for (int n = 0; n < 2; ++n) _Pragma("unroll") for (int k = 0; k < 2; ++k) \
        acc[ai][bj][m][n] = __builtin_amdgcn_mfma_f32_16x16x32_bf16(Bt[n][k], At[m][k], acc[ai][bj][m][n], 0, 0, 0); __builtin_amdgcn_s_setprio(0); } while (0)
#define PG8_WAIT_V(n) asm volatile("s_waitcnt vmcnt(" #n ")" ::: "memory")
#define PG8_WAIT_L(n) asm volatile("s_waitcnt lgkmcnt(" #n ")" ::: "memory")
#define PG8_BAR __builtin_amdgcn_s_barrier()
#define PG8_SCHED __builtin_amdgcn_sched_barrier(0)
    Unit cur, nxt; int ui = 0;
    if (!S.next(0, cur)) return;
    f32x4 acc[2][2][4][2];
#pragma unroll
    for (int a = 0; a < 2; ++a)
#pragma unroll
        for (int b = 0; b < 2; ++b)
#pragma unroll
            for (int m = 0; m < 4; ++m)
#pragma unroll
                for (int n = 0; n < 2; ++n) acc[a][b][m][n] = (f32x4){0.f, 0.f, 0.f, 0.f};
    bf16x8 At[4][2], B0[2][2], B1[2][2];
    const char* cA = (const char*)g.A + (size_t)cur.pm * tstep; const char* cB = (const char*)g.Bt + (size_t)cur.pn * (cur.hf ? hstep : tstep);
    S.a_ready(cur);
    if constexpr (SP2) {
        PG8_STAGE(PG8_SB(0, 0), cB, voffB); PG8_STAGE(PG8_SB(0, 1), cB + hstep, voffB); PG8_STAGE(PG8_SA(0, 0), cA, voffA); PG8_STAGE(PG8_SA(0, 1), cA + hstep, voffA);
        if (wr == 1) PG8_BAR;
        PG8_WAIT_V(2); PG8_BAR;
        PG8_STAGE(PG8_SB(1, 0), cB + kstep, voffB); PG8_STAGE(PG8_SA(1, 0), cA + kstep, voffA); PG8_STAGE(PG8_SB(1, 1), cB + hstep + kstep, voffB);
        PG8_WAIT_V(6); PG8_BAR;
    } else {
        PG8_STAGE(PG8_SB(0, 0), cB, voffB); PG8_STAGE(PG8_SA(0, 0), cA, voffA); PG8_STAGE(PG8_SB(0, 1), cB + hstep, voffB); PG8_STAGE(PG8_SA(0, 1), cA + hstep, voffA);
        if (wr == 1) PG8_BAR;
        PG8_WAIT_V(4); PG8_BAR;
        PG8_STAGE(PG8_SB(1, 0), cB + kstep, voffB); PG8_STAGE(PG8_SA(1, 0), cA + kstep, voffA); PG8_STAGE(PG8_SB(1, 1), cB + hstep + kstep, voffB);
        PG8_WAIT_V(6); PG8_BAR;
    }
    for (;;) {
        const bool has_next = S.next(ui + 1, nxt);
        const char* nA = has_next ? (const char*)g.A + (size_t)nxt.pm * tstep : cA; const char* nB = has_next ? (const char*)g.Bt + (size_t)nxt.pn * (nxt.hf ? hstep : tstep) : cB;
        const bool fullu = cur.hf == 0;
        if (fullu) {
        for (int t = 0; t < nt; t += 2) {
            const bool last = (t == nt - 2);
            const char* a1 = cA + (size_t)(t + 1) * kstep;
            const char* a2 = last ? nA : cA + (size_t)(t + 2) * kstep; const char* b2 = last ? nB : cB + (size_t)(t + 2) * kstep;
            const char* a3 = a2 + kstep; const char* b3 = b2 + kstep;
            if (last && has_next) S.a_ready(nxt);
            if constexpr (SP2) {
            PG8_LDB(B0, 0, 0); PG8_LDB(B1, 0, 1); PG8_SCHED; PG8_LDA(At, 0, 0); PG8_STAGE(PG8_SA(1, 1), a1 + hstep, voffA);
            PG8_WAIT_V(8); PG8_WAIT_L(0); PG8_BAR; PG8_MMA(0, 0, At, B0); PG8_MMA(0, 1, At, B1); PG8_BAR; PG8_SCHED;
            PG8_LDA(At, 0, 1); PG8_STAGE(PG8_SB(0, 0), b2, voffB); PG8_STAGE(PG8_SB(0, 1), b2 + hstep, voffB); PG8_STAGE(PG8_SA(0, 0), a2, voffA);
            PG8_WAIT_V(8); PG8_WAIT_L(0); PG8_BAR; PG8_MMA(1, 0, At, B0); PG8_MMA(1, 1, At, B1); PG8_BAR; PG8_SCHED;
            PG8_LDB(B0, 1, 0); PG8_LDB(B1, 1, 1); PG8_SCHED; PG8_LDA(At, 1, 0); PG8_STAGE(PG8_SA(0, 1), a2 + hstep, voffA);
            PG8_WAIT_V(8); PG8_WAIT_L(0); PG8_BAR; PG8_MMA(0, 0, At, B0); PG8_MMA(0, 1, At, B1); PG8_BAR; PG8_SCHED;
            PG8_LDA(At, 1, 1); PG8_STAGE(PG8_SB(1, 0), b3, voffB); PG8_STAGE(PG8_SB(1, 1), b3 + hstep, voffB); PG8_STAGE(PG8_SA(1, 0), a3, voffA);
            PG8_WAIT_V(8); PG8_WAIT_L(0); PG8_BAR; PG8_MMA(1, 0, At, B0); PG8_MMA(1, 1, At, B1); PG8_BAR; PG8_SCHED;
            } else {
            PG8_LDB(B0, 0, 0); PG8_SCHED; PG8_LDA(At, 0, 0); PG8_STAGE(PG8_SA(1, 1), a1 + hstep, voffA);
            PG8_WAIT_L(8); PG8_BAR; PG8_WAIT_L(0); PG8_MMA(0, 0, At, B0); PG8_BAR; PG8_SCHED;
            PG8_LDB(B1, 0, 1); PG8_STAGE(PG8_SB(0, 0), b2, voffB);
            PG8_BAR; PG8_WAIT_L(0); PG8_MMA(0, 1, At, B1); PG8_BAR;
            PG8_LDA(At, 0, 1); PG8_STAGE(PG8_SA(0, 0), a2, voffA);
            PG8_BAR; PG8_WAIT_L(0); PG8_MMA(1, 0, At, B0); PG8_BAR; PG8_SCHED;
            PG8_STAGE(PG8_SB(0, 1), b2 + hstep, voffB);
            PG8_WAIT_V(6); PG8_BAR; PG8_MMA(1, 1, At, B1); PG8_BAR;
            PG8_LDB(B0, 1, 0); PG8_SCHED; PG8_LDA(At, 1, 0); PG8_STAGE(PG8_SA(0, 1), a2 + hstep, voffA);
            PG8_WAIT_L(8); PG8_BAR; PG8_WAIT_L(0); PG8_MMA(0, 0, At, B0); PG8_BAR; PG8_SCHED;
            PG8_LDB(B1, 1, 1); PG8_STAGE(PG8_SB(1, 0), b3, voffB);
            PG8_BAR; PG8_WAIT_L(0); PG8_MMA(0, 1, At, B1); PG8_BAR;
            PG8_LDA(At, 1, 1); PG8_STAGE(PG8_SA(1, 0), a3, voffA);
            PG8_BAR; PG8_WAIT_L(0); PG8_MMA(1, 0, At, B0); PG8_BAR; PG8_SCHED;
            PG8_STAGE(PG8_SB(1, 1), b3 + hstep, voffB);
            PG8_WAIT_V(6); PG8_BAR; PG8_MMA(1, 1, At, B1); PG8_BAR;
            }
        }
        } else {
        for (int t = 0; t < nt; t += 2) {
            const bool last = (t == nt - 2);
            const char* a1 = cA + (size_t)(t + 1) * kstep;
            const char* a2 = last ? nA : cA + (size_t)(t + 2) * kstep; const char* b2 = last ? nB : cB + (size_t)(t + 2) * kstep;
            const char* a3 = a2 + kstep; const char* b3 = b2 + kstep;
            if (last && has_next) S.a_ready(nxt);
            if constexpr (SP2) {
            PG8_LDB(B0, 0, 0); PG8_LDB(B1, 0, 1); PG8_SCHED; PG8_LDA(At, 0, 0); PG8_STAGE(PG8_SA(1, 1), a1 + hstep, voffA);
            PG8_WAIT_V(8); PG8_WAIT_L(0); PG8_BAR; PG8_MMA(0, 0, At, B0);  PG8_BAR; PG8_SCHED;
            PG8_LDA(At, 0, 1); PG8_STAGE(PG8_SB(0, 0), b2, voffB); PG8_STAGE(PG8_SB(0, 1), b2 + hstep, voffB); PG8_STAGE(PG8_SA(0, 0), a2, voffA);
            PG8_WAIT_V(8); PG8_WAIT_L(0); PG8_BAR; PG8_MMA(1, 0, At, B0);  PG8_BAR; PG8_SCHED;
            PG8_LDB(B0, 1, 0); PG8_LDB(B1, 1, 1); PG8_SCHED; PG8_LDA(At, 1, 0); PG8_STAGE(PG8_SA(0, 1), a2 + hstep, voffA);
            PG8_WAIT_V(8); PG8_WAIT_L(0); PG8_BAR; PG8_MMA(0, 0, At, B0);  PG8_BAR; PG8_SCHED;
            PG8_LDA(At, 1, 1); PG8_STAGE(PG8_SB(1, 0), b3, voffB); PG8_STAGE(PG8_SB(1, 1), b3 + hstep, voffB); PG8_STAGE(PG8_SA(1, 0), a3, voffA);
            PG8_WAIT_V(8); PG8_WAIT_L(0); PG8_BAR; PG8_MMA(1, 0, At, B0);  PG8_BAR; PG8_SCHED;
            } else {
            PG8_LDB(B0, 0, 0); PG8_SCHED; PG8_LDA(At, 0, 0); PG8_STAGE(PG8_SA(1, 1), a1 + hstep, voffA);
            PG8_WAIT_L(8); PG8_BAR; PG8_WAIT_L(0); PG8_MMA(0, 0, At, B0); PG8_BAR; PG8_SCHED;
            PG8_LDB(B1, 0, 1); PG8_STAGE(PG8_SB(0, 0), b2, voffB);
            PG8_BAR; PG8_WAIT_L(0); PG8_MMA(0, 1, At, B1); PG8_BAR;
            PG8_LDA(At, 0, 1); PG8_STAGE(PG8_SA(0, 0), a2, voffA);
            PG8_BAR; PG8_WAIT_L(0); PG8_MMA(1, 0, At, B0); PG8_BAR; PG8_SCHED;
            PG8_STAGE(PG8_SB(0, 1), b2 + hstep, voffB);
            PG8_WAIT_V(6); PG8_BAR; PG8_MMA(1, 1, At, B1); PG8_BAR;
            PG8_LDB(B0, 1, 0); PG8_SCHED; PG8_LDA(At, 1, 0); PG8_STAGE(PG8_SA(0, 1), a2 + hstep, voffA);
            PG8_WAIT_L(8); PG8_BAR; PG8_WAIT_L(0); PG8_MMA(0, 0, At, B0); PG8_BAR; PG8_SCHED;
            PG8_LDB(B1, 1, 1); PG8_STAGE(PG8_SB(1, 0), b3, voffB);
            PG8_BAR; PG8_WAIT_L(0); PG8_MMA(0, 1, At, B1); PG8_BAR;
            PG8_LDA(At, 1, 1); PG8_STAGE(PG8_SA(1, 0), a3, voffA);
            PG8_BAR; PG8_WAIT_L(0); PG8_MMA(1, 0, At, B0); PG8_BAR; PG8_SCHED;
            PG8_STAGE(PG8_SB(1, 1), b3 + hstep, voffB);
            PG8_WAIT_V(6); PG8_BAR; PG8_MMA(1, 1, At, B1); PG8_BAR;
            }
        }
        }
        if constexpr (ALIGN_EPI) { if (wr == 0) PG8_BAR; }
        if constexpr (!Epi::AFTER_DRAIN) { E(acc, cur, wr, wc, fr, fq); S.done(cur); }
        if (!has_next) break;
#pragma unroll
        for (int a = 0; a < 2; ++a)
#pragma unroll
            for (int b = 0; b < 2; ++b)
#pragma unroll
                for (int m = 0; m < 4; ++m)
#pragma unroll
                    for (int n = 0; n < 2; ++n) acc[a][b][m][n] = (f32x4){0.f, 0.f, 0.f, 0.f};
        cur = nxt; cA = nA; cB = nB; ++ui;
        if constexpr (ALIGN_EPI) { if (wr == 1) PG8_BAR; }
    }
    PG8_WAIT_V(0);
    if constexpr (!ALIGN_EPI) { if (wr == 0) PG8_BAR; }
    PG8_BAR;
    if constexpr (Epi::AFTER_DRAIN) { E.fused(acc, cur, wr, wc, fr, fq, lds, wid, lane); S.done(cur); }
#undef PG8_SA
#undef PG8_SB
#undef PG8_STAGE
#undef PG8_LDA
#undef PG8_LDB
#undef PG8_MMA
#undef PG8_WAIT_V
#undef PG8_WAIT_L
#undef PG8_BAR
#undef PG8_SCHED
}
}
namespace attn {
using bf16 = __hip_bfloat16;
constexpr int   D = 128, NW = 8, QBLK = 32, KVBLK = 64;
constexpr float SCALE = 0.088388347648318440f;
constexpr float THR = 8.f;
constexpr int SDEPTH = 2;
constexpr int LDQ = 1024, LDK = 128, LDO = 1024;
constexpr size_t SHM_V = KVBLK * D * 2, SHM_K = KVBLK * D * 2, SHM_ATTN = 2 * SHM_V + 2 * SHM_K + NW * 64 * 4;
using bf16x8 = __attribute__((ext_vector_type(8))) short;
using s16x4  = __attribute__((ext_vector_type(4))) short;
using f32x16 = __attribute__((ext_vector_type(16))) float;
using f32x8  = __attribute__((ext_vector_type(8))) float;
using u32x4  = __attribute__((ext_vector_type(4))) unsigned;
#define KSWZ(row, colB) ((row) * 256 + ((colB) ^ (((row) & 7) << 4)))
#define SBAR() __builtin_amdgcn_sched_barrier(0)
__device__ __forceinline__ int crow(int r, int hi) { return (r & 3) + 8 * (r >> 2) + 4 * hi; }
__device__ __forceinline__ unsigned cvtpk(float lo, float hi) {
  unsigned r; asm volatile("v_cvt_pk_bf16_f32 %0, %1, %2" : "=v"(r) : "v"(lo), "v"(hi)); return r;
}
template <typename TIn> struct Stage;
template <> struct Stage<bf16>  { using T = bf16x8;
  __device__ static __forceinline__ T ld8(const bf16* p) { return *reinterpret_cast<const bf16x8*>(p); }
  __device__ static __forceinline__ bf16x8 tobf(T x) { return x; } };
template <> struct Stage<float> { using T = f32x8;
  __device__ static __forceinline__ T ld8(const float* p) { return *reinterpret_cast<const f32x8*>(p); }
  __device__ static __forceinline__ bf16x8 tobf(T x) {
    u32x4 w = {cvtpk(x[0], x[1]), cvtpk(x[2], x[3]), cvtpk(x[4], x[5]), cvtpk(x[6], x[7])}; return *reinterpret_cast<bf16x8*>(&w); } };

__device__ __forceinline__ void partialSM(f32x16& p0, f32x16& p1, float& m_reg, float& mn, float& alpha) {
  constexpr float C = SCALE * 1.4426950408889634f;
  float pmax = p0[0]; for (int r = 1; r < 16; ++r) pmax = fmaxf(pmax, p0[r]); for (int r = 0; r < 16; ++r) pmax = fmaxf(pmax, p1[r]);
  { auto rr = __builtin_amdgcn_permlane32_swap(__float_as_uint(pmax), __float_as_uint(pmax), false, false);
    pmax = fmaxf(__uint_as_float(rr[0]), __uint_as_float(rr[1])); }
  if (__builtin_expect(__all(pmax - m_reg <= THR / SCALE), 1)) { mn = m_reg; alpha = 1.f; }
  else { mn = fmaxf(m_reg, pmax); alpha = __builtin_amdgcn_exp2f((m_reg - mn) * C); m_reg = mn; }
  float mnC = -mn * C;
  for (int r = 0; r < 16; ++r) p0[r] = fmaf(p0[r], C, mnC); for (int r = 0; r < 16; ++r) p1[r] = fmaf(p1[r], C, mnC);
  for (int r = 0; r < 16; ++r) p0[r] = __builtin_amdgcn_exp2f(p0[r]);
}
__device__ __forceinline__ void finishSM(f32x16& p0, f32x16& p1, float alpha, float& l_reg, bf16x8& pa0, bf16x8& pa1, bf16x8& pa2, bf16x8& pa3) {
  for (int r = 0; r < 16; ++r) p1[r] = __builtin_amdgcn_exp2f(p1[r]);
  float ps = 0; for (int r = 0; r < 16; ++r) ps += p0[r]; for (int r = 0; r < 16; ++r) ps += p1[r];
  { auto rr = __builtin_amdgcn_permlane32_swap(__float_as_uint(ps), __float_as_uint(ps), false, false);
    ps = __uint_as_float(rr[0]) + __uint_as_float(rr[1]); }
  l_reg = l_reg * alpha + ps;
#define PK4(P, BASE, OUT) do { unsigned a0 = cvtpk(P[BASE + 0], P[BASE + 1]), a1 = cvtpk(P[BASE + 2], P[BASE + 3]);   \
    unsigned b0 = cvtpk(P[BASE + 4], P[BASE + 5]), b1 = cvtpk(P[BASE + 6], P[BASE + 7]);                              \
    auto r0 = __builtin_amdgcn_permlane32_swap(a0, b0, false, false); auto r1 = __builtin_amdgcn_permlane32_swap(a1, b1, false, false); \
    u32x4 w = {r0[0], r1[0], r0[1], r1[1]}; OUT = *reinterpret_cast<bf16x8*>(&w); } while (0)
  PK4(p0, 0, pa0); PK4(p0, 8, pa1); PK4(p1, 0, pa2); PK4(p1, 8, pa3);
#undef PK4
}
__device__ __forceinline__ void qkt(f32x16& p0, f32x16& p1, const bf16* Ks, const bf16x8* qr, int r32, int hi) {
  p0 = f32x16{}; p1 = f32x16{};
  for (int d0 = 0; d0 < 8; ++d0) { int cb = (d0 * 16 + hi * 8) * 2;
    bf16x8 b0 = *reinterpret_cast<const bf16x8*>((const char*)Ks + KSWZ(r32, cb));
    bf16x8 b1 = *reinterpret_cast<const bf16x8*>((const char*)Ks + KSWZ(32 + r32, cb));
    p0 = __builtin_amdgcn_mfma_f32_32x32x16_bf16(b0, qr[d0], p0, 0, 0, 0);
    p1 = __builtin_amdgcn_mfma_f32_32x32x16_bf16(b1, qr[d0], p1, 0, 0, 0); }
}
__device__ __forceinline__ int v_st(int k, int c) { const int kk = (k & ~0xC) | ((k & 4) << 1) | ((k & 8) >> 1); return ((kk >> 3) * 4 + (c >> 5)) * 512 + ((kk & 7) * 32 + (c & 31)) * 2; }
__device__ __forceinline__ int v_rd_base(int lane) { return ((lane & 3) << 3) | (((lane >> 2) & 3) << 6) | (((lane >> 4) & 1) << 5) | (((lane >> 5) & 1) << 8); }
constexpr int v_rd_off(int d0, int ks, int half) { return d0 * 512 + ks * 4096 + half * 2048; }
template <int OFF> __device__ __forceinline__ s16x4 tr_read(int vb) {
  s16x4 r; asm volatile("ds_read_b64_tr_b16 %0, %1 offset:%2" : "=&v"(r) : "v"(vb), "i"(OFF) : "memory"); return r;
}
template <int D0> __device__ __forceinline__ void pv_one(f32x16& od, int vb, bf16x8 pa0, bf16x8 pa1, bf16x8 pa2, bf16x8 pa3) {
  const s16x4 l0 = tr_read<v_rd_off(D0, 0, 0)>(vb), h0 = tr_read<v_rd_off(D0, 0, 1)>(vb), l1 = tr_read<v_rd_off(D0, 1, 0)>(vb), h1 = tr_read<v_rd_off(D0, 1, 1)>(vb);
  const s16x4 l2 = tr_read<v_rd_off(D0, 2, 0)>(vb), h2 = tr_read<v_rd_off(D0, 2, 1)>(vb), l3 = tr_read<v_rd_off(D0, 3, 0)>(vb), h3 = tr_read<v_rd_off(D0, 3, 1)>(vb);
  asm volatile("s_waitcnt lgkmcnt(0)" ::: "memory"); SBAR();
#define PK(L, H) (bf16x8){L[0], L[1], L[2], L[3], H[0], H[1], H[2], H[3]}
  od = __builtin_amdgcn_mfma_f32_32x32x16_bf16(pa0, PK(l0, h0), od, 0, 0, 0);
  od = __builtin_amdgcn_mfma_f32_32x32x16_bf16(pa1, PK(l1, h1), od, 0, 0, 0);
  od = __builtin_amdgcn_mfma_f32_32x32x16_bf16(pa2, PK(l2, h2), od, 0, 0, 0);
  od = __builtin_amdgcn_mfma_f32_32x32x16_bf16(pa3, PK(l3, h3), od, 0, 0, 0);
#undef PK
}
__device__ __forceinline__ void pv_d0(f32x16* o, int vb, bf16x8 pa0, bf16x8 pa1, bf16x8 pa2, bf16x8 pa3) {
  pv_one<0>(o[0], vb, pa0, pa1, pa2, pa3); pv_one<1>(o[1], vb, pa0, pa1, pa2, pa3); pv_one<2>(o[2], vb, pa0, pa1, pa2, pa3); pv_one<3>(o[3], vb, pa0, pa1, pa2, pa3);
}

template <typename TQ>
__device__ __forceinline__ void attn_dense_body(const TQ* __restrict__ Qb, const bf16* __restrict__ Kh, const bf16* __restrict__ Vh,
                                                bf16* __restrict__ Ob, int seq, char* lds) {
  using St = Stage<bf16>; using SQ = Stage<TQ>;
  const int tid = threadIdx.x, wid = tid >> 6, lane = tid & 63, r32 = lane & 31, hi = lane >> 5;
  bf16* V_lds = (bf16*)lds; bf16* K_lds = (bf16*)(lds + 2 * SHM_V);
  float* ws = (float*)(lds + 2 * SHM_V + 2 * SHM_K) + wid * 64; float* li_l = ws; float* al_l = ws + 32;
  float m_reg = -1e30f, l_reg = 0; f32x16 o[4] = {}; bf16x8 qr[8];
  const TQ* Qw = Qb + (long)(wid * QBLK + r32) * LDQ + hi * 8;
#pragma unroll
  for (int d0 = 0; d0 < 8; ++d0) qr[d0] = SQ::tobf(SQ::ld8(Qw + d0 * 16));
  const int sr = tid >> 4, sc = (tid & 15) * 8, vst0 = v_st(sr, sc), vst1 = v_st(32 + sr, sc);
  const int vb0 = (int)(uintptr_t)V_lds + v_rd_base(lane);
  struct { typename St::T vs0, vs1, ks0, ks1; } sr_[SDEPTH];
#define SLOAD(i, k0) do { sr_[i].vs0 = St::ld8(&Vh[(long)((k0) + sr) * LDK + sc]); sr_[i].vs1 = St::ld8(&Vh[(long)((k0) + 32 + sr) * LDK + sc]); \
    sr_[i].ks0 = St::ld8(&Kh[(long)((k0) + sr) * LDK + sc]); sr_[i].ks1 = St::ld8(&Kh[(long)((k0) + 32 + sr) * LDK + sc]); } while (0)
#define SWRITE(b, i) do { *(bf16x8*)((char*)V_lds + (b) * SHM_V + vst0) = St::tobf(sr_[i].vs0);          \
    *(bf16x8*)((char*)V_lds + (b) * SHM_V + vst1) = St::tobf(sr_[i].vs1); int kc = sc * 2;               \
    *(bf16x8*)((char*)K_lds + (b) * SHM_K + KSWZ(sr, kc)) = St::tobf(sr_[i].ks0);                       \
    *(bf16x8*)((char*)K_lds + (b) * SHM_K + KSWZ(32 + sr, kc)) = St::tobf(sr_[i].ks1); } while (0)
#define SWAIT() do { if constexpr (SDEPTH == 2) asm volatile("s_waitcnt vmcnt(4)" ::: "memory"); else asm volatile("s_waitcnt vmcnt(0)" ::: "memory"); } while (0)
#define RESC(a) do { if (__any((a) < 1.f)) { if (hi == 0) al_l[r32] = (a); asm volatile("s_waitcnt lgkmcnt(0)" ::: "memory"); \
    for (int d = 0; d < 4; ++d) for (int r = 0; r < 16; ++r) o[d][r] *= al_l[crow(r, hi)]; } } while (0)
  f32x16 pA0, pA1, pB0, pB1; float mnA, mnB, alA, alB; bf16x8 pa0, pa1, pa2, pa3; const int NT = seq / KVBLK;
  constexpr int SE = 0, SO = SDEPTH - 1;
  SLOAD(SE, 0); asm volatile("s_waitcnt vmcnt(0)" ::: "memory"); SWRITE(0, SE); __syncthreads();
  qkt(pA0, pA1, K_lds, qr, r32, hi); partialSM(pA0, pA1, m_reg, mnA, alA);
  SLOAD(SO, KVBLK); if constexpr (SDEPTH == 2) { if (2 < NT) SLOAD(SE, 2 * KVBLK); }
  SWAIT(); SWRITE(1, SO); __syncthreads();
  for (int j = 1; j + 1 < NT; j += 2) {
    SBAR(); qkt(pB0, pB1, (bf16*)((char*)K_lds + SHM_K), qr, r32, hi);
    finishSM(pA0, pA1, alA, l_reg, pa0, pa1, pa2, pa3); SBAR();
    SLOAD(SO, (j + SDEPTH) * KVBLK); SBAR();
    pv_d0(o, vb0, pa0, pa1, pa2, pa3); partialSM(pB0, pB1, m_reg, mnB, alB);
    __syncthreads(); SWAIT(); SWRITE(0, SE);
    RESC(alB); __syncthreads();
    SBAR(); qkt(pA0, pA1, K_lds, qr, r32, hi);
    finishSM(pB0, pB1, alB, l_reg, pa0, pa1, pa2, pa3); SBAR();
    if (SDEPTH == 1 || j + 3 < NT) SLOAD(SE, (j + 1 + SDEPTH) * KVBLK); SBAR();
    pv_d0(o, vb0 + (int)SHM_V, pa0, pa1, pa2, pa3); partialSM(pA0, pA1, m_reg, mnA, alA);
    __syncthreads(); SWAIT(); SWRITE(1, SO);
    RESC(alA); __syncthreads();
  }
  SBAR(); qkt(pB0, pB1, (bf16*)((char*)K_lds + SHM_K), qr, r32, hi);
  finishSM(pA0, pA1, alA, l_reg, pa0, pa1, pa2, pa3); SBAR();
  pv_d0(o, vb0, pa0, pa1, pa2, pa3); partialSM(pB0, pB1, m_reg, mnB, alB);
  __syncthreads(); RESC(alB);
  finishSM(pB0, pB1, alB, l_reg, pa0, pa1, pa2, pa3); SBAR();
  pv_d0(o, vb0 + (int)SHM_V, pa0, pa1, pa2, pa3);
  if (hi == 0) li_l[r32] = l_reg; asm volatile("s_waitcnt lgkmcnt(0)" ::: "memory");
  float rli[16];
#pragma unroll
  for (int r = 0; r < 16; ++r) rli[r] = __builtin_amdgcn_rcpf(li_l[crow(r, hi)]);
  bf16* Ow = Ob + (long)(wid * QBLK) * LDO;
#pragma unroll
  for (int r = 0; r < 16; ++r) { int orow = crow(r, hi);
    for (int d0 = 0; d0 < 4; ++d0) Ow[(long)orow * LDO + d0 * 32 + r32] = __float2bfloat16(o[d0][r] * rli[r]); }
#undef SLOAD
#undef SWRITE
#undef SWAIT
#undef RESC
}
}
#define LAS __attribute__((address_space(3)))
typedef __hip_bfloat16 bf16;
typedef float f32x4v __attribute__((ext_vector_type(4)));
typedef unsigned u32x4v __attribute__((ext_vector_type(4)));
typedef unsigned u32x2v __attribute__((ext_vector_type(2)));
constexpr int DM = 1024, NCTX = 4096, NLAT = 16384, MTOK = NCTX + NLAT, DFF = 2816, NQKV = 1536, EVIN = 2048, LCTX = 256, LLAT = 4096, PAST = 512, SKV = PAST + LLAT;
constexpr float EPS = 1e-6f;
constexpr size_t MiB = 1u << 20;
constexpr size_t WS_MODS = 0;
constexpr size_t WS_GP = 256 * 1024, WS_SWF1 = 384 * 1024, WS_SWQKV = 640 * 1024, WS_SS = 672 * 1024;
constexpr size_t WS_WIN = 1 * MiB, WS_WOUT = 5 * MiB, WS_WQKV = 7 * MiB, WS_WO = 10 * MiB, WS_WF1 = 12 * MiB, WF1_STRIDE = 11 * MiB, WS_WF2 = 34 * MiB, WF2_STRIDE = (size_t)DM * DFF * 2;
constexpr size_t WS_H = 46 * MiB;
constexpr size_t WS_B = 86 * MiB;
constexpr size_t WS_P = WS_B, WS_MX = WS_B + 80 * MiB;
constexpr size_t WS_ACT = WS_B;
constexpr size_t WS_O = WS_B;
constexpr size_t WS_QKV = WS_B, WS_Q = WS_B + 60 * MiB, WS_KLAT = WS_B + 100 * MiB, WS_VLAT = WS_B + 109 * MiB, WS_KCTX = WS_B + 118 * MiB, WS_VCTX = WS_B + 120 * MiB;
constexpr size_t WS_XB = 208 * MiB, WS_END = 248 * MiB;
constexpr size_t WS_BAR = 992 * 1024, WS_ZERO_BEGIN = WS_SS, WS_ZERO_BYTES = 1 * MiB - WS_SS;
constexpr int LDS_BYTES = 135168;
constexpr int NPHASE = 14;

struct Params { const float* in[22]; float* out; unsigned char* ws; int ph_lo, ph_hi; };

__device__ __forceinline__ float wave_sum(float v) {
#pragma unroll
    for (int o = 1; o < 64; o <<= 1) v += __shfl_xor(v, o);
    return v;
}
__device__ __forceinline__ unsigned f2bf(float f) { unsigned u = __builtin_bit_cast(unsigned, f); return (u + 0x7fffu + ((u >> 16) & 1u)) >> 16; }
__device__ __forceinline__ unsigned pk2(float lo, float hi) { return f2bf(lo) | (f2bf(hi) << 16); }
__device__ __forceinline__ float bf_lo(unsigned w) { return __builtin_bit_cast(float, w << 16); }
__device__ __forceinline__ float bf_hi(unsigned w) { return __builtin_bit_cast(float, w & 0xffff0000u); }
__device__ __forceinline__ float bf1(unsigned short h) { return __builtin_bit_cast(float, (unsigned)h << 16); }

__device__ __forceinline__ void ld8f(const unsigned short* ptr, float* f) { const u32x4v w = *(const u32x4v*)ptr; f[0] = bf_lo(w.x); f[1] = bf_hi(w.x); f[2] = bf_lo(w.y); f[3] = bf_hi(w.y); f[4] = bf_lo(w.z); f[5] = bf_hi(w.z); f[6] = bf_lo(w.w); f[7] = bf_hi(w.w); }
__device__ __forceinline__ void ld8f_nt(const unsigned short* ptr, float* f) { const u32x4v w = __builtin_nontemporal_load((const u32x4v*)ptr); f[0] = bf_lo(w.x); f[1] = bf_hi(w.x); f[2] = bf_lo(w.y); f[3] = bf_hi(w.y); f[4] = bf_lo(w.z); f[5] = bf_hi(w.z); f[6] = bf_lo(w.w); f[7] = bf_hi(w.w); }
__device__ __forceinline__ void transpose_item(const float* W, int N, int k0, int n0, unsigned short* WT, int ldk, int dst_row0, int dst_k0, LAS float* scr, int lane) {
    float tv[32];
#pragma unroll
    for (int i = 0; i < 32; ++i) tv[i] = __builtin_nontemporal_load(&W[(size_t)(k0 + 2 * i + (lane >> 5)) * N + n0 + (lane & 31)]);
#pragma unroll
    for (int i = 0; i < 32; ++i) scr[(2 * i + (lane >> 5)) * 33 + (lane & 31)] = tv[i];
    asm volatile("s_waitcnt lgkmcnt(0)" ::: "memory");
    const int c = lane & 7;
#pragma unroll
    for (int j = 0; j < 4; ++j) { const int n = (lane >> 3) + 8 * j; const LAS float* s = scr + (8 * c) * 33 + n;
        u32x4v o; o.x = pk2(s[0 * 33], s[1 * 33]); o.y = pk2(s[2 * 33], s[3 * 33]); o.z = pk2(s[4 * 33], s[5 * 33]); o.w = pk2(s[6 * 33], s[7 * 33]);
        *(u32x4v*)(WT + (size_t)(dst_row0 + n) * ldk + dst_k0 + k0 + 8 * c) = o; }
    asm volatile("s_waitcnt lgkmcnt(0)" ::: "memory");
}

__device__ __forceinline__ void phase_prep(const Params& p, LAS unsigned char* lds, int tid, int lane, int wave) {
    unsigned char* ws = p.ws;
    {
        LAS float* sc = (LAS float*)lds;
        LAS float* red = (LAS float*)(lds + 20480);
        const float* cl = p.in[4]; const float* cctx = p.in[5]; const float* w_ada = p.in[6]; const float* b_ada = p.in[7];
        float* mods = (float*)(ws + WS_MODS);
        if ((int)blockIdx.x < 192) {
            for (int idx = tid; idx < 5 * 1024; idx += 512) { const int j = idx >> 10, k = idx & 1023; const float v = j == 0 ? cctx[k] : cl[(j - 1) * 1024 + k]; sc[idx] = v / (1.0f + __expf(-v)); }
            __syncthreads();
            for (int item = blockIdx.x; item < 192; item += gridDim.x) {
                const int l = item / 96, n0 = (item % 96) * 64;
                float a0 = 0.f, a1 = 0.f, a2 = 0.f, a3 = 0.f, a4 = 0.f;
                const float* wp = w_ada + ((size_t)l * 1024 + wave * 128) * 6144 + n0 + lane;
#pragma unroll 16
                for (int k = 0; k < 128; ++k) { const float wv = __builtin_nontemporal_load(&wp[(size_t)k * 6144]); const int kk = wave * 128 + k;
                    a0 += sc[kk] * wv; a1 += sc[1024 + kk] * wv; a2 += sc[2048 + kk] * wv; a3 += sc[3072 + kk] * wv; a4 += sc[4096 + kk] * wv; }
                red[(wave * 5 + 0) * 64 + lane] = a0; red[(wave * 5 + 1) * 64 + lane] = a1; red[(wave * 5 + 2) * 64 + lane] = a2; red[(wave * 5 + 3) * 64 + lane] = a3; red[(wave * 5 + 4) * 64 + lane] = a4;
                __syncthreads();
                if (tid < 320) { const int j = tid >> 6, ln = tid & 63; float s = b_ada[l * 6144 + n0 + ln];
#pragma unroll
                    for (int w = 0; w < 8; ++w) s += red[(w * 5 + j) * 64 + ln];
                    mods[(size_t)(l * 5 + j) * 6144 + n0 + ln] = s; }
                __syncthreads();
            }
        }
    }
    {
        LAS float* scr = (LAS float*)(lds + 32768 + wave * 8704);
        const int gw = blockIdx.x * 8 + wave, NGW = gridDim.x * 8;
        constexpr int I_IN = 16 * 64, I_QKV = 16 * 48, I_O = 16 * 32, I_OUT = 8 * 32, I_F1 = 16 * 176, I_F2 = 44 * 32, I_FOLD = 1024;
        constexpr int NITEMS = I_IN + I_QKV + I_O + I_OUT + 2 * I_F1 + 2 * I_F2 + I_FOLD;
        for (int it = gw; it < NITEMS; it += NGW) {
            int r = it;
            if (r < I_IN) { const int kb = r / 64, nb = r % 64; transpose_item(p.in[9], EVIN, kb * 64, nb * 32, (unsigned short*)(ws + WS_WIN), 1024, nb * 32, 0, scr, lane); continue; } r -= I_IN;
            if (r < I_QKV) { const int kb = r / 48, nb = r % 48; transpose_item(p.in[15], NQKV, kb * 64, nb * 32, (unsigned short*)(ws + WS_WQKV), 1024, nb * 32, 0, scr, lane); continue; } r -= I_QKV;
            if (r < I_O) { const int kb = r / 32, nb = r % 32; transpose_item(p.in[18], DM, kb * 64, nb * 32, (unsigned short*)(ws + WS_WO), 1024, nb * 32, 0, scr, lane); continue; } r -= I_O;
            if (r < I_OUT) { const int kb = r / 32, nb = r % 32; transpose_item(p.in[14] + (size_t)512 * 1024, DM, kb * 64, nb * 32, (unsigned short*)(ws + WS_WOUT), 1024, nb * 32, 512, scr, lane); continue; } r -= I_OUT;
            if (r < 2 * I_F1) { const int l = r / I_F1, q = r % I_F1, kb = q / 176, nb = q % 176, n0 = nb * 32;
                const int part = n0 >= DFF, jj = n0 - part * DFF, drow = (jj >> 7) * 256 + part * 128 + (jj & 127);
                transpose_item(p.in[19] + (size_t)l * DM * 2 * DFF, 2 * DFF, kb * 64, n0, (unsigned short*)(ws + WS_WF1 + l * WF1_STRIDE), 1024, drow, 0, scr, lane); continue; } r -= 2 * I_F1;
            if (r < 2 * I_F2) { const int l = r / I_F2, q = r % I_F2, kb = q / 32, nb = q % 32;
                transpose_item(p.in[20] + (size_t)l * DFF * DM, DM, kb * 64, nb * 32, (unsigned short*)(ws + WS_WF2 + l * WF2_STRIDE), DFF, nb * 32, 0, scr, lane); continue; } r -= 2 * I_F2;
            {
                const int g = r >> 8, cc = (r >> 4) & 15, nb = r & 15, n = nb * 64 + lane;
                const float* pw = p.in[10] + ((size_t)g * 128 + cc * 8) * 128; const float* psc = p.in[11] + g * 128; const float* wo = p.in[14] + (size_t)(g * 128) * 1024 + n;
                float a[8] = {0.f, 0.f, 0.f, 0.f, 0.f, 0.f, 0.f, 0.f};
                for (int d = 0; d < 128; ++d) { const float wv = psc[d] * wo[(size_t)d * 1024];
#pragma unroll
                    for (int c = 0; c < 8; ++c) a[c] += pw[c * 128 + d] * wv; }
                u32x4v o; o.x = pk2(a[0], a[1]); o.y = pk2(a[2], a[3]); o.z = pk2(a[4], a[5]); o.w = pk2(a[6], a[7]);
                *(u32x4v*)((unsigned short*)(ws + WS_WOUT) + (size_t)n * 1024 + g * 128 + cc * 8) = o;
            }
        }
    }
}

__device__ __forceinline__ void phase_p1(const Params& p, int tid, int lane, int wave) {
    unsigned char* ws = p.ws;
    const float* mods = (const float*)(ws + WS_MODS); const float* norm_g = p.in[8];
    const int gw = blockIdx.x * 8 + wave, NGW = gridDim.x * 8;
    {   float* gp = (float*)(ws + WS_GP);
        for (int idx = blockIdx.x * 512 + tid; idx < 3 * 5 * 1024; idx += gridDim.x * 512) { const int site = idx / 5120, j = (idx >> 10) % 5, c = idx & 1023, l = site >= 1, nrm = site != 1;
            gp[idx] = norm_g[(l * 2 + nrm) * 1024 + c] * (1.0f + mods[(size_t)(l * 5 + j) * 6144 + (nrm ? 4 : 1) * 1024 + c]); } }
#pragma unroll 1
    for (int site = 0; site < 3; ++site) {
        const int N = site == 1 ? NQKV : 2 * DFF, l = site >= 1, chunk = site == 1 ? 0 : 3;
        const unsigned short* Wt = (const unsigned short*)(ws + (site == 0 ? WS_WF1 : site == 1 ? WS_WQKV : WS_WF1 + WF1_STRIDE));
        float* dst = site == 1 ? (float*)(ws + WS_SWQKV) : (float*)(ws + WS_SWF1) + (site == 2) * 5 * 2 * DFF;
        if (gw < N) {
            float sh[5][16];
#pragma unroll
            for (int j = 0; j < 5; ++j) { const float* sp = mods + (size_t)(l * 5 + j) * 6144 + chunk * 1024 + 8 * lane;
#pragma unroll
                for (int q = 0; q < 4; ++q) { const f32x4v v = *(const f32x4v*)(sp + (q >> 1) * 512 + (q & 1) * 4); sh[j][4 * q] = v.x; sh[j][4 * q + 1] = v.y; sh[j][4 * q + 2] = v.z; sh[j][4 * q + 3] = v.w; } }
            for (int col = gw; col < N; col += NGW) {
                float f[16]; ld8f(Wt + (size_t)col * 1024 + 8 * lane, f); ld8f(Wt + (size_t)col * 1024 + 512 + 8 * lane, f + 8);
                float a[5];
#pragma unroll
                for (int j = 0; j < 5; ++j) { float s = 0.f;
#pragma unroll
                    for (int q = 0; q < 16; ++q) s += sh[j][q] * f[q];
                    a[j] = wave_sum(s); }
                if (lane == 0) {
#pragma unroll
                    for (int j = 0; j < 5; ++j) dst[(size_t)j * N + col] = a[j]; }
            }
        }
    }
    const float* xc = p.in[0]; const float* xl = p.in[1]; unsigned short* h = (unsigned short*)(ws + WS_H);
    for (int it = gw; it < MTOK / 4; it += NGW) {
        f32x4v v[4][4]; float ss[4];
#pragma unroll
        for (int rr = 0; rr < 4; ++rr) { const int row = it + rr * (MTOK / 4); const float* xr = row < NCTX ? xc + (size_t)row * DM : xl + (size_t)(row - NCTX) * DM;
#pragma unroll
            for (int q = 0; q < 4; ++q) v[rr][q] = *(const f32x4v*)(xr + 4 * lane + 256 * q); }
#pragma unroll
        for (int rr = 0; rr < 4; ++rr) { float s = 0.f;
#pragma unroll
            for (int q = 0; q < 4; ++q) s += (v[rr][q].x * v[rr][q].x + v[rr][q].y * v[rr][q].y) + (v[rr][q].z * v[rr][q].z + v[rr][q].w * v[rr][q].w);
            ss[rr] = s; }
#pragma unroll
        for (int rr = 0; rr < 4; ++rr) { const int row = it + rr * (MTOK / 4); const int j = row < NCTX ? 0 : 1 + ((row - NCTX) >> 12);
            const float rstd = __builtin_amdgcn_rsqf(wave_sum(ss[rr]) * (1.0f / DM) + EPS);
            const float* shp = mods + (size_t)j * 6144; const float* scp = shp + 1024;
#pragma unroll
            for (int q = 0; q < 4; ++q) { const int c = 4 * lane + 256 * q;
                const f32x4v gg = *(const f32x4v*)(norm_g + c), sc = *(const f32x4v*)(scp + c), shv = *(const f32x4v*)(shp + c);
                const f32x4v o = (v[rr][q] * rstd) * gg * (sc + 1.0f) + shv;
                u32x2v w; w.x = pk2(o.x, o.y); w.y = pk2(o.z, o.w);
                *(u32x2v*)(h + (size_t)row * DM + c) = w; } }
    }
}
__device__ __forceinline__ void phase_final(const unsigned short* xb, float* y, const float* g, const float* ss, int lane, int wave) {
    const int gw = blockIdx.x * 8 + wave, NGW = gridDim.x * 8;
    f32x4v gg[4];
#pragma unroll
    for (int q = 0; q < 4; ++q) gg[q] = *(const f32x4v*)(g + 4 * lane + 256 * q);
    for (int it = gw; it < MTOK / 4; it += NGW) {
        u32x2v v[4][4]; float rs[4];
#pragma unroll
        for (int rr = 0; rr < 4; ++rr) { const int row = it + rr * (MTOK / 4); rs[rr] = __builtin_amdgcn_rsqf(ss[row] * (1.0f / DM) + EPS);
#pragma unroll
            for (int q = 0; q < 4; ++q) v[rr][q] = __builtin_nontemporal_load((const u32x2v*)(xb + (size_t)row * DM + 4 * lane + 256 * q)); }
#pragma unroll
        for (int rr = 0; rr < 4; ++rr) { const int row = it + rr * (MTOK / 4);
#pragma unroll
            for (int q = 0; q < 4; ++q) { const f32x4v x = {bf_lo(v[rr][q].x), bf_hi(v[rr][q].x), bf_lo(v[rr][q].y), bf_hi(v[rr][q].y)};
                __builtin_nontemporal_store((x * rs[rr]) * gg[q], (f32x4v*)(y + (size_t)row * DM + 4 * lane + 256 * q)); } }
    }
}
__device__ __forceinline__ void phase_mixer(const unsigned short* P, unsigned short* MX, const float* conv_w, const float* conv_b, int lane, int wave) {
    const int gw = blockIdx.x * 8 + wave, NGW = gridDim.x * 8;
    const int c0 = 8 * lane, half = 1 << (lane >> 4);
    for (int it = gw; it < 2 * (MTOK / 8); it += NGW) {
        const int type = it & 1, row0 = (it >> 1) * 8;
        int t0, L; if (row0 < NCTX) { t0 = row0 & (LCTX - 1); L = LCTX; } else { t0 = (row0 - NCTX) & (LLAT - 1); L = LLAT; }
        const unsigned short* pr = P + (size_t)row0 * EVIN;
        if (type == 0) {
            float S[8] = {0.f, 0.f, 0.f, 0.f, 0.f, 0.f, 0.f, 0.f}, f[8];
#pragma unroll
            for (int k = 0; k < 16; ++k) { const int s = t0 - half + k; const float wgt = (k < 2 * half && s >= 0 && s < L) ? 1.f : 0.f; const int sc = min(max(s, 0), L - 1);
                ld8f_nt(pr + (ptrdiff_t)(sc - t0) * EVIN + c0, f);
#pragma unroll
                for (int i = 0; i < 8; ++i) S[i] += wgt * f[i]; }
#pragma unroll
            for (int r = 0; r < 8; ++r) { const int t = t0 + r; const int lo = max(t - half, 0), hi = min(t + half, L); const float inv = 1.0f / (float)(hi - lo);
                ld8f_nt(pr + (size_t)r * EVIN + c0, f);
                u32x4v o; o.x = pk2(S[0] * inv - f[0], S[1] * inv - f[1]); o.y = pk2(S[2] * inv - f[2], S[3] * inv - f[3]); o.z = pk2(S[4] * inv - f[4], S[5] * inv - f[5]); o.w = pk2(S[6] * inv - f[6], S[7] * inv - f[7]);
                *(u32x4v*)(MX + (size_t)(row0 + r) * DM + c0) = o;
                if (r < 7) {
                    { const int s = t + half; const float wgt = s < L ? 1.f : 0.f; ld8f_nt(pr + (ptrdiff_t)(min(s, L - 1) - t0) * EVIN + c0, f);
#pragma unroll
                      for (int i = 0; i < 8; ++i) S[i] += wgt * f[i]; }
                    { const int s = t - half; const float wgt = s >= 0 ? 1.f : 0.f; ld8f_nt(pr + (ptrdiff_t)(max(s, 0) - t0) * EVIN + c0, f);
#pragma unroll
                      for (int i = 0; i < 8; ++i) S[i] -= wgt * f[i]; } } }
        } else {
            float cw0[8], cw1[8], cw2[8], cb[8];
#pragma unroll
            for (int i = 0; i < 8; ++i) { cw0[i] = conv_w[c0 + i]; cw1[i] = conv_w[512 + c0 + i]; cw2[i] = conv_w[1024 + c0 + i]; cb[i] = conv_b[c0 + i]; }
            float zp[8], zc[8], zn[8], a[8], b[8];
            if (t0 > 0) { ld8f_nt(pr - EVIN + 1024 + c0, a); ld8f_nt(pr - EVIN + 1536 + c0, b);
#pragma unroll
                for (int i = 0; i < 8; ++i) zp[i] = a[i] * b[i]; }
            else {
#pragma unroll
                for (int i = 0; i < 8; ++i) zp[i] = 0.f; }
            ld8f_nt(pr + 1024 + c0, a); ld8f_nt(pr + 1536 + c0, b);
#pragma unroll
            for (int i = 0; i < 8; ++i) zc[i] = a[i] * b[i];
#pragma unroll
            for (int r = 0; r < 8; ++r) { const int t = t0 + r;
                if (t + 1 < L) { ld8f_nt(pr + (size_t)(r + 1) * EVIN + 1024 + c0, a); ld8f_nt(pr + (size_t)(r + 1) * EVIN + 1536 + c0, b);
#pragma unroll
                    for (int i = 0; i < 8; ++i) zn[i] = a[i] * b[i]; }
                else {
#pragma unroll
                    for (int i = 0; i < 8; ++i) zn[i] = 0.f; }
                ld8f_nt(pr + (size_t)r * EVIN + 512 + c0, a);
                float y[8];
#pragma unroll
                for (int i = 0; i < 8; ++i) y[i] = a[i] * (zp[i] * cw0[i] + zc[i] * cw1[i] + zn[i] * cw2[i] + cb[i]);
                u32x4v o; o.x = pk2(y[0], y[1]); o.y = pk2(y[2], y[3]); o.z = pk2(y[4], y[5]); o.w = pk2(y[6], y[7]);
                *(u32x4v*)(MX + (size_t)(row0 + r) * DM + 512 + c0) = o;
#pragma unroll
                for (int i = 0; i < 8; ++i) { zp[i] = zc[i]; zc[i] = zn[i]; } }
        }
    }
}
__device__ __forceinline__ void phase_qknorm(const Params& p, int lane, int wave) {
    unsigned char* ws = p.ws;
    const unsigned short* QKV = (const unsigned short*)(ws + WS_QKV);
    unsigned short* Q = (unsigned short*)(ws + WS_Q); unsigned short* KLAT = (unsigned short*)(ws + WS_KLAT); unsigned short* VLAT = (unsigned short*)(ws + WS_VLAT);
    unsigned short* KCTX = (unsigned short*)(ws + WS_KCTX); unsigned short* VCTX = (unsigned short*)(ws + WS_VCTX);
    float* nck = p.out + (size_t)MTOK * DM; float* ncv = nck + (size_t)16 * 256 * 256;
    const int gw = blockIdx.x * 8 + wave, NGW = gridDim.x * 8;
    const int i8 = 8 * (lane & 15), hsel = lane >> 4;
    const bool colaxis = (i8 >> 6) != 0, second = ((i8 >> 5) & 1) != 0;
    float qg[8], kg[8], invf[8];
#pragma unroll
    for (int q = 0; q < 8; ++q) { qg[q] = p.in[16][i8 + q]; kg[q] = p.in[17][i8 + q]; invf[q] = __builtin_amdgcn_exp2f(-(float)((i8 & 31) + q) * (13.287712379549449f / 32.0f)); }
    for (int row = gw; row < MTOK; row += NGW) {
        const unsigned short* r = QKV + (size_t)row * NQKV + 8 * lane;
        const u32x4v w0 = __builtin_nontemporal_load((const u32x4v*)(r)), w1 = __builtin_nontemporal_load((const u32x4v*)(r + 512)), w2 = __builtin_nontemporal_load((const u32x4v*)(r + 1024));
        const bool lat = row >= NCTX; int b, t; float cs[8], sn[8];
        if (lat) { const int rr = row - NCTX; b = rr >> 12; t = rr & 4095; const float pos = (float)(colaxis ? (t & 63) : (t >> 6));
#pragma unroll
            for (int q = 0; q < 8; ++q) { const float ang = pos * invf[q]; cs[q] = __cosf(ang); sn[q] = __sinf(ang); if (!second) sn[q] = -sn[q]; } }
        else { b = row >> 8; t = row & 255;
#pragma unroll
            for (int q = 0; q < 8; ++q) { cs[q] = 1.f; sn[q] = 0.f; } }
#pragma unroll
        for (int c = 0; c < 3; ++c) {
            const u32x4v w = c == 0 ? w0 : c == 1 ? w1 : w2;
            float x[8] = {bf_lo(w.x), bf_hi(w.x), bf_lo(w.y), bf_hi(w.y), bf_lo(w.z), bf_hi(w.z), bf_lo(w.w), bf_hi(w.w)};
            float s = 0.f;
#pragma unroll
            for (int q = 0; q < 8; ++q) s += x[q] * x[q];
            s += __shfl_xor(s, 1); s += __shfl_xor(s, 2); s += __shfl_xor(s, 4); s += __shfl_xor(s, 8);
            const float rstd = __builtin_amdgcn_rsqf(s * (1.0f / 128.0f) + EPS);
            float o[8];
#pragma unroll
            for (int q = 0; q < 8; ++q) { const float y = x[q] * rstd * (c < 2 ? qg[q] : kg[q]); const float yp = __shfl_xor(y, 4); o[q] = y * cs[q] + yp * sn[q]; }
            if (c < 2) { u32x4v ow; ow.x = pk2(o[0], o[1]); ow.y = pk2(o[2], o[3]); ow.z = pk2(o[4], o[5]); ow.w = pk2(o[6], o[7]);
                *(u32x4v*)(Q + (size_t)row * DM + c * 512 + 8 * lane) = ow; }
            else {
                const int kh = hsel & 1; const bool isv = hsel >= 2;
                u32x4v ow = w;
                if (!isv) { ow.x = pk2(o[0], o[1]); ow.y = pk2(o[2], o[3]); ow.z = pk2(o[4], o[5]); ow.w = pk2(o[6], o[7]); }
                if (lat) { unsigned short* dst = (isv ? VLAT : KLAT) + ((size_t)(b * 2 + kh) * SKV + PAST + t) * 128 + i8; *(u32x4v*)dst = ow; }
                else { unsigned short* dst = (isv ? VCTX : KCTX) + ((size_t)(b * 2 + kh) * LCTX + t) * 128 + i8; *(u32x4v*)dst = ow;
                    float* od = (isv ? ncv : nck) + ((size_t)(b * LCTX + t) * 2 + kh) * 128 + i8;
                    f32x4v f0, f1;
                    if (isv) { f0 = (f32x4v){x[0], x[1], x[2], x[3]}; f1 = (f32x4v){x[4], x[5], x[6], x[7]}; } else { f0 = (f32x4v){o[0], o[1], o[2], o[3]}; f1 = (f32x4v){o[4], o[5], o[6], o[7]}; }
                    __builtin_nontemporal_store(f0, (f32x4v*)od); __builtin_nontemporal_store(f1, (f32x4v*)(od + 4)); }
            }
        }
    }
    for (int it = gw; it < 2 * 4 * PAST; it += NGW) {
        const int which = it >> 11, q = it & 2047, b = q >> 9, s = q & 511, kh = lane >> 5;
        const f32x4v v = __builtin_nontemporal_load((const f32x4v*)((which ? p.in[3] : p.in[2]) + (size_t)(b * PAST + s) * 256 + 4 * lane));
        u32x2v w; w.x = pk2(v.x, v.y); w.y = pk2(v.z, v.w);
        *(u32x2v*)((which ? VLAT : KLAT) + ((size_t)(b * 2 + kh) * SKV + s) * 128 + 4 * (lane & 31)) = w;
    }
}
__device__ __forceinline__ void phase_attention(const Params& p, char* lds) {
    unsigned char* ws = p.ws;
    const bf16* Q = (const bf16*)(ws + WS_Q); bf16* O = (bf16*)(ws + WS_O);
    const bf16* KLAT = (const bf16*)(ws + WS_KLAT); const bf16* VLAT = (const bf16*)(ws + WS_VLAT); const bf16* KCTX = (const bf16*)(ws + WS_KCTX); const bf16* VCTX = (const bf16*)(ws + WS_VCTX);
    for (int L = blockIdx.x; L < 128 + 512; L += gridDim.x) {
        const bf16* Qp; const bf16* Kp; const bf16* Vp; bf16* Op; int seq;
        if (L < 128) { const int b = L >> 3, h = L & 7; const size_t q0 = (size_t)(b * LCTX) * DM + h * 128, k0 = (size_t)(b * 2 + (h >> 2)) * LCTX * 128;
            Qp = Q + q0; Kp = KCTX + k0; Vp = VCTX + k0; Op = O + q0; seq = LCTX; }
        else { const int u = L - 128, bk = u & 7, w = u >> 3, hq = w >> 4, qb = w & 15, b = bk >> 1, kvh = bk & 1, h = kvh * 4 + hq;
            const size_t q0 = (size_t)(NCTX + b * LLAT + qb * 256) * DM + h * 128, k0 = (size_t)(b * 2 + kvh) * SKV * 128;
            Qp = Q + q0; Kp = KLAT + k0; Vp = VLAT + k0; Op = O + q0; seq = SKV; }
        attn::attn_dense_body<bf16>(Qp, Kp, Vp, Op, seq, lds);
        __syncthreads();
    }
}

#define XB_TMO      128
#define XB_XCNT(j)  (256  + 64 * (j))
#define XB_XSUB(j)  (1280 + 64 * (j))
#define XB_XGEN(j)  (2304 + 64 * (j))
#define XB_TOP      3328
#define XB_TOPGEN   3392
#define XCD_BAR_WORDS 3456
#define XB_SPIN_CAP (1u << 18)

__device__ __forceinline__ unsigned xb_ld(unsigned* p)              { return __hip_atomic_load(p, __ATOMIC_RELAXED, __HIP_MEMORY_SCOPE_AGENT); }
__device__ __forceinline__ unsigned xb_add(unsigned* p, unsigned v) { return __hip_atomic_fetch_add(p, v, __ATOMIC_RELAXED, __HIP_MEMORY_SCOPE_AGENT); }
__device__ __forceinline__ unsigned xb_xcc_id() { return (unsigned)__builtin_amdgcn_s_getreg((3 << 11) | 20) & 0xFu; }
#define XB_SPIN(cond, bar) do { unsigned _sp = 0; while (cond) { __builtin_amdgcn_s_sleep(1); \
    if ((++_sp & 255u) == 0u) { if (xb_ld(&(bar)[XB_TMO])) break; if (_sp > XB_SPIN_CAP) { atomicAdd(&(bar)[XB_TMO], 1u); break; } } } } while (0)

struct XcdBarrier {
    unsigned* bar; unsigned x;
    volatile LAS unsigned* st;
};

__device__ __forceinline__ XcdBarrier xcd_barrier_post(unsigned* bar, volatile LAS unsigned* st) {
    XcdBarrier b; b.bar = bar; b.x = xb_xcc_id(); b.st = st;
    if (threadIdx.x == 0) (void)xb_add(&bar[XB_XCNT(b.x)], 1u);
    return b;
}
__device__ __forceinline__ void xcd_barrier_complete(unsigned* bar, unsigned x, unsigned& nloc, unsigned& nx) {
    const unsigned G = gridDim.x * gridDim.y * gridDim.z;
    unsigned sum, cnt, mine, sp = 0u;
    for (;;) {
        sum = 0u; cnt = 0u; mine = 0u;
#pragma unroll
        for (unsigned j = 0; j < 16; ++j) { const unsigned c = xb_ld(&bar[XB_XCNT(j)]); sum += c; cnt += (c > 0u) ? 1u : 0u; mine = (j == x) ? c : mine; }
        if (sum == G) break;
        __builtin_amdgcn_s_sleep(1);
        if ((++sp & 255u) == 0u) { if (xb_ld(&bar[XB_TMO])) break; if (sp > XB_SPIN_CAP) { atomicAdd(&bar[XB_TMO], 1u); break; } }
    }
    nloc = mine > 0u ? mine : 1u; nx = cnt > 0u ? cnt : 1u;
}

__device__ __forceinline__ void xcd_barrier(const XcdBarrier& b) {
    asm volatile("s_waitcnt vmcnt(0)" ::: "memory");
    __syncthreads();
    if (threadIdx.x == 0) {
        unsigned* bar = b.bar;
        __builtin_amdgcn_s_waitcnt(0);
        unsigned nloc = b.st[0], nx = b.st[1];
        if (nloc == 0u) { xcd_barrier_complete(bar, b.x, nloc, nx); b.st[0] = nloc; b.st[1] = nx; }
        const unsigned old = xb_add(&bar[XB_XSUB(b.x)], 1u);
        const unsigned gen = old / nloc;
        if (old + 1u == (gen + 1u) * nloc) {
            __builtin_amdgcn_fence(__ATOMIC_RELEASE, "agent");
            asm volatile("s_waitcnt vmcnt(0)" ::: "memory");
            const unsigned og = xb_add(&bar[XB_TOP], 1u);
            const unsigned tg = og / nx;
            if (og + 1u == (tg + 1u) * nx) xb_add(&bar[XB_TOPGEN], 1u);
            else XB_SPIN(xb_ld(&bar[XB_TOPGEN]) == tg, bar);
            __builtin_amdgcn_fence(__ATOMIC_ACQUIRE, "agent");
            xb_add(&bar[XB_XGEN(b.x)], 1u);
            asm volatile("s_waitcnt vmcnt(0)" ::: "memory");
        } else {
            XB_SPIN(xb_ld(&bar[XB_XGEN(b.x)]) == gen, bar);
            __builtin_amdgcn_fence(__ATOMIC_ACQUIRE, "agent");
            asm volatile("s_waitcnt vmcnt(0)" ::: "memory");
        }
    }
    __syncthreads();
}

template <int ph> __device__ __forceinline__ void run_phase(const Params& p, unsigned char* lds, int tid, int lane, int wave) {
    unsigned char* ws = p.ws;
    const float* mods = (const float*)(ws + WS_MODS); const float* gp = (const float*)(ws + WS_GP); float* ss = (float*)(ws + WS_SS);
    const float* sWf1 = (const float*)(ws + WS_SWF1); const float* sWqkv = (const float*)(ws + WS_SWQKV);
    float* xo = p.out;
    typedef pg8::bf16_t bt;
    if constexpr (ph == 0) phase_prep(p, (LAS unsigned char*)lds, tid, lane, wave);
    else if constexpr (ph == 1) phase_p1(p, tid, lane, wave);
    else if constexpr (ph == 2) {
        pg8::Gemm g{(const bt*)(ws + WS_H), (const bt*)(ws + WS_WIN), MTOK, EVIN, DM}; pg8::HalfOrder S; S.init(gridDim.x, blockIdx.x, EVIN / 256);
        pg8::EpiStoreN<false> E{(bt*)(ws + WS_P), EVIN, nullptr, nullptr, 0};
        pg8::gemm_phase<pg8::EpiStoreN<false>, pg8::HalfOrder, true, true>((LAS unsigned char*)lds, g, S, E); }
    else if constexpr (ph == 3) phase_mixer((const unsigned short*)(ws + WS_P), (unsigned short*)(ws + WS_MX), p.in[12], p.in[13], lane, wave);
    else if constexpr (ph == 4 || ph == 6 || ph == 10 || ph == 12) {
        constexpr int l = ph >= 10; constexpr bool ffn = (ph == 6 || ph == 12); constexpr int K = ffn ? DFF : DM; constexpr int site = ph == 4 ? 0 : ph == 6 ? 1 : ph == 10 ? 2 : 3;
        const unsigned char* A = ws + (ffn ? WS_ACT : (ph == 4 ? WS_MX : WS_O));
        const unsigned char* Bt = ws + (ffn ? WS_WF2 + l * WF2_STRIDE : (ph == 4 ? WS_WOUT : WS_WO));
        pg8::Gemm g{(const bt*)A, (const bt*)Bt, MTOK, DM, K}; pg8::HalfOrder S; S.init(gridDim.x, blockIdx.x);
        typedef pg8::EpiResNorm<(site < 3), (ph == 4)> Epi;
        Epi E{p.in[0], p.in[1], (bt*)(ws + WS_XB), mods + (size_t)l * 5 * 6144 + (ffn ? 5 : 2) * 1024, gp + (site < 3 ? site : 0) * 5120, (bt*)(ws + WS_H), ss + site * MTOK};
        pg8::gemm_phase<Epi, pg8::HalfOrder, true, true>((LAS unsigned char*)lds, g, S, E); }
    else if constexpr (ph == 5 || ph == 11) { constexpr int l = ph == 11;
        pg8::Gemm g{(const bt*)(ws + WS_H), (const bt*)(ws + WS_WF1 + l * WF1_STRIDE), MTOK, 2 * DFF, DM}; pg8::StaticOrder S; S.init(MTOK, 2 * DFF, gridDim.x, blockIdx.x);
        pg8::EpiSwigluN E{(bt*)(ws + WS_ACT), DFF, ss + (l ? 2 : 0) * MTOK, sWf1 + l * 5 * 2 * DFF, 2 * DFF};
        pg8::gemm_phase<pg8::EpiSwigluN, pg8::StaticOrder, true, true>((LAS unsigned char*)lds, g, S, E); }
    else if constexpr (ph == 7) {
        pg8::Gemm g{(const bt*)(ws + WS_H), (const bt*)(ws + WS_WQKV), MTOK, NQKV, DM}; pg8::StaticOrder S; S.init(MTOK, NQKV, gridDim.x, blockIdx.x);
        pg8::EpiStoreN<true> E{(bt*)(ws + WS_QKV), NQKV, ss + 1 * MTOK, sWqkv, NQKV};
        pg8::gemm_phase<pg8::EpiStoreN<true>, pg8::StaticOrder, true, true>((LAS unsigned char*)lds, g, S, E); }
    else if constexpr (ph == 8) phase_qknorm(p, lane, wave);
    else if constexpr (ph == 9) phase_attention(p, (char*)lds);
    else if constexpr (ph == 13) phase_final((const unsigned short*)(ws + WS_XB), xo, p.in[21], ss + 3 * MTOK, lane, wave);
}
__global__ void __launch_bounds__(512, 2) mega_fwd(Params p) {
    extern __shared__ __attribute__((aligned(16))) unsigned char lds[];
    cg::grid_group grid = cg::this_grid();
    const int tid = threadIdx.x, lane = tid & 63, wave = __builtin_amdgcn_readfirstlane(tid >> 6);
    const bool multi = p.ph_hi - p.ph_lo > 1, use_cg = gridDim.x > 1024u;
    if (tid < 2) ((LAS unsigned*)(lds + 131072))[tid] = 0u;
    __syncthreads();
    XcdBarrier bar; bar.bar = (unsigned*)(p.ws + WS_BAR); bar.x = 0; bar.st = nullptr;
    if (multi && !use_cg) bar = xcd_barrier_post((unsigned*)(p.ws + WS_BAR), (volatile LAS unsigned*)(lds + 131072));
#define SEAM(k) do { if (use_cg) grid.sync(); else xcd_barrier(bar); } while (0)
#define PHASE(k) if (p.ph_lo <= (k) && (k) < p.ph_hi) { run_phase<(k)>(p, lds, tid, lane, wave); if ((k) + 1 < p.ph_hi) SEAM(k); }
    PHASE(0) PHASE(1) PHASE(2) PHASE(3) PHASE(4) PHASE(5) PHASE(6) PHASE(7) PHASE(8) PHASE(9) PHASE(10) PHASE(11) PHASE(12) PHASE(13)
#undef PHASE
}

#ifndef MK_SPLIT
#define MK_SPLIT 0
#endif
extern "C" void kernel_launch(void* const* d_in, const int* in_sizes, int n_in, void* d_out, int out_size, void* d_ws, size_t ws_size, hipStream_t stream) {
    static int grid_blocks = 0;
    if (grid_blocks == 0) {
        if (n_in != 22 || ws_size < WS_END) { fprintf(stderr, "kernel_launch: unexpected n_in %d / ws_size %zu\n", n_in, ws_size); grid_blocks = -1; return; }
        int dev = 0, cus = 0, per_cu = 0;
        (void)hipGetDevice(&dev); (void)hipDeviceGetAttribute(&cus, hipDeviceAttributeMultiprocessorCount, dev);
        if (hipFuncSetAttribute((const void*)mega_fwd, hipFuncAttributeMaxDynamicSharedMemorySize, LDS_BYTES) != hipSuccess) { fprintf(stderr, "kernel_launch: hipFuncSetAttribute failed\n"); grid_blocks = -1; return; }
        if (hipOccupancyMaxActiveBlocksPerMultiprocessor(&per_cu, (const void*)mega_fwd, 512, LDS_BYTES) != hipSuccess || per_cu < 1) { fprintf(stderr, "kernel_launch: occupancy query gave %d\n", per_cu); grid_blocks = -1; return; }
        grid_blocks = cus * per_cu;
    }
    if (grid_blocks < 0) return;
    if (hipMemsetAsync((char*)d_ws + WS_ZERO_BEGIN, 0, WS_ZERO_BYTES, stream) != hipSuccess) { fprintf(stderr, "kernel_launch: hipMemsetAsync failed\n"); return; }
    Params p{};
    for (int i = 0; i < 22; ++i) p.in[i] = (const float*)d_in[i];
    p.out = (float*)d_out; p.ws = (unsigned char*)d_ws;
#if MK_SPLIT
    for (int ph = 0; ph < NPHASE; ++ph) {
        p.ph_lo = ph; p.ph_hi = ph + 1; void* args[] = {&p};
        hipError_t e = hipLaunchCooperativeKernel((const void*)mega_fwd, dim3(grid_blocks), dim3(512), args, LDS_BYTES, stream);
        if (e != hipSuccess) { fprintf(stderr, "cooperative launch failed: %s (grid %d)\n", hipGetErrorString(e), grid_blocks); return; }
    }
#else
    p.ph_lo = 0; p.ph_hi = NPHASE; void* args[] = {&p};
    hipError_t e = hipLaunchCooperativeKernel((const void*)mega_fwd, dim3(grid_blocks), dim3(512), args, LDS_BYTES, stream);
    if (e != hipSuccess) fprintf(stderr, "cooperative launch failed: %s (grid %d)\n", hipGetErrorString(e), grid_blocks);
#endif
}
```

```cpp
#include <hip/hip_runtime.h>
#include <hip/hip_cooperative_groups.h>
#include <hip/hip_bf16.h>
#include <cstdio>
#include <cstdint>
namespace cg = cooperative_groups;

namespace pg8 {
#define PG8_LAS __attribute__((address_space(3)))
typedef unsigned short bf16_t;
typedef short bf16x8 __attribute__((ext_vector_type(8)));
typedef float f32x4 __attribute__((ext_vector_type(4)));
typedef unsigned u32x4 __attribute__((ext_vector_type(4)));
constexpr int BM = 256, BK = 64, HALF = 128, HTB = HALF * BK * 2  , STAGE_BYTES = 8 * HTB, NXCD = 8, WGM = 8;

__host__ __device__ __forceinline__ int lds_byte(int r, int c) { const int st = (r >> 4) * 2 + (c >> 5), rr = r & 15, cc = c & 31, ob = rr * 64 + cc * 2; return st * 1024 + (ob ^ (((ob >> 9) & 1) << 5)); }
__host__ __device__ __forceinline__ void stage_rc(int b, int& R, int& C) { const int st = b / 1024, sb = b % 1024, swz = sb ^ (((sb >> 9) & 1) << 5); R = (st >> 1) * 16 + swz / 64; C = (st & 1) * 32 + (swz % 64) / 2; }
__host__ __device__ __forceinline__ int perm32(int rho) { const int n = rho >> 4, i = rho & 15; return 8 * (i >> 2) + 4 * n + (i & 3); }

struct Unit { int pm, pn, hf; };
struct Gemm { const bf16_t* A; const bf16_t* Bt; int M, N, K; };

struct StaticOrder {
    int nM, nN, nwg, G, c;
    __host__ __device__ void init(int M, int N, int G_, int c_) { nM = M / BM; nN = N / BM; nwg = nM * nN; G = G_; c = c_; }
    __host__ __device__ bool next(int i, Unit& u) const {
        const long L = (long)i * G + c; if (L >= nwg) return false;
        int wgid = (int)L; { const int q = nwg / NXCD, r = nwg % NXCD, xcd = wgid % NXCD, off = wgid / NXCD; wgid = (xcd < r ? xcd * (q + 1) : r * (q + 1) + (xcd - r) * q) + off; }
        const int nig = WGM * nN, gid = wgid / nig, fm = gid * WGM, gsz = (nM - fm) < WGM ? (nM - fm) : WGM;
        u.pm = fm + ((wgid % nig) % gsz); u.pn = (wgid % nig) / gsz; u.hf = 0; return true;
    }
    __device__ __forceinline__ void a_ready(const Unit&) const {}
    __device__ __forceinline__ void done(const Unit&) const {}
};
struct HalfOrder {
    int G, c, ncol;
    __host__ __device__ void init(int G_, int c_, int ncol_ = 4) { G = G_; c = c_; ncol = ncol_; }
    __host__ __device__ __forceinline__ bool next(int i, Unit& u) const {
        const int L = i * G + c, nhalf = 32 * ncol; if (L >= nhalf + 64 * ncol) return false;
        const bool full = L >= nhalf; const int Lf = L - nhalf, x = Lf & 7, slot = Lf >> 3, h = L;
        u.pm = full ? 16 + x * 8 + slot / ncol : h / (2 * ncol); u.pn = full ? slot % ncol : h % (2 * ncol); u.hf = full ? 0 : 1;
        return true;
    }
    __device__ __forceinline__ void a_ready(const Unit&) const {}
    __device__ __forceinline__ void done(const Unit&) const {}
};

__device__ __forceinline__ unsigned cvt_pk_bf16(float lo, float hi) { unsigned r; asm volatile("v_cvt_pk_bf16_f32 %0, %1, %2" : "=v"(r) : "v"(lo), "v"(hi)); return r; }
__device__ __forceinline__ int cond_of(int pm) { return pm < 16 ? 0 : 1 + ((pm - 16) >> 4); }
template <bool NORM> struct EpiStoreN {
    static constexpr bool PERM = true, AFTER_DRAIN = false;
    bf16_t* O; int ldc; const float* ss; const float* sW; int ldw;
    __device__ __forceinline__ void operator()(const f32x4 (&acc)[2][2][4][2], const Unit& u, int wr, int wc, int fr, int fq) const {
        const int row0 = u.pm * BM + wr * 64 + fr, col0 = u.pn * (u.hf ? HALF : BM) + wc * 32 + 8 * fq; const int nbj = u.hf ? 1 : 2;
        f32x4 bv[2][2];
        if constexpr (NORM) { const float* bp = sW + (size_t)cond_of(u.pm) * ldw + col0;
#pragma unroll
            for (int bj = 0; bj < 2; ++bj)
#pragma unroll
                for (int n = 0; n < 2; ++n) bv[bj][n] = *(const f32x4*)(bp + bj * HALF + 4 * n); }
#pragma unroll
        for (int ai = 0; ai < 2; ++ai)
#pragma unroll
            for (int m = 0; m < 4; ++m) { const int r = row0 + ai * HALF + m * 16; bf16_t* rowp = O + (size_t)r * ldc + col0;
                float rs = 1.f; if constexpr (NORM) rs = __builtin_amdgcn_rsqf(ss[r] * (1.0f / 1024.0f) + 1e-6f);
#pragma unroll
                for (int bj = 0; bj < 2; ++bj) { if (bj >= nbj) continue; f32x4 v0 = acc[ai][bj][m][0], v1 = acc[ai][bj][m][1];
                    if constexpr (NORM) { v0 = v0 * rs + bv[bj][0]; v1 = v1 * rs + bv[bj][1]; }
                    u32x4 w; w.x = cvt_pk_bf16(v0[0], v0[1]); w.y = cvt_pk_bf16(v0[2], v0[3]); w.z = cvt_pk_bf16(v1[0], v1[1]); w.w = cvt_pk_bf16(v1[2], v1[3]);
                    *(u32x4*)(rowp + bj * HALF) = w; } }
    }
};
__device__ __forceinline__ float silu_mul(float a, float b) { return a * __builtin_amdgcn_rcpf(1.0f + __builtin_amdgcn_exp2f(-1.4426950408889634f * a)) * b; }
struct EpiSwigluN {
    static constexpr bool PERM = true, AFTER_DRAIN = false;
    bf16_t* O; int ldc; const float* ss; const float* sW; int ldw;
    __device__ __forceinline__ void operator()(const f32x4 (&acc)[2][2][4][2], const Unit& u, int wr, int wc, int fr, int fq) const {
        const int row0 = u.pm * BM + wr * 64 + fr, col0 = u.pn * HALF + wc * 32 + 8 * fq;
        const float* bp = sW + (size_t)cond_of(u.pm) * ldw + u.pn * BM + wc * 32 + 8 * fq;
        const f32x4 ba0 = *(const f32x4*)(bp), ba1 = *(const f32x4*)(bp + 4), bb0 = *(const f32x4*)(bp + HALF), bb1 = *(const f32x4*)(bp + HALF + 4);
#pragma unroll
        for (int ai = 0; ai < 2; ++ai)
#pragma unroll
            for (int m = 0; m < 4; ++m) { const int r = row0 + ai * HALF + m * 16; bf16_t* rowp = O + (size_t)r * ldc + col0;
                const float rs = __builtin_amdgcn_rsqf(ss[r] * (1.0f / 1024.0f) + 1e-6f);
                const f32x4 a0 = acc[ai][0][m][0] * rs + ba0, a1 = acc[ai][0][m][1] * rs + ba1, b0 = acc[ai][1][m][0] * rs + bb0, b1 = acc[ai][1][m][1] * rs + bb1;
                u32x4 w; w.x = cvt_pk_bf16(silu_mul(a0[0], b0[0]), silu_mul(a0[1], b0[1])); w.y = cvt_pk_bf16(silu_mul(a0[2], b0[2]), silu_mul(a0[3], b0[3]));
                w.z = cvt_pk_bf16(silu_mul(a1[0], b1[0]), silu_mul(a1[1], b1[1])); w.w = cvt_pk_bf16(silu_mul(a1[2], b1[2]), silu_mul(a1[3], b1[3]));
                *(u32x4*)rowp = w; }
    }
};
template <bool HB, bool FIRST> struct EpiResNorm {
    static constexpr bool PERM = true, AFTER_DRAIN = false;
    const float* base_ctx; const float* base_lat; bf16_t* xb; const float* gate; const float* gp; bf16_t* hb; float* ss;
    __device__ __forceinline__ void operator()(const f32x4 (&acc)[2][2][4][2], const Unit& u, int wr, int wc, int fr, int fq) const {
        const int j = cond_of(u.pm);
        const float* base = u.pm < 16 ? base_ctx + (size_t)u.pm * BM * 1024 : base_lat + (size_t)(u.pm - 16) * BM * 1024;
        const int col0 = u.pn * (u.hf ? HALF : BM) + wc * 32 + 8 * fq, rl0 = wr * 64 + fr; const int nbj = u.hf ? 1 : 2;
        f32x4 gv[2][2], pv[2][2];
#pragma unroll
        for (int bj = 0; bj < 2; ++bj)
#pragma unroll
            for (int n = 0; n < 2; ++n) { if (bj >= nbj) continue; gv[bj][n] = *(const f32x4*)(gate + (size_t)j * 6144 + col0 + bj * HALF + n * 4);
                if constexpr (HB) pv[bj][n] = *(const f32x4*)(gp + (size_t)j * 1024 + col0 + bj * HALF + n * 4); }
        bf16_t* outp = xb + (size_t)u.pm * BM * 1024; bf16_t* hbp = hb + (size_t)u.pm * BM * 1024; float* ssp = ss + u.pm * BM;
#pragma unroll
        for (int ai = 0; ai < 2; ++ai)
#pragma unroll
            for (int m = 0; m < 4; ++m) { const int rl = rl0 + ai * HALF + m * 16; const size_t off = (size_t)rl * 1024 + col0; float s = 0.f;
#pragma unroll
                for (int bj = 0; bj < 2; ++bj) { if (bj >= nbj) continue;
                    f32x4 b0, b1;
                    if constexpr (FIRST) { b0 = __builtin_nontemporal_load((const f32x4*)(base + off + bj * HALF)); b1 = __builtin_nontemporal_load((const f32x4*)(base + off + bj * HALF + 4)); }
                    else { const u32x4 bw = *(const u32x4*)(outp + off + bj * HALF);
                        b0 = (f32x4){__builtin_bit_cast(float, bw.x << 16), __builtin_bit_cast(float, bw.x & 0xffff0000u), __builtin_bit_cast(float, bw.y << 16), __builtin_bit_cast(float, bw.y & 0xffff0000u)};
                        b1 = (f32x4){__builtin_bit_cast(float, bw.z << 16), __builtin_bit_cast(float, bw.z & 0xffff0000u), __builtin_bit_cast(float, bw.w << 16), __builtin_bit_cast(float, bw.w & 0xffff0000u)}; }
                    const f32x4 o0 = b0 + gv[bj][0] * acc[ai][bj][m][0], o1 = b1 + gv[bj][1] * acc[ai][bj][m][1];
                    { u32x4 ow; ow.x = cvt_pk_bf16(o0[0], o0[1]); ow.y = cvt_pk_bf16(o0[2], o0[3]); ow.z = cvt_pk_bf16(o1[0], o1[1]); ow.w = cvt_pk_bf16(o1[2], o1[3]); *(u32x4*)(outp + off + bj * HALF) = ow; }
                    s += ((o0[0] * o0[0] + o0[1] * o0[1]) + (o0[2] * o0[2] + o0[3] * o0[3])) + ((o1[0] * o1[0] + o1[1] * o1[1]) + (o1[2] * o1[2] + o1[3] * o1[3]));
                    if constexpr (HB) { const f32x4 h0 = o0 * pv[bj][0], h1 = o1 * pv[bj][1]; u32x4 w; w.x = cvt_pk_bf16(h0[0], h0[1]); w.y = cvt_pk_bf16(h0[2], h0[3]); w.z = cvt_pk_bf16(h1[0], h1[1]); w.w = cvt_pk_bf16(h1[2], h1[3]); *(u32x4*)(hbp + off + bj * HALF) = w; } }
                s += __shfl_xor(s, 16); s += __shfl_xor(s, 32);
                if (fq == 0) __hip_atomic_fetch_add(ssp + rl, s, __ATOMIC_RELAXED, __HIP_MEMORY_SCOPE_AGENT); }
    }
};

template <class Epi, class Sched, bool ALIGN_EPI = false, bool SP2 = false>
__device__ __forceinline__ void gemm_phase(PG8_LAS unsigned char* lds, const Gemm g, const Sched& S, const Epi& E) {
    const int tid = threadIdx.x, wid = __builtin_amdgcn_readfirstlane(tid >> 6), lane = tid & 63, wr = wid >> 2, wc = wid & 3, fr = lane & 15, fq = lane >> 4;
    const int K = g.K, nt = K / BK;
    unsigned voffA[2], voffB[2];
#pragma unroll
    for (int i = 0; i < 2; ++i) { int R, C; stage_rc(tid * 16 + i * 8192, R, C); const int Rb = Epi::PERM ? ((R & ~31) + perm32(R & 31)) : R;
        voffA[i] = (unsigned)(R * K + C) * 2u; voffB[i] = (unsigned)(Rb * K + C) * 2u; }
    const size_t kstep = (size_t)(BK * 2);
    const size_t hstep = (size_t)HALF * K * 2;
    const size_t tstep = 2 * hstep;
    const unsigned ldsw = (unsigned)wid * 1024u;
    const int aoff = lds_byte(wr * 64 + fr, fq * 8), boff = lds_byte(wc * 32 + fr, fq * 8);
#define PG8_SA(b, h) (((b) * 2 + (h)) * HTB)
#define PG8_SB(b, h) ((4 + (b) * 2 + (h)) * HTB)
#define PG8_STAGE(bufoff, gbase, voff) do { _Pragma("unroll") for (int _i = 0; _i < 2; ++_i) \
        __builtin_amdgcn_global_load_lds((const unsigned*)((const char*)(gbase) + (voff)[_i]), (PG8_LAS unsigned*)(lds + (bufoff) + ldsw + _i * 8192), 16, 0, 0); } while (0)
#define PG8_LDA(dst, b, h) do { _Pragma("unroll") for (int m = 0; m < 4; ++m) _Pragma("unroll") for (int k = 0; k < 2; ++k) dst[m][k] = *(const PG8_LAS bf16x8*)(lds + PG8_SA(b, h) + aoff + m * 2048 + k * 1024); } while (0)
#define PG8_LDB(dst, b, h) do { _Pragma("unroll") for (int n = 0; n < 2; ++n) _Pragma("unroll") for (int k = 0; k < 2; ++k) dst[n][k] = *(const PG8_LAS bf16x8*)(lds + PG8_SB(b, h) + boff + n * 2048 + k * 1024); } while (0)
#define PG8_MMA(ai, bj, At, Bt) do { __builtin_amdgcn_s_setprio(1); _Pragma("unroll") for (int m = 0; m < 4; ++m) _Pragma("unroll") for (int n = 0; n < 2; ++n) _Pragma("unroll") for (int k = 0; k < 2; ++k) \
        acc[ai][bj][m][n] = __builtin_amdgcn_mfma_f32_16x16x32_bf16(Bt[n][k], At[m][k], acc[ai][bj][m][n], 0, 0, 0); __builtin_amdgcn_s_setprio(0); } while (0)
#define PG8_WAIT_V(n) asm volatile("s_waitcnt vmcnt(" #n ")" ::: "memory")
#define PG8_WAIT_L(n) asm volatile("s_waitcnt lgkmcnt(" #n ")" ::: "memory")
#define PG8_BAR __builtin_amdgcn_s_barrier()
#define PG8_SCHED __builtin_amdgcn_sched_barrier(0)
    Unit cur, nxt; int ui = 0;
    if (!S.next(0, cur)) return;
    f32x4 acc[2][2][4][2];
#pragma unroll
    for (int a = 0; a < 2; ++a)
#pragma unroll
        for (int b = 0; b < 2; ++b)
#pragma unroll
            for (int m = 0; m < 4; ++m)
#pragma unroll
                for (int n = 0; n < 2; ++n) acc[a][b][m][n] = (f32x4){0.f, 0.f, 0.f, 0.f};
    bf16x8 At[4][2], B0[2][2], B1[2][2];
    const char* cA = (const char*)g.A + (size_t)cur.pm * tstep; const char* cB = (const char*)g.Bt + (size_t)cur.pn * (cur.hf ? hstep : tstep);
    size_t cbh = cur.hf ? 0 : hstep;
    S.a_ready(cur);
    if constexpr (SP2) {
        PG8_STAGE(PG8_SB(0, 0), cB, voffB); PG8_STAGE(PG8_SB(0, 1), cB + cbh, voffB); PG8_STAGE(PG8_SA(0, 0), cA, voffA); PG8_STAGE(PG8_SA(0, 1), cA + hstep, voffA);
        if (wr == 1) PG8_BAR;
        PG8_WAIT_V(2); PG8_BAR;
        PG8_STAGE(PG8_SB(1, 0), cB + kstep, voffB); PG8_STAGE(PG8_SA(1, 0), cA + kstep, voffA); PG8_STAGE(PG8_SB(1, 1), cB + cbh + kstep, voffB);
        PG8_WAIT_V(6); PG8_BAR;
    } else {
        PG8_STAGE(PG8_SB(0, 0), cB, voffB); PG8_STAGE(PG8_SA(0, 0), cA, voffA); PG8_STAGE(PG8_SB(0, 1), cB + cbh, voffB); PG8_STAGE(PG8_SA(0, 1), cA + hstep, voffA);
        if (wr == 1) PG8_BAR;
        PG8_WAIT_V(4); PG8_BAR;
        PG8_STAGE(PG8_SB(1, 0), cB + kstep, voffB); PG8_STAGE(PG8_SA(1, 0), cA + kstep, voffA); PG8_STAGE(PG8_SB(1, 1), cB + cbh + kstep, voffB);
        PG8_WAIT_V(6); PG8_BAR;
    }
    for (;;) {
        const bool has_next = S.next(ui + 1, nxt);
        const char* nA = has_next ? (const char*)g.A + (size_t)nxt.pm * tstep : cA; const char* nB = has_next ? (const char*)g.Bt + (size_t)nxt.pn * (nxt.hf ? hstep : tstep) : cB;
        const bool fullu = cur.hf == 0; const size_t nbh = has_next ? (nxt.hf ? 0 : hstep) : cbh;
        if (fullu) {
        for (int t = 0; t < nt; t += 2) {
            const bool last = (t == nt - 2);
            const char* a1 = cA + (size_t)(t + 1) * kstep;
            const char* a2 = last ? nA : cA + (size_t)(t + 2) * kstep; const char* b2 = last ? nB : cB + (size_t)(t + 2) * kstep;
            const char* a3 = a2 + kstep; const char* b3 = b2 + kstep; const size_t b2h = last ? nbh : cbh;
            if (last && has_next) S.a_ready(nxt);
            if constexpr (SP2) {
            PG8_LDB(B0, 0, 0); PG8_LDB(B1, 0, 1); PG8_SCHED; PG8_LDA(At, 0, 0); PG8_STAGE(PG8_SA(1, 1), a1 + hstep, voffA);
            PG8_WAIT_V(8); PG8_WAIT_L(0); PG8_BAR; PG8_MMA(0, 0, At, B0); PG8_MMA(0, 1, At, B1); PG8_BAR; PG8_SCHED;
            PG8_LDA(At, 0, 1); PG8_STAGE(PG8_SB(0, 0), b2, voffB); PG8_STAGE(PG8_SB(0, 1), b2 + b2h, voffB); PG8_STAGE(PG8_SA(0, 0), a2, voffA);
            PG8_WAIT_V(8); PG8_WAIT_L(0); PG8_BAR; PG8_MMA(1, 0, At, B0); PG8_MMA(1, 1, At, B1); PG8_BAR; PG8_SCHED;
            PG8_LDB(B0, 1, 0); PG8_LDB(B1, 1, 1); PG8_SCHED; PG8_LDA(At, 1, 0); PG8_STAGE(PG8_SA(0, 1), a2 + hstep, voffA);
            PG8_WAIT_V(8); PG8_WAIT_L(0); PG8_BAR; PG8_MMA(0, 0, At, B0); PG8_MMA(0, 1, At, B1); PG8_BAR; PG8_SCHED;
            PG8_LDA(At, 1, 1); PG8_STAGE(PG8_SB(1, 0), b3, voffB); PG8_STAGE(PG8_SB(1, 1), b3 + b2h, voffB); PG8_STAGE(PG8_SA(1, 0), a3, voffA);
            PG8_WAIT_V(8); PG8_WAIT_L(0); PG8_BAR; PG8_MMA(1, 0, At, B0); PG8_MMA(1, 1, At, B1); PG8_BAR; PG8_SCHED;
            } else {
            PG8_LDB(B0, 0, 0); PG8_SCHED; PG8_LDA(At, 0, 0); PG8_STAGE(PG8_SA(1, 1), a1 + hstep, voffA);
            PG8_WAIT_L(8); PG8_BAR; PG8_WAIT_L(0); PG8_MMA(0, 0, At, B0); PG8_BAR; PG8_SCHED;
            PG8_LDB(B1, 0, 1); PG8_STAGE(PG8_SB(0, 0), b2, voffB);
            PG8_BAR; PG8_WAIT_L(0); PG8_MMA(0, 1, At, B1); PG8_BAR;
            PG8_LDA(At, 0, 1); PG8_STAGE(PG8_SA(0, 0), a2, voffA);
            PG8_BAR; PG8_WAIT_L(0); PG8_MMA(1, 0, At, B0); PG8_BAR; PG8_SCHED;
            PG8_STAGE(PG8_SB(0, 1), b2 + b2h, voffB);
            PG8_WAIT_V(6); PG8_BAR; PG8_MMA(1, 1, At, B1); PG8_BAR;
            PG8_LDB(B0, 1, 0); PG8_SCHED; PG8_LDA(At, 1, 0); PG8_STAGE(PG8_SA(0, 1), a2 + hstep, voffA);
            PG8_WAIT_L(8); PG8_BAR; PG8_WAIT_L(0); PG8_MMA(0, 0, At, B0); PG8_BAR; PG8_SCHED;
            PG8_LDB(B1, 1, 1); PG8_STAGE(PG8_SB(1, 0), b3, voffB);
            PG8_BAR; PG8_WAIT_L(0); PG8_MMA(0, 1, At, B1); PG8_BAR;
            PG8_LDA(At, 1, 1); PG8_STAGE(PG8_SA(1, 0), a3, voffA);
            PG8_BAR; PG8_WAIT_L(0); PG8_MMA(1, 0, At, B0); PG8_BAR; PG8_SCHED;
            PG8_STAGE(PG8_SB(1, 1), b3 + b2h, voffB);
            PG8_WAIT_V(6); PG8_BAR; PG8_MMA(1, 1, At, B1); PG8_BAR;
            }
        }
        } else {
        for (int t = 0; t < nt; t += 2) {
            const bool last = (t == nt - 2);
            const char* a1 = cA + (size_t)(t + 1) * kstep;
            const char* a2 = last ? nA : cA + (size_t)(t + 2) * kstep; const char* b2 = last ? nB : cB + (size_t)(t + 2) * kstep;
            const char* a3 = a2 + kstep; const char* b3 = b2 + kstep; const size_t b2h = last ? nbh : cbh;
            if (last && has_next) S.a_ready(nxt);
            if constexpr (SP2) {
            PG8_LDB(B0, 0, 0); PG8_LDB(B1, 0, 1); PG8_SCHED; PG8_LDA(At, 0, 0); PG8_STAGE(PG8_SA(1, 1), a1 + hstep, voffA);
            PG8_WAIT_V(8); PG8_WAIT_L(0); PG8_BAR; PG8_MMA(0, 0, At, B0);  PG8_BAR; PG8_SCHED;
            PG8_LDA(At, 0, 1); PG8_STAGE(PG8_SB(0, 0), b2, voffB); PG8_STAGE(PG8_SB(0, 1), b2 + b2h, voffB); PG8_STAGE(PG8_SA(0, 0), a2, voffA);
            PG8_WAIT_V(8); PG8_WAIT_L(0); PG8_BAR; PG8_MMA(1, 0, At, B0);  PG8_BAR; PG8_SCHED;
            PG8_LDB(B0, 1, 0); PG8_LDB(B1, 1, 1); PG8_SCHED; PG8_LDA(At, 1, 0); PG8_STAGE(PG8_SA(0, 1), a2 + hstep, voffA);
            PG8_WAIT_V(8); PG8_WAIT_L(0); PG8_BAR; PG8_MMA(0, 0, At, B0);  PG8_BAR; PG8_SCHED;
            PG8_LDA(At, 1, 1); PG8_STAGE(PG8_SB(1, 0), b3, voffB); PG8_STAGE(PG8_SB(1, 1), b3 + b2h, voffB); PG8_STAGE(PG8_SA(1, 0), a3, voffA);
            PG8_WAIT_V(8); PG8_WAIT_L(0); PG8_BAR; PG8_MMA(1, 0, At, B0);  PG8_BAR; PG8_SCHED;
            } else {
            PG8_LDB(B0, 0, 0); PG8_SCHED; PG8_LDA(At, 0, 0); PG8_STAGE(PG8_SA(1, 1), a1 + hstep, voffA);
            PG8_WAIT_L(8); PG8_BAR; PG8_WAIT_L(0); PG8_MMA(0, 0, At, B0); PG8_BAR; PG8_SCHED;
            PG8_LDB(B1, 0, 1); PG8_STAGE(PG8_SB(0, 0), b2, voffB);
            PG8_BAR; PG8_WAIT_L(0); PG8_MMA(0, 1, At, B1); PG8_BAR;
            PG8_LDA(At, 0, 1); PG8_STAGE(PG8_SA(0, 0), a2, voffA);
            PG8_BAR; PG8_WAIT_L(0); PG8_MMA(1, 0, At, B0); PG8_BAR; PG8_SCHED;
            PG8_STAGE(PG8_SB(0, 1), b2 + b2h, voffB);
            PG8_WAIT_V(6); PG8_BAR; PG8_MMA(1, 1, At, B1); PG8_BAR;
            PG8_LDB(B0, 1, 0); PG8_SCHED; PG8_LDA(At, 1, 0); PG8_STAGE(PG8_SA(0, 1), a2 + hstep, voffA);
            PG8_WAIT_L(8); PG8_BAR; PG8_WAIT_L(0); PG8_MMA(0, 0, At, B0); PG8_BAR; PG8_SCHED;
            PG8_LDB(B1, 1, 1); PG8_STAGE(PG8_SB(1, 0), b3, voffB);
            PG8_BAR; PG8_WAIT_L(0); PG8_MMA(0, 1, At, B1); PG8_BAR;
            PG8_LDA(At, 1, 1); PG8_STAGE(PG8_SA(1, 0), a3, voffA);
            PG8_BAR; PG8_WAIT_L(0); PG8_MMA(1, 0, At, B0); PG8_BAR; PG8_SCHED;
            PG8_STAGE(PG8_SB(1, 1), b3 + b2h, voffB);
            PG8_WAIT_V(6); PG8_BAR; PG8_MMA(1, 1, At, B1); PG8_BAR;
            }
        }
        }
        if constexpr (ALIGN_EPI) { if (wr == 0) PG8_BAR; }
        if constexpr (!Epi::AFTER_DRAIN) { E(acc, cur, wr, wc, fr, fq); S.done(cur); }
        if (!has_next) break;
#pragma unroll
        for (int a = 0; a < 2; ++a)
#pragma unroll
            for (int b = 0; b < 2; ++b)
#pragma unroll
                for (int m = 0; m < 4; ++m)
#pragma unroll
                    for (int n = 0; n < 2; ++n) acc[a][b][m][n] = (f32x4){0.f, 0.f, 0.f, 0.f};
        cur = nxt; cA = nA; cB = nB; cbh = nbh; ++ui;
        if constexpr (ALIGN_EPI) { if (wr == 1) PG8_BAR; }
    }
    PG8_WAIT_V(0);
    if constexpr (!ALIGN_EPI) { if (wr == 0) PG8_BAR; }
    PG8_BAR;
    if constexpr (Epi::AFTER_DRAIN) { E.fused(acc, cur, wr, wc, fr, fq, lds, wid, lane); S.done(cur); }
#undef PG8_SA
#undef PG8_SB
#undef PG8_STAGE
#undef PG8_LDA
#undef PG8_LDB
#undef PG8_MMA
#undef PG8_WAIT_V
#undef PG8_WAIT_L
#undef PG8_BAR
#undef PG8_SCHED
}
}
namespace attn {
using bf16 = __hip_bfloat16;
constexpr int   D = 128, NW = 8, QBLK = 32, KVBLK = 64;
constexpr float SCALE = 0.088388347648318440f;
constexpr float THR = 8.f;
constexpr int SDEPTH = 2;
constexpr int LDQ = 1024, LDK = 128, LDO = 1024;
constexpr size_t SHM_V = KVBLK * D * 2, SHM_K = KVBLK * D * 2, SHM_ATTN = 2 * SHM_V + 2 * SHM_K + NW * 64 * 4;
using bf16x8 = __attribute__((ext_vector_type(8))) short;
using s16x4  = __attribute__((ext_vector_type(4))) short;
using f32x16 = __attribute__((ext_vector_type(16))) float;
using f32x8  = __attribute__((ext_vector_type(8))) float;
using u32x4  = __attribute__((ext_vector_type(4))) unsigned;
#define KSWZ(row, colB) ((row) * 256 + ((colB) ^ (((row) & 7) << 4)))
#define SBAR() __builtin_amdgcn_sched_barrier(0)
__device__ __forceinline__ int crow(int r, int hi) { return (r & 3) + 8 * (r >> 2) + 4 * hi; }
__device__ __forceinline__ unsigned cvtpk(float lo, float hi) {
  unsigned r; asm volatile("v_cvt_pk_bf16_f32 %0, %1, %2" : "=v"(r) : "v"(lo), "v"(hi)); return r;
}
template <typename TIn> struct Stage;
template <> struct Stage<bf16>  { using T = bf16x8;
  __device__ static __forceinline__ T ld8(const bf16* p) { return *reinterpret_cast<const bf16x8*>(p); }
  __device__ static __forceinline__ bf16x8 tobf(T x) { return x; } };
template <> struct Stage<float> { using T = f32x8;
  __device__ static __forceinline__ T ld8(const float* p) { return *reinterpret_cast<const f32x8*>(p); }
  __device__ static __forceinline__ bf16x8 tobf(T x) {
    u32x4 w = {cvtpk(x[0], x[1]), cvtpk(x[2], x[3]), cvtpk(x[4], x[5]), cvtpk(x[6], x[7])}; return *reinterpret_cast<bf16x8*>(&w); } };

__device__ __forceinline__ void partialSM(f32x16& p0, f32x16& p1, float& m_reg, float& mn, float& alpha) {
  constexpr float C = SCALE * 1.4426950408889634f;
  float pmax = p0[0]; for (int r = 1; r < 16; ++r) pmax = fmaxf(pmax, p0[r]); for (int r = 0; r < 16; ++r) pmax = fmaxf(pmax, p1[r]);
  { auto rr = __builtin_amdgcn_permlane32_swap(__float_as_uint(pmax), __float_as_uint(pmax), false, false);
    pmax = fmaxf(__uint_as_float(rr[0]), __uint_as_float(rr[1])); }
  if (__builtin_expect(__all(pmax - m_reg <= THR / SCALE), 1)) { mn = m_reg; alpha = 1.f; }
  else { mn = fmaxf(m_reg, pmax); alpha = __builtin_amdgcn_exp2f((m_reg - mn) * C); m_reg = mn; }
  float mnC = -mn * C;
  for (int r = 0; r < 16; ++r) p0[r] = fmaf(p0[r], C, mnC); for (int r = 0; r < 16; ++r) p1[r] = fmaf(p1[r], C, mnC);
  for (int r = 0; r < 16; ++r) p0[r] = __builtin_amdgcn_exp2f(p0[r]);
}
__device__ __forceinline__ void finishSM(f32x16& p0, f32x16& p1, float alpha, float& l_reg, bf16x8& pa0, bf16x8& pa1, bf16x8& pa2, bf16x8& pa3) {
  for (int r = 0; r < 16; ++r) p1[r] = __builtin_amdgcn_exp2f(p1[r]);
  float ps = 0; for (int r = 0; r < 16; ++r) ps += p0[r]; for (int r = 0; r < 16; ++r) ps += p1[r];
  { auto rr = __builtin_amdgcn_permlane32_swap(__float_as_uint(ps), __float_as_uint(ps), false, false);
    ps = __uint_as_float(rr[0]) + __uint_as_float(rr[1]); }
  l_reg = l_reg * alpha + ps;
#define PK4(P, BASE, OUT) do { unsigned a0 = cvtpk(P[BASE + 0], P[BASE + 1]), a1 = cvtpk(P[BASE + 2], P[BASE + 3]);   \
    unsigned b0 = cvtpk(P[BASE + 4], P[BASE + 5]), b1 = cvtpk(P[BASE + 6], P[BASE + 7]);                              \
    auto r0 = __builtin_amdgcn_permlane32_swap(a0, b0, false, false); auto r1 = __builtin_amdgcn_permlane32_swap(a1, b1, false, false); \
    u32x4 w = {r0[0], r1[0], r0[1], r1[1]}; OUT = *reinterpret_cast<bf16x8*>(&w); } while (0)
  PK4(p0, 0, pa0); PK4(p0, 8, pa1); PK4(p1, 0, pa2); PK4(p1, 8, pa3);
#undef PK4
}
__device__ __forceinline__ void qkt(f32x16& p0, f32x16& p1, const bf16* Ks, const bf16x8* qr, int r32, int hi) {
  p0 = f32x16{}; p1 = f32x16{};
  for (int d0 = 0; d0 < 8; ++d0) { int cb = (d0 * 16 + hi * 8) * 2;
    bf16x8 b0 = *reinterpret_cast<const bf16x8*>((const char*)Ks + KSWZ(r32, cb));
    bf16x8 b1 = *reinterpret_cast<const bf16x8*>((const char*)Ks + KSWZ(32 + r32, cb));
    p0 = __builtin_amdgcn_mfma_f32_32x32x16_bf16(b0, qr[d0], p0, 0, 0, 0);
    p1 = __builtin_amdgcn_mfma_f32_32x32x16_bf16(b1, qr[d0], p1, 0, 0, 0); }
}
__device__ __forceinline__ int v_st(int k, int c) { const int kk = (k & ~0xC) | ((k & 4) << 1) | ((k & 8) >> 1); return ((kk >> 3) * 4 + (c >> 5)) * 512 + ((kk & 7) * 32 + (c & 31)) * 2; }
__device__ __forceinline__ int v_rd_base(int lane) { return ((lane & 3) << 3) | (((lane >> 2) & 3) << 6) | (((lane >> 4) & 1) << 5) | (((lane >> 5) & 1) << 8); }
constexpr int v_rd_off(int d0, int ks, int half) { return d0 * 512 + ks * 4096 + half * 2048; }
template <int OFF> __device__ __forceinline__ s16x4 tr_read(int vb) {
  s16x4 r; asm volatile("ds_read_b64_tr_b16 %0, %1 offset:%2" : "=&v"(r) : "v"(vb), "i"(OFF) : "memory"); return r;
}
template <int D0> __device__ __forceinline__ void pv_one(f32x16& od, int vb, bf16x8 pa0, bf16x8 pa1, bf16x8 pa2, bf16x8 pa3) {
  const s16x4 l0 = tr_read<v_rd_off(D0, 0, 0)>(vb), h0 = tr_read<v_rd_off(D0, 0, 1)>(vb), l1 = tr_read<v_rd_off(D0, 1, 0)>(vb), h1 = tr_read<v_rd_off(D0, 1, 1)>(vb);
  const s16x4 l2 = tr_read<v_rd_off(D0, 2, 0)>(vb), h2 = tr_read<v_rd_off(D0, 2, 1)>(vb), l3 = tr_read<v_rd_off(D0, 3, 0)>(vb), h3 = tr_read<v_rd_off(D0, 3, 1)>(vb);
  asm volatile("s_waitcnt lgkmcnt(0)" ::: "memory"); SBAR();
#define PK(L, H) (bf16x8){L[0], L[1], L[2], L[3], H[0], H[1], H[2], H[3]}
  od = __builtin_amdgcn_mfma_f32_32x32x16_bf16(pa0, PK(l0, h0), od, 0, 0, 0);
  od = __builtin_amdgcn_mfma_f32_32x32x16_bf16(pa1, PK(l1, h1), od, 0, 0, 0);
  od = __builtin_amdgcn_mfma_f32_32x32x16_bf16(pa2, PK(l2, h2), od, 0, 0, 0);
  od = __builtin_amdgcn_mfma_f32_32x32x16_bf16(pa3, PK(l3, h3), od, 0, 0, 0);
#undef PK
}
__device__ __forceinline__ void pv_d0(f32x16* o, int vb, bf16x8 pa0, bf16x8 pa1, bf16x8 pa2, bf16x8 pa3) {
  pv_one<0>(o[0], vb, pa0, pa1, pa2, pa3); pv_one<1>(o[1], vb, pa0, pa1, pa2, pa3); pv_one<2>(o[2], vb, pa0, pa1, pa2, pa3); pv_one<3>(o[3], vb, pa0, pa1, pa2, pa3);
}

template <typename TQ>
__device__ __forceinline__ void attn_dense_body(const TQ* __restrict__ Qb, const bf16* __restrict__ Kh, const bf16* __restrict__ Vh,
                                                bf16* __restrict__ Ob, int seq, char* lds) {
  using St = Stage<bf16>; using SQ = Stage<TQ>;
  const int tid = threadIdx.x, wid = tid >> 6, lane = tid & 63, r32 = lane & 31, hi = lane >> 5;
  bf16* V_lds = (bf16*)lds; bf16* K_lds = (bf16*)(lds + 2 * SHM_V);
  float* ws = (float*)(lds + 2 * SHM_V + 2 * SHM_K) + wid * 64; float* li_l = ws; float* al_l = ws + 32;
  float m_reg = -1e30f, l_reg = 0; f32x16 o[4] = {}; bf16x8 qr[8];
  const TQ* Qw = Qb + (long)(wid * QBLK + r32) * LDQ + hi * 8;
#pragma unroll
  for (int d0 = 0; d0 < 8; ++d0) qr[d0] = SQ::tobf(SQ::ld8(Qw + d0 * 16));
  const int sr = tid >> 4, sc = (tid & 15) * 8, vst0 = v_st(sr, sc), vst1 = v_st(32 + sr, sc);
  const int vb0 = (int)(uintptr_t)V_lds + v_rd_base(lane);
  struct { typename St::T vs0, vs1, ks0, ks1; } sr_[SDEPTH];
#define SLOAD(i, k0) do { sr_[i].vs0 = St::ld8(&Vh[(long)((k0) + sr) * LDK + sc]); sr_[i].vs1 = St::ld8(&Vh[(long)((k0) + 32 + sr) * LDK + sc]); \
    sr_[i].ks0 = St::ld8(&Kh[(long)((k0) + sr) * LDK + sc]); sr_[i].ks1 = St::ld8(&Kh[(long)((k0) + 32 + sr) * LDK + sc]); } while (0)
#define SWRITE(b, i) do { *(bf16x8*)((char*)V_lds + (b) * SHM_V + vst0) = St::tobf(sr_[i].vs0);          \
    *(bf16x8*)((char*)V_lds + (b) * SHM_V + vst1) = St::tobf(sr_[i].vs1); int kc = sc * 2;               \
    *(bf16x8*)((char*)K_lds + (b) * SHM_K + KSWZ(sr, kc)) = St::tobf(sr_[i].ks0);                       \
    *(bf16x8*)((char*)K_lds + (b) * SHM_K + KSWZ(32 + sr, kc)) = St::tobf(sr_[i].ks1); } while (0)
#define SWAIT() do { if constexpr (SDEPTH == 2) asm volatile("s_waitcnt vmcnt(4)" ::: "memory"); else asm volatile("s_waitcnt vmcnt(0)" ::: "memory"); } while (0)
#define RESC(a) do { if (__any((a) < 1.f)) { if (hi == 0) al_l[r32] = (a); asm volatile("s_waitcnt lgkmcnt(0)" ::: "memory"); \
    for (int d = 0; d < 4; ++d) for (int r = 0; r < 16; ++r) o[d][r] *= al_l[crow(r, hi)]; } } while (0)
  f32x16 pA0, pA1, pB0, pB1; float mnA, mnB, alA, alB; bf16x8 pa0, pa1, pa2, pa3; const int NT = seq / KVBLK;
  constexpr int SE = 0, SO = SDEPTH - 1;
  SLOAD(SE, 0); asm volatile("s_waitcnt vmcnt(0)" ::: "memory"); SWRITE(0, SE); __syncthreads();
  qkt(pA0, pA1, K_lds, qr, r32, hi); partialSM(pA0, pA1, m_reg, mnA, alA);
  SLOAD(SO, KVBLK); if constexpr (SDEPTH == 2) { if (2 < NT) SLOAD(SE, 2 * KVBLK); }
  SWAIT(); SWRITE(1, SO); __syncthreads();
  for (int j = 1; j + 1 < NT; j += 2) {
    SBAR(); qkt(pB0, pB1, (bf16*)((char*)K_lds + SHM_K), qr, r32, hi);
    finishSM(pA0, pA1, alA, l_reg, pa0, pa1, pa2, pa3); SBAR();
    SLOAD(SO, (j + SDEPTH) * KVBLK); SBAR();
    pv_d0(o, vb0, pa0, pa1, pa2, pa3); partialSM(pB0, pB1, m_reg, mnB, alB);
    __syncthreads(); SWAIT(); SWRITE(0, SE);
    RESC(alB); __syncthreads();
    SBAR(); qkt(pA0, pA1, K_lds, qr, r32, hi);
    finishSM(pB0, pB1, alB, l_reg, pa0, pa1, pa2, pa3); SBAR();
    if (SDEPTH == 1 || j + 3 < NT) SLOAD(SE, (j + 1 + SDEPTH) * KVBLK); SBAR();
    pv_d0(o, vb0 + (int)SHM_V, pa0, pa1, pa2, pa3); partialSM(pA0, pA1, m_reg, mnA, alA);
    __syncthreads(); SWAIT(); SWRITE(1, SO);
    RESC(alA); __syncthreads();
  }
  SBAR(); qkt(pB0, pB1, (bf16*)((char*)K_lds + SHM_K), qr, r32, hi);
  finishSM(pA0, pA1, alA, l_reg, pa0, pa1, pa2, pa3); SBAR();
  pv_d0(o, vb0, pa0, pa1, pa2, pa3); partialSM(pB0, pB1, m_reg, mnB, alB);
  __syncthreads(); RESC(alB);
  finishSM(pB0, pB1, alB, l_reg, pa0, pa1, pa2, pa3); SBAR();
  pv_d0(o, vb0 + (int)SHM_V, pa0, pa1, pa2, pa3);
  if (hi == 0) li_l[r32] = l_reg; asm volatile("s_waitcnt lgkmcnt(0)" ::: "memory");
  float rli[16];
#pragma unroll
  for (int r = 0; r < 16; ++r) rli[r] = __builtin_amdgcn_rcpf(li_l[crow(r, hi)]);
  bf16* Ow = Ob + (long)(wid * QBLK) * LDO;
#pragma unroll
  for (int r = 0; r < 16; ++r) { int orow = crow(r, hi);
    for (int d0 = 0; d0 < 4; ++d0) Ow[(long)orow * LDO + d0 * 32 + r32] = __float2bfloat16(o[d0][r] * rli[r]); }
#undef SLOAD
#undef SWRITE
#undef SWAIT
#undef RESC
}
}
#define LAS __attribute__((address_space(3)))
typedef __hip_bfloat16 bf16;
typedef float f32x4v __attribute__((ext_vector_type(4)));
typedef unsigned u32x4v __attribute__((ext_vector_type(4)));
typedef unsigned u32x2v __attribute__((ext_vector_type(2)));
constexpr int DM = 1024, NCTX = 4096, NLAT = 16384, MTOK = NCTX + NLAT, DFF = 2816, NQKV = 1536, EVIN = 2048, LCTX = 256, LLAT = 4096, PAST = 512, SKV = PAST + LLAT;
constexpr float EPS = 1e-6f;
constexpr size_t MiB = 1u << 20;
constexpr size_t WS_MODS = 0;
constexpr size_t WS_GP = 256 * 1024, WS_SWF1 = 384 * 1024, WS_SWQKV = 640 * 1024, WS_SS = 672 * 1024;
constexpr size_t WS_WIN = 1 * MiB, WS_WOUT = 5 * MiB, WS_WQKV = 7 * MiB, WS_WO = 10 * MiB, WS_WF1 = 12 * MiB, WF1_STRIDE = 11 * MiB, WS_WF2 = 34 * MiB, WF2_STRIDE = (size_t)DM * DFF * 2;
constexpr size_t WS_H = 46 * MiB;
constexpr size_t WS_B = 86 * MiB;
constexpr size_t WS_P = WS_B, WS_MX = WS_B + 80 * MiB;
constexpr size_t WS_ACT = WS_B;
constexpr size_t WS_O = WS_B;
constexpr size_t WS_QKV = WS_B, WS_Q = WS_B + 60 * MiB, WS_KLAT = WS_B + 100 * MiB, WS_VLAT = WS_B + 109 * MiB, WS_KCTX = WS_B + 118 * MiB, WS_VCTX = WS_B + 120 * MiB;
constexpr size_t WS_XB = 208 * MiB, WS_END = 248 * MiB;
constexpr size_t WS_BAR = 992 * 1024, WS_ZERO_BEGIN = WS_SS, WS_ZERO_BYTES = 1 * MiB - WS_SS;
constexpr int LDS_BYTES = 135168;
constexpr int NPHASE = 14;

struct Params { const float* in[22]; float* out; unsigned char* ws; int ph_lo, ph_hi; };

__device__ __forceinline__ float wave_sum(float v) {
#pragma unroll
    for (int o = 1; o < 64; o <<= 1) v += __shfl_xor(v, o);
    return v;
}
__device__ __forceinline__ unsigned f2bf(float f) { unsigned u = __builtin_bit_cast(unsigned, f); return (u + 0x7fffu + ((u >> 16) & 1u)) >> 16; }
__device__ __forceinline__ unsigned pk2(float lo, float hi) { return f2bf(lo) | (f2bf(hi) << 16); }
__device__ __forceinline__ float bf_lo(unsigned w) { return __builtin_bit_cast(float, w << 16); }
__device__ __forceinline__ float bf_hi(unsigned w) { return __builtin_bit_cast(float, w & 0xffff0000u); }
__device__ __forceinline__ float bf1(unsigned short h) { return __builtin_bit_cast(float, (unsigned)h << 16); }

__device__ __forceinline__ void ld8f(const unsigned short* ptr, float* f) { const u32x4v w = *(const u32x4v*)ptr; f[0] = bf_lo(w.x); f[1] = bf_hi(w.x); f[2] = bf_lo(w.y); f[3] = bf_hi(w.y); f[4] = bf_lo(w.z); f[5] = bf_hi(w.z); f[6] = bf_lo(w.w); f[7] = bf_hi(w.w); }
__device__ __forceinline__ void ld8f_nt(const unsigned short* ptr, float* f) { const u32x4v w = __builtin_nontemporal_load((const u32x4v*)ptr); f[0] = bf_lo(w.x); f[1] = bf_hi(w.x); f[2] = bf_lo(w.y); f[3] = bf_hi(w.y); f[4] = bf_lo(w.z); f[5] = bf_hi(w.z); f[6] = bf_lo(w.w); f[7] = bf_hi(w.w); }
__device__ __forceinline__ void transpose_item(const float* W, int N, int k0, int n0, unsigned short* WT, int ldk, int dst_row0, int dst_k0, LAS float* scr, int lane) {
    float tv[32];
#pragma unroll
    for (int i = 0; i < 32; ++i) tv[i] = __builtin_nontemporal_load(&W[(size_t)(k0 + 2 * i + (lane >> 5)) * N + n0 + (lane & 31)]);
#pragma unroll
    for (int i = 0; i < 32; ++i) scr[(2 * i + (lane >> 5)) * 33 + (lane & 31)] = tv[i];
    asm volatile("s_waitcnt lgkmcnt(0)" ::: "memory");
    const int c = lane & 7;
#pragma unroll
    for (int j = 0; j < 4; ++j) { const int n = (lane >> 3) + 8 * j; const LAS float* s = scr + (8 * c) * 33 + n;
        u32x4v o; o.x = pk2(s[0 * 33], s[1 * 33]); o.y = pk2(s[2 * 33], s[3 * 33]); o.z = pk2(s[4 * 33], s[5 * 33]); o.w = pk2(s[6 * 33], s[7 * 33]);
        *(u32x4v*)(WT + (size_t)(dst_row0 + n) * ldk + dst_k0 + k0 + 8 * c) = o; }
    asm volatile("s_waitcnt lgkmcnt(0)" ::: "memory");
}

__device__ __forceinline__ void phase_prep(const Params& p, LAS unsigned char* lds, int tid, int lane, int wave) {
    unsigned char* ws = p.ws;
    {
        LAS float* sc = (LAS float*)lds;
        LAS float* red = (LAS float*)(lds + 20480);
        const float* cl = p.in[4]; const float* cctx = p.in[5]; const float* w_ada = p.in[6]; const float* b_ada = p.in[7];
        float* mods = (float*)(ws + WS_MODS);
        if ((int)blockIdx.x < 192) {
            for (int idx = tid; idx < 5 * 1024; idx += 512) { const int j = idx >> 10, k = idx & 1023; const float v = j == 0 ? cctx[k] : cl[(j - 1) * 1024 + k]; sc[idx] = v / (1.0f + __expf(-v)); }
            __syncthreads();
            for (int item = blockIdx.x; item < 192; item += gridDim.x) {
                const int l = item / 96, n0 = (item % 96) * 64;
                float a0 = 0.f, a1 = 0.f, a2 = 0.f, a3 = 0.f, a4 = 0.f;
                const float* wp = w_ada + ((size_t)l * 1024 + wave * 128) * 6144 + n0 + lane;
#pragma unroll 16
                for (int k = 0; k < 128; ++k) { const float wv = __builtin_nontemporal_load(&wp[(size_t)k * 6144]); const int kk = wave * 128 + k;
                    a0 += sc[kk] * wv; a1 += sc[1024 + kk] * wv; a2 += sc[2048 + kk] * wv; a3 += sc[3072 + kk] * wv; a4 += sc[4096 + kk] * wv; }
                red[(wave * 5 + 0) * 64 + lane] = a0; red[(wave * 5 + 1) * 64 + lane] = a1; red[(wave * 5 + 2) * 64 + lane] = a2; red[(wave * 5 + 3) * 64 + lane] = a3; red[(wave * 5 + 4) * 64 + lane] = a4;
                __syncthreads();
                if (tid < 320) { const int j = tid >> 6, ln = tid & 63; float s = b_ada[l * 6144 + n0 + ln];
#pragma unroll
                    for (int w = 0; w < 8; ++w) s += red[(w * 5 + j) * 64 + ln];
                    mods[(size_t)(l * 5 + j) * 6144 + n0 + ln] = s; }
                __syncthreads();
            }
        }
    }
    {
        LAS float* scr = (LAS float*)(lds + 32768 + wave * 8704);
        const int gw = blockIdx.x * 8 + wave, NGW = gridDim.x * 8;
        constexpr int I_IN = 16 * 64, I_QKV = 16 * 48, I_O = 16 * 32, I_OUT = 8 * 32, I_F1 = 16 * 176, I_F2 = 44 * 32, I_FOLD = 1024;
        constexpr int NITEMS = I_IN + I_QKV + I_O + I_OUT + 2 * I_F1 + 2 * I_F2 + I_FOLD;
        for (int it = gw; it < NITEMS; it += NGW) {
            int r = it;
            if (r < I_IN) { const int kb = r / 64, nb = r % 64; transpose_item(p.in[9], EVIN, kb * 64, nb * 32, (unsigned short*)(ws + WS_WIN), 1024, nb * 32, 0, scr, lane); continue; } r -= I_IN;
            if (r < I_QKV) { const int kb = r / 48, nb = r % 48; transpose_item(p.in[15], NQKV, kb * 64, nb * 32, (unsigned short*)(ws + WS_WQKV), 1024, nb * 32, 0, scr, lane); continue; } r -= I_QKV;
            if (r < I_O) { const int kb = r / 32, nb = r % 32; transpose_item(p.in[18], DM, kb * 64, nb * 32, (unsigned short*)(ws + WS_WO), 1024, nb * 32, 0, scr, lane); continue; } r -= I_O;
            if (r < I_OUT) { const int kb = r / 32, nb = r % 32; transpose_item(p.in[14] + (size_t)512 * 1024, DM, kb * 64, nb * 32, (unsigned short*)(ws + WS_WOUT), 1024, nb * 32, 512, scr, lane); continue; } r -= I_OUT;
            if (r < 2 * I_F1) { const int l = r / I_F1, q = r % I_F1, kb = q / 176, nb = q % 176, n0 = nb * 32;
                const int part = n0 >= DFF, jj = n0 - part * DFF, drow = (jj >> 7) * 256 + part * 128 + (jj & 127);
                transpose_item(p.in[19] + (size_t)l * DM * 2 * DFF, 2 * DFF, kb * 64, n0, (unsigned short*)(ws + WS_WF1 + l * WF1_STRIDE), 1024, drow, 0, scr, lane); continue; } r -= 2 * I_F1;
            if (r < 2 * I_F2) { const int l = r / I_F2, q = r % I_F2, kb = q / 32, nb = q % 32;
                transpose_item(p.in[20] + (size_t)l * DFF * DM, DM, kb * 64, nb * 32, (unsigned short*)(ws + WS_WF2 + l * WF2_STRIDE), DFF, nb * 32, 0, scr, lane); continue; } r -= 2 * I_F2;
            {
                const int g = r >> 8, cc = (r >> 4) & 15, nb = r & 15, n = nb * 64 + lane;
                const float* pw = p.in[10] + ((size_t)g * 128 + cc * 8) * 128; const float* psc = p.in[11] + g * 128; const float* wo = p.in[14] + (size_t)(g * 128) * 1024 + n;
                float a[8] = {0.f, 0.f, 0.f, 0.f, 0.f, 0.f, 0.f, 0.f};
                for (int d = 0; d < 128; ++d) { const float wv = psc[d] * wo[(size_t)d * 1024];
#pragma unroll
                    for (int c = 0; c < 8; ++c) a[c] += pw[c * 128 + d] * wv; }
                u32x4v o; o.x = pk2(a[0], a[1]); o.y = pk2(a[2], a[3]); o.z = pk2(a[4], a[5]); o.w = pk2(a[6], a[7]);
                *(u32x4v*)((unsigned short*)(ws + WS_WOUT) + (size_t)n * 1024 + g * 128 + cc * 8) = o;
            }
        }
    }
}

__device__ __forceinline__ void phase_p1(const Params& p, int tid, int lane, int wave) {
    unsigned char* ws = p.ws;
    const float* mods = (const float*)(ws + WS_MODS); const float* norm_g = p.in[8];
    const int gw = blockIdx.x * 8 + wave, NGW = gridDim.x * 8;
    {   float* gp = (float*)(ws + WS_GP);
        for (int idx = blockIdx.x * 512 + tid; idx < 3 * 5 * 1024; idx += gridDim.x * 512) { const int site = idx / 5120, j = (idx >> 10) % 5, c = idx & 1023, l = site >= 1, nrm = site != 1;
            gp[idx] = norm_g[(l * 2 + nrm) * 1024 + c] * (1.0f + mods[(size_t)(l * 5 + j) * 6144 + (nrm ? 4 : 1) * 1024 + c]); } }
#pragma unroll 1
    for (int site = 0; site < 3; ++site) {
        const int N = site == 1 ? NQKV : 2 * DFF, l = site >= 1, chunk = site == 1 ? 0 : 3;
        const unsigned short* Wt = (const unsigned short*)(ws + (site == 0 ? WS_WF1 : site == 1 ? WS_WQKV : WS_WF1 + WF1_STRIDE));
        float* dst = site == 1 ? (float*)(ws + WS_SWQKV) : (float*)(ws + WS_SWF1) + (site == 2) * 5 * 2 * DFF;
        if (gw < N) {
            float sh[5][16];
#pragma unroll
            for (int j = 0; j < 5; ++j) { const float* sp = mods + (size_t)(l * 5 + j) * 6144 + chunk * 1024 + 8 * lane;
#pragma unroll
                for (int q = 0; q < 4; ++q) { const f32x4v v = *(const f32x4v*)(sp + (q >> 1) * 512 + (q & 1) * 4); sh[j][4 * q] = v.x; sh[j][4 * q + 1] = v.y; sh[j][4 * q + 2] = v.z; sh[j][4 * q + 3] = v.w; } }
            for (int col = gw; col < N; col += NGW) {
                float f[16]; ld8f(Wt + (size_t)col * 1024 + 8 * lane, f); ld8f(Wt + (size_t)col * 1024 + 512 + 8 * lane, f + 8);
                float a[5];
#pragma unroll
                for (int j = 0; j < 5; ++j) { float s = 0.f;
#pragma unroll
                    for (int q = 0; q < 16; ++q) s += sh[j][q] * f[q];
                    a[j] = wave_sum(s); }
                if (lane == 0) {
#pragma unroll
                    for (int j = 0; j < 5; ++j) dst[(size_t)j * N + col] = a[j]; }
            }
        }
    }
    const float* xc = p.in[0]; const float* xl = p.in[1]; unsigned short* h = (unsigned short*)(ws + WS_H);
    for (int it = gw; it < MTOK / 4; it += NGW) {
        f32x4v v[4][4]; float ss[4];
#pragma unroll
        for (int rr = 0; rr < 4; ++rr) { const int row = it + rr * (MTOK / 4); const float* xr = row < NCTX ? xc + (size_t)row * DM : xl + (size_t)(row - NCTX) * DM;
#pragma unroll
            for (int q = 0; q < 4; ++q) v[rr][q] = *(const f32x4v*)(xr + 4 * lane + 256 * q); }
#pragma unroll
        for (int rr = 0; rr < 4; ++rr) { float s = 0.f;
#pragma unroll
            for (int q = 0; q < 4; ++q) s += (v[rr][q].x * v[rr][q].x + v[rr][q].y * v[rr][q].y) + (v[rr][q].z * v[rr][q].z + v[rr][q].w * v[rr][q].w);
            ss[rr] = s; }
#pragma unroll
        for (int rr = 0; rr < 4; ++rr) { const int row = it + rr * (MTOK / 4); const int j = row < NCTX ? 0 : 1 + ((row - NCTX) >> 12);
            const float rstd = __builtin_amdgcn_rsqf(wave_sum(ss[rr]) * (1.0f / DM) + EPS);
            const float* shp = mods + (size_t)j * 6144; const float* scp = shp + 1024;
#pragma unroll
            for (int q = 0; q < 4; ++q) { const int c = 4 * lane + 256 * q;
                const f32x4v gg = *(const f32x4v*)(norm_g + c), sc = *(const f32x4v*)(scp + c), shv = *(const f32x4v*)(shp + c);
                const f32x4v o = (v[rr][q] * rstd) * gg * (sc + 1.0f) + shv;
                u32x2v w; w.x = pk2(o.x, o.y); w.y = pk2(o.z, o.w);
                *(u32x2v*)(h + (size_t)row * DM + c) = w; } }
    }
}
__device__ __forceinline__ void phase_final(const unsigned short* xb, float* y, const float* g, const float* ss, int lane, int wave) {
    const int gw = blockIdx.x * 8 + wave, NGW = gridDim.x * 8;
    f32x4v gg[4];
#pragma unroll
    for (int q = 0; q < 4; ++q) gg[q] = *(const f32x4v*)(g + 4 * lane + 256 * q);
    for (int it = gw; it < MTOK / 4; it += NGW) {
        u32x2v v[4][4]; float rs[4];
#pragma unroll
        for (int rr = 0; rr < 4; ++rr) { const int row = it + rr * (MTOK / 4); rs[rr] = __builtin_amdgcn_rsqf(ss[row] * (1.0f / DM) + EPS);
#pragma unroll
            for (int q = 0; q < 4; ++q) v[rr][q] = __builtin_nontemporal_load((const u32x2v*)(xb + (size_t)row * DM + 4 * lane + 256 * q)); }
#pragma unroll
        for (int rr = 0; rr < 4; ++rr) { const int row = it + rr * (MTOK / 4);
#pragma unroll
            for (int q = 0; q < 4; ++q) { const f32x4v x = {bf_lo(v[rr][q].x), bf_hi(v[rr][q].x), bf_lo(v[rr][q].y), bf_hi(v[rr][q].y)};
                __builtin_nontemporal_store((x * rs[rr]) * gg[q], (f32x4v*)(y + (size_t)row * DM + 4 * lane + 256 * q)); } }
    }
}
__device__ __forceinline__ void phase_mixer(const unsigned short* P, unsigned short* MX, const float* conv_w, const float* conv_b, int lane, int wave) {
    const int gw = blockIdx.x * 8 + wave, NGW = gridDim.x * 8;
    const int c0 = 8 * lane, half = 1 << (lane >> 4);
    for (int it = gw; it < 2 * (MTOK / 8); it += NGW) {
        const int type = it & 1, row0 = (it >> 1) * 8;
        int t0, L; if (row0 < NCTX) { t0 = row0 & (LCTX - 1); L = LCTX; } else { t0 = (row0 - NCTX) & (LLAT - 1); L = LLAT; }
        const unsigned short* pr = P + (size_t)row0 * EVIN;
        if (type == 0) {
            float S[8] = {0.f, 0.f, 0.f, 0.f, 0.f, 0.f, 0.f, 0.f}, f[8];
#pragma unroll
            for (int k = 0; k < 16; ++k) { const int s = t0 - half + k; const float wgt = (k < 2 * half && s >= 0 && s < L) ? 1.f : 0.f; const int sc = min(max(s, 0), L - 1);
                ld8f_nt(pr + (ptrdiff_t)(sc - t0) * EVIN + c0, f);
#pragma unroll
                for (int i = 0; i < 8; ++i) S[i] += wgt * f[i]; }
#pragma unroll
            for (int r = 0; r < 8; ++r) { const int t = t0 + r; const int lo = max(t - half, 0), hi = min(t + half, L); const float inv = 1.0f / (float)(hi - lo);
                ld8f_nt(pr + (size_t)r * EVIN + c0, f);
                u32x4v o; o.x = pk2(S[0] * inv - f[0], S[1] * inv - f[1]); o.y = pk2(S[2] * inv - f[2], S[3] * inv - f[3]); o.z = pk2(S[4] * inv - f[4], S[5] * inv - f[5]); o.w = pk2(S[6] * inv - f[6], S[7] * inv - f[7]);
                *(u32x4v*)(MX + (size_t)(row0 + r) * DM + c0) = o;
                if (r < 7) {
                    { const int s = t + half; const float wgt = s < L ? 1.f : 0.f; ld8f_nt(pr + (ptrdiff_t)(min(s, L - 1) - t0) * EVIN + c0, f);
#pragma unroll
                      for (int i = 0; i < 8; ++i) S[i] += wgt * f[i]; }
                    { const int s = t - half; const float wgt = s >= 0 ? 1.f : 0.f; ld8f_nt(pr + (ptrdiff_t)(max(s, 0) - t0) * EVIN + c0, f);
#pragma unroll
                      for (int i = 0; i < 8; ++i) S[i] -= wgt * f[i]; } } }
        } else {
            float cw0[8], cw1[8], cw2[8], cb[8];
#pragma unroll
            for (int i = 0; i < 8; ++i) { cw0[i] = conv_w[c0 + i]; cw1[i] = conv_w[512 + c0 + i]; cw2[i] = conv_w[1024 + c0 + i]; cb[i] = conv_b[c0 + i]; }
            float zp[8], zc[8], zn[8], a[8], b[8];
            if (t0 > 0) { ld8f_nt(pr - EVIN + 1024 + c0, a); ld8f_nt(pr - EVIN + 1536 + c0, b);
#pragma unroll
                for (int i = 0; i < 8; ++i) zp[i] = a[i] * b[i]; }
            else {
#pragma unroll
                for (int i = 0; i < 8; ++i) zp[i] = 0.f; }
            ld8f_nt(pr + 1024 + c0, a); ld8f_nt(pr + 1536 + c0, b);
#pragma unroll
            for (int i = 0; i < 8; ++i) zc[i] = a[i] * b[i];
#pragma unroll
            for (int r = 0; r < 8; ++r) { const int t = t0 + r;
                if (t + 1 < L) { ld8f_nt(pr + (size_t)(r + 1) * EVIN + 1024 + c0, a); ld8f_nt(pr + (size_t)(r + 1) * EVIN + 1536 + c0, b);
#pragma unroll
                    for (int i = 0; i < 8; ++i) zn[i] = a[i] * b[i]; }
                else {
#pragma unroll
                    for (int i = 0; i < 8; ++i) zn[i] = 0.f; }
                ld8f_nt(pr + (size_t)r * EVIN + 512 + c0, a);
                float y[8];
#pragma unroll
                for (int i = 0; i < 8; ++i) y[i] = a[i] * (zp[i] * cw0[i] + zc[i] * cw1[i] + zn[i] * cw2[i] + cb[i]);
                u32x4v o; o.x = pk2(y[0], y[1]); o.y = pk2(y[2], y[3]); o.z = pk2(y[4], y[5]); o.w = pk2(y[6], y[7]);
                *(u32x4v*)(MX + (size_t)(row0 + r) * DM + 512 + c0) = o;
#pragma unroll
                for (int i = 0; i < 8; ++i) { zp[i] = zc[i]; zc[i] = zn[i]; } }
        }
    }
}
__device__ __forceinline__ void phase_qknorm(const Params& p, int lane, int wave) {
    unsigned char* ws = p.ws;
    const unsigned short* QKV = (const unsigned short*)(ws + WS_QKV);
    unsigned short* Q = (unsigned short*)(ws + WS_Q); unsigned short* KLAT = (unsigned short*)(ws + WS_KLAT); unsigned short* VLAT = (unsigned short*)(ws + WS_VLAT);
    unsigned short* KCTX = (unsigned short*)(ws + WS_KCTX); unsigned short* VCTX = (unsigned short*)(ws + WS_VCTX);
    float* nck = p.out + (size_t)MTOK * DM; float* ncv = nck + (size_t)16 * 256 * 256;
    const int gw = blockIdx.x * 8 + wave, NGW = gridDim.x * 8;
    const int i8 = 8 * (lane & 15), hsel = lane >> 4;
    const bool colaxis = (i8 >> 6) != 0, second = ((i8 >> 5) & 1) != 0;
    float qg[8], kg[8], invf[8];
#pragma unroll
    for (int q = 0; q < 8; ++q) { qg[q] = p.in[16][i8 + q]; kg[q] = p.in[17][i8 + q]; invf[q] = __builtin_amdgcn_exp2f(-(float)((i8 & 31) + q) * (13.287712379549449f / 32.0f)); }
    for (int row = gw; row < MTOK; row += NGW) {
        const unsigned short* r = QKV + (size_t)row * NQKV + 8 * lane;
        const u32x4v w0 = __builtin_nontemporal_load((const u32x4v*)(r)), w1 = __builtin_nontemporal_load((const u32x4v*)(r + 512)), w2 = __builtin_nontemporal_load((const u32x4v*)(r + 1024));
        const bool lat = row >= NCTX; int b, t; float cs[8], sn[8];
        if (lat) { const int rr = row - NCTX; b = rr >> 12; t = rr & 4095; const float pos = (float)(colaxis ? (t & 63) : (t >> 6));
#pragma unroll
            for (int q = 0; q < 8; ++q) { const float ang = pos * invf[q]; cs[q] = __cosf(ang); sn[q] = __sinf(ang); if (!second) sn[q] = -sn[q]; } }
        else { b = row >> 8; t = row & 255;
#pragma unroll
            for (int q = 0; q < 8; ++q) { cs[q] = 1.f; sn[q] = 0.f; } }
#pragma unroll
        for (int c = 0; c < 3; ++c) {
            const u32x4v w = c == 0 ? w0 : c == 1 ? w1 : w2;
            float x[8] = {bf_lo(w.x), bf_hi(w.x), bf_lo(w.y), bf_hi(w.y), bf_lo(w.z), bf_hi(w.z), bf_lo(w.w), bf_hi(w.w)};
            float s = 0.f;
#pragma unroll
            for (int q = 0; q < 8; ++q) s += x[q] * x[q];
            s += __shfl_xor(s, 1); s += __shfl_xor(s, 2); s += __shfl_xor(s, 4); s += __shfl_xor(s, 8);
            const float rstd = __builtin_amdgcn_rsqf(s * (1.0f / 128.0f) + EPS);
            float o[8];
#pragma unroll
            for (int q = 0; q < 8; ++q) { const float y = x[q] * rstd * (c < 2 ? qg[q] : kg[q]); const float yp = __shfl_xor(y, 4); o[q] = y * cs[q] + yp * sn[q]; }
            if (c < 2) { u32x4v ow; ow.x = pk2(o[0], o[1]); ow.y = pk2(o[2], o[3]); ow.z = pk2(o[4], o[5]); ow.w = pk2(o[6], o[7]);
                *(u32x4v*)(Q + (size_t)row * DM + c * 512 + 8 * lane) = ow; }
            else {
                const int kh = hsel & 1; const bool isv = hsel >= 2;
                u32x4v ow = w;
                if (!isv) { ow.x = pk2(o[0], o[1]); ow.y = pk2(o[2], o[3]); ow.z = pk2(o[4], o[5]); ow.w = pk2(o[6], o[7]); }
                if (lat) { unsigned short* dst = (isv ? VLAT : KLAT) + ((size_t)(b * 2 + kh) * SKV + PAST + t) * 128 + i8; *(u32x4v*)dst = ow; }
                else { unsigned short* dst = (isv ? VCTX : KCTX) + ((size_t)(b * 2 + kh) * LCTX + t) * 128 + i8; *(u32x4v*)dst = ow;
                    float* od = (isv ? ncv : nck) + ((size_t)(b * LCTX + t) * 2 + kh) * 128 + i8;
                    f32x4v f0, f1;
                    if (isv) { f0 = (f32x4v){x[0], x[1], x[2], x[3]}; f1 = (f32x4v){x[4], x[5], x[6], x[7]}; } else { f0 = (f32x4v){o[0], o[1], o[2], o[3]}; f1 = (f32x4v){o[4], o[5], o[6], o[7]}; }
                    __builtin_nontemporal_store(f0, (f32x4v*)od); __builtin_nontemporal_store(f1, (f32x4v*)(od + 4)); }
            }
        }
    }
    for (int it = gw; it < 2 * 4 * PAST; it += NGW) {
        const int which = it >> 11, q = it & 2047, b = q >> 9, s = q & 511, kh = lane >> 5;
        const f32x4v v = __builtin_nontemporal_load((const f32x4v*)((which ? p.in[3] : p.in[2]) + (size_t)(b * PAST + s) * 256 + 4 * lane));
        u32x2v w; w.x = pk2(v.x, v.y); w.y = pk2(v.z, v.w);
        *(u32x2v*)((which ? VLAT : KLAT) + ((size_t)(b * 2 + kh) * SKV + s) * 128 + 4 * (lane & 31)) = w;
    }
}
__device__ __forceinline__ void phase_attention(const Params& p, char* lds) {
    unsigned char* ws = p.ws;
    const bf16* Q = (const bf16*)(ws + WS_Q); bf16* O = (bf16*)(ws + WS_O);
    const bf16* KLAT = (const bf16*)(ws + WS_KLAT); const bf16* VLAT = (const bf16*)(ws + WS_VLAT); const bf16* KCTX = (const bf16*)(ws + WS_KCTX); const bf16* VCTX = (const bf16*)(ws + WS_VCTX);
    for (int L = blockIdx.x; L < 128 + 512; L += gridDim.x) {
        const bf16* Qp; const bf16* Kp; const bf16* Vp; bf16* Op; int seq;
        if (L < 128) { const int b = L >> 3, h = L & 7; const size_t q0 = (size_t)(b * LCTX) * DM + h * 128, k0 = (size_t)(b * 2 + (h >> 2)) * LCTX * 128;
            Qp = Q + q0; Kp = KCTX + k0; Vp = VCTX + k0; Op = O + q0; seq = LCTX; }
        else { const int u = L - 128, bk = u & 7, w = u >> 3, hq = w >> 4, qb = w & 15, b = bk >> 1, kvh = bk & 1, h = kvh * 4 + hq;
            const size_t q0 = (size_t)(NCTX + b * LLAT + qb * 256) * DM + h * 128, k0 = (size_t)(b * 2 + kvh) * SKV * 128;
            Qp = Q + q0; Kp = KLAT + k0; Vp = VLAT + k0; Op = O + q0; seq = SKV; }
        attn::attn_dense_body<bf16>(Qp, Kp, Vp, Op, seq, lds);
        __syncthreads();
    }
}

#define XB_TMO      128
#define XB_XCNT(j)  (256  + 64 * (j))
#define XB_XSUB(j)  (1280 + 64 * (j))
#define XB_XGEN(j)  (2304 + 64 * (j))
#define XB_TOP      3328
#define XB_TOPGEN   3392
#define XCD_BAR_WORDS 3456
#define XB_SPIN_CAP (1u << 18)

__device__ __forceinline__ unsigned xb_ld(unsigned* p)              { return __hip_atomic_load(p, __ATOMIC_RELAXED, __HIP_MEMORY_SCOPE_AGENT); }
__device__ __forceinline__ unsigned xb_add(unsigned* p, unsigned v) { return __hip_atomic_fetch_add(p, v, __ATOMIC_RELAXED, __HIP_MEMORY_SCOPE_AGENT); }
__device__ __forceinline__ unsigned xb_xcc_id() { return (unsigned)__builtin_amdgcn_s_getreg((3 << 11) | 20) & 0xFu; }
#define XB_SPIN(cond, bar) do { unsigned _sp = 0; while (cond) { __builtin_amdgcn_s_sleep(1); \
    if ((++_sp & 255u) == 0u) { if (xb_ld(&(bar)[XB_TMO])) break; if (_sp > XB_SPIN_CAP) { atomicAdd(&(bar)[XB_TMO], 1u); break; } } } } while (0)

struct XcdBarrier {
    unsigned* bar; unsigned x;
    volatile LAS unsigned* st;
};

__device__ __forceinline__ XcdBarrier xcd_barrier_post(unsigned* bar, volatile LAS unsigned* st) {
    XcdBarrier b; b.bar = bar; b.x = xb_xcc_id(); b.st = st;
    if (threadIdx.x == 0) (void)xb_add(&bar[XB_XCNT(b.x)], 1u);
    return b;
}
__device__ __forceinline__ void xcd_barrier_complete(unsigned* bar, unsigned x, unsigned& nloc, unsigned& nx) {
    const unsigned G = gridDim.x * gridDim.y * gridDim.z;
    unsigned sum, cnt, mine, sp = 0u;
    for (;;) {
        sum = 0u; cnt = 0u; mine = 0u;
#pragma unroll
        for (unsigned j = 0; j < 16; ++j) { const unsigned c = xb_ld(&bar[XB_XCNT(j)]); sum += c; cnt += (c > 0u) ? 1u : 0u; mine = (j == x) ? c : mine; }
        if (sum == G) break;
        __builtin_amdgcn_s_sleep(1);
        if ((++sp & 255u) == 0u) { if (xb_ld(&bar[XB_TMO])) break; if (sp > XB_SPIN_CAP) { atomicAdd(&bar[XB_TMO], 1u); break; } }
    }
    nloc = mine > 0u ? mine : 1u; nx = cnt > 0u ? cnt : 1u;
}

__device__ __forceinline__ void xcd_barrier(const XcdBarrier& b) {
    asm volatile("s_waitcnt vmcnt(0)" ::: "memory");
    __syncthreads();
    if (threadIdx.x == 0) {
        unsigned* bar = b.bar;
        __builtin_amdgcn_s_waitcnt(0);
        unsigned nloc = b.st[0], nx = b.st[1];
        if (nloc == 0u) { xcd_barrier_complete(bar, b.x, nloc, nx); b.st[0] = nloc; b.st[1] = nx; }
        const unsigned old = xb_add(&bar[XB_XSUB(b.x)], 1u);
        const unsigned gen = old / nloc;
        if (old + 1u == (gen + 1u) * nloc) {
            __builtin_amdgcn_fence(__ATOMIC_RELEASE, "agent");
            asm volatile("s_waitcnt vmcnt(0)" ::: "memory");
            const unsigned og = xb_add(&bar[XB_TOP], 1u);
            const unsigned tg = og / nx;
            if (og + 1u == (tg + 1u) * nx) xb_add(&bar[XB_TOPGEN], 1u);
            else XB_SPIN(xb_ld(&bar[XB_TOPGEN]) == tg, bar);
            __builtin_amdgcn_fence(__ATOMIC_ACQUIRE, "agent");
            xb_add(&bar[XB_XGEN(b.x)], 1u);
            asm volatile("s_waitcnt vmcnt(0)" ::: "memory");
        } else {
            XB_SPIN(xb_ld(&bar[XB_XGEN(b.x)]) == gen, bar);
            __builtin_amdgcn_fence(__ATOMIC_ACQUIRE, "agent");
            asm volatile("s_waitcnt vmcnt(0)" ::: "memory");
        }
    }
    __syncthreads();
}

template <int ph> __device__ __forceinline__ void run_phase(const Params& p, unsigned char* lds, int tid, int lane, int wave) {
    unsigned char* ws = p.ws;
    const float* mods = (const float*)(ws + WS_MODS); const float* gp = (const float*)(ws + WS_GP); float* ss = (float*)(ws + WS_SS);
    const float* sWf1 = (const float*)(ws + WS_SWF1); const float* sWqkv = (const float*)(ws + WS_SWQKV);
    float* xo = p.out;
    typedef pg8::bf16_t bt;
    if constexpr (ph == 0) phase_prep(p, (LAS unsigned char*)lds, tid, lane, wave);
    else if constexpr (ph == 1) phase_p1(p, tid, lane, wave);
    else if constexpr (ph == 2) {
        pg8::Gemm g{(const bt*)(ws + WS_H), (const bt*)(ws + WS_WIN), MTOK, EVIN, DM}; pg8::HalfOrder S; S.init(gridDim.x, blockIdx.x, EVIN / 256);
        pg8::EpiStoreN<false> E{(bt*)(ws + WS_P), EVIN, nullptr, nullptr, 0};
        pg8::gemm_phase<pg8::EpiStoreN<false>, pg8::HalfOrder, true, true>((LAS unsigned char*)lds, g, S, E); }
    else if constexpr (ph == 3) phase_mixer((const unsigned short*)(ws + WS_P), (unsigned short*)(ws + WS_MX), p.in[12], p.in[13], lane, wave);
    else if constexpr (ph == 4 || ph == 6 || ph == 10 || ph == 12) {
        constexpr int l = ph >= 10; constexpr bool ffn = (ph == 6 || ph == 12); constexpr int K = ffn ? DFF : DM; constexpr int site = ph == 4 ? 0 : ph == 6 ? 1 : ph == 10 ? 2 : 3;
        const unsigned char* A = ws + (ffn ? WS_ACT : (ph == 4 ? WS_MX : WS_O));
        const unsigned char* Bt = ws + (ffn ? WS_WF2 + l * WF2_STRIDE : (ph == 4 ? WS_WOUT : WS_WO));
        pg8::Gemm g{(const bt*)A, (const bt*)Bt, MTOK, DM, K}; pg8::HalfOrder S; S.init(gridDim.x, blockIdx.x);
        typedef pg8::EpiResNorm<(site < 3), (ph == 4)> Epi;
        Epi E{p.in[0], p.in[1], (bt*)(ws + WS_XB), mods + (size_t)l * 5 * 6144 + (ffn ? 5 : 2) * 1024, gp + (site < 3 ? site : 0) * 5120, (bt*)(ws + WS_H), ss + site * MTOK};
        pg8::gemm_phase<Epi, pg8::HalfOrder, true, true>((LAS unsigned char*)lds, g, S, E); }
    else if constexpr (ph == 5 || ph == 11) { constexpr int l = ph == 11;
        pg8::Gemm g{(const bt*)(ws + WS_H), (const bt*)(ws + WS_WF1 + l * WF1_STRIDE), MTOK, 2 * DFF, DM}; pg8::StaticOrder S; S.init(MTOK, 2 * DFF, gridDim.x, blockIdx.x);
        pg8::EpiSwigluN E{(bt*)(ws + WS_ACT), DFF, ss + (l ? 2 : 0) * MTOK, sWf1 + l * 5 * 2 * DFF, 2 * DFF};
        pg8::gemm_phase<pg8::EpiSwigluN, pg8::StaticOrder, true, true>((LAS unsigned char*)lds, g, S, E); }
    else if constexpr (ph == 7) {
        pg8::Gemm g{(const bt*)(ws + WS_H), (const bt*)(ws + WS_WQKV), MTOK, NQKV, DM}; pg8::StaticOrder S; S.init(MTOK, NQKV, gridDim.x, blockIdx.x);
        pg8::EpiStoreN<true> E{(bt*)(ws + WS_QKV), NQKV, ss + 1 * MTOK, sWqkv, NQKV};
        pg8::gemm_phase<pg8::EpiStoreN<true>, pg8::StaticOrder, true, true>((LAS unsigned char*)lds, g, S, E); }
    else if constexpr (ph == 8) phase_qknorm(p, lane, wave);
    else if constexpr (ph == 9) phase_attention(p, (char*)lds);
    else if constexpr (ph == 13) phase_final((const unsigned short*)(ws + WS_XB), xo, p.in[21], ss + 3 * MTOK, lane, wave);
}
__global__ void __launch_bounds__(512, 2) mega_fwd(Params p) {
    extern __shared__ __attribute__((aligned(16))) unsigned char lds[];
    cg::grid_group grid = cg::this_grid();
    const int tid = threadIdx.x, lane = tid & 63, wave = __builtin_amdgcn_readfirstlane(tid >> 6);
    const bool multi = p.ph_hi - p.ph_lo > 1, use_cg = gridDim.x > 1024u;
    if (tid < 2) ((LAS unsigned*)(lds + 131072))[tid] = 0u;
    __syncthreads();
    XcdBarrier bar; bar.bar = (unsigned*)(p.ws + WS_BAR); bar.x = 0; bar.st = nullptr;
    if (multi && !use_cg) bar = xcd_barrier_post((unsigned*)(p.ws + WS_BAR), (volatile LAS unsigned*)(lds + 131072));
#define SEAM(k) do { if (use_cg) grid.sync(); else xcd_barrier(bar); } while (0)
#define PHASE(k) if (p.ph_lo <= (k) && (k) < p.ph_hi) { run_phase<(k)>(p, lds, tid, lane, wave); if ((k) + 1 < p.ph_hi) SEAM(k); }
    PHASE(0) PHASE(1) PHASE(2) PHASE(3) PHASE(4) PHASE(5) PHASE(6) PHASE(7) PHASE(8) PHASE(9) PHASE(10) PHASE(11) PHASE(12) PHASE(13)
#undef PHASE
}

#ifndef MK_SPLIT
#define MK_SPLIT 0
#endif
extern "C" void kernel_launch(void* const* d_in, const int* in_sizes, int n_in, void* d_out, int out_size, void* d_ws, size_t ws_size, hipStream_t stream) {
    static int grid_blocks = 0;
    if (grid_blocks == 0) {
        if (n_in != 22 || ws_size < WS_END) { fprintf(stderr, "kernel_launch: unexpected n_in %d / ws_size %zu\n", n_in, ws_size); grid_blocks = -1; return; }
        int dev = 0, cus = 0, per_cu = 0;
        (void)hipGetDevice(&dev); (void)hipDeviceGetAttribute(&cus, hipDeviceAttributeMultiprocessorCount, dev);
        if (hipFuncSetAttribute((const void*)mega_fwd, hipFuncAttributeMaxDynamicSharedMemorySize, LDS_BYTES) != hipSuccess) { fprintf(stderr, "kernel_launch: hipFuncSetAttribute failed\n"); grid_blocks = -1; return; }
        if (hipOccupancyMaxActiveBlocksPerMultiprocessor(&per_cu, (const void*)mega_fwd, 512, LDS_BYTES) != hipSuccess || per_cu < 1) { fprintf(stderr, "kernel_launch: occupancy query gave %d\n", per_cu); grid_blocks = -1; return; }
        grid_blocks = cus * per_cu;
    }
    if (grid_blocks < 0) return;
    if (hipMemsetAsync((char*)d_ws + WS_ZERO_BEGIN, 0, WS_ZERO_BYTES, stream) != hipSuccess) { fprintf(stderr, "kernel_launch: hipMemsetAsync failed\n"); return; }
    Params p{};
    for (int i = 0; i < 22; ++i) p.in[i] = (const float*)d_in[i];
    p.out = (float*)d_out; p.ws = (unsigned char*)d_ws;
#if MK_SPLIT
    for (int ph = 0; ph < NPHASE; ++ph) {
        p.ph_lo = ph; p.ph_hi = ph + 1; void* args[] = {&p};
        hipError_t e = hipLaunchCooperativeKernel((const void*)mega_fwd, dim3(grid_blocks), dim3(512), args, LDS_BYTES, stream);
        if (e != hipSuccess) { fprintf(stderr, "cooperative launch failed: %s (grid %d)\n", hipGetErrorString(e), grid_blocks); return; }
    }
#else
    p.ph_lo = 0; p.ph_hi = NPHASE; void* args[] = {&p};
    hipError_t e = hipLaunchCooperativeKernel((const void*)mega_fwd, dim3(grid_blocks), dim3(512), args, LDS_BYTES, stream);
    if (e != hipSuccess) fprintf(stderr, "cooperative launch failed: %s (grid %d)\n", hipGetErrorString(e), grid_blocks);
#endif
}
```
